# Optimizing an MI355X kernel written in HIP

```python
import jax, jax.numpy as jnp
from jax import lax
import numpy as np

D_MODEL = 1024
BATCH = 8
SEQ = 2048
DEPTH = 1
DEC_BATCH = 128
DEC_SEQ = 4
PAST_LEN = 16384
PAGE_SIZE = 128

N_HEADS_A = 8
N_KV_A = 2
Q_PER_KV = N_HEADS_A // N_KV_A
HEAD_DIM_A = 64
WINDOW = 128
ATTN_WIDTH = N_HEADS_A * HEAD_DIM_A
KV_WIDTH = N_KV_A * HEAD_DIM_A
D_INNER = D_MODEL
HEAD_DIM_M = 64
N_HEADS_M = D_INNER // HEAD_DIM_M
N_GROUPS_M = 2
HEADS_PER_GROUP = N_HEADS_M // N_GROUPS_M
D_STATE = 128
CONV_W = 4
CONV_DIM = D_INNER + 2 * N_GROUPS_M * D_STATE
CHUNK = 128
D_FF = 4 * D_MODEL
EPS = 1e-6
IN_WIDTH = ATTN_WIDTH + 2 * KV_WIDTH + D_INNER + CONV_DIM + N_HEADS_M + 2 * D_MODEL

kernel_name = "hybrid_swa_sink_mamba2_gated_step"


def _rmsnorm(x, w):
    xf = x.astype(jnp.float32)
    y = xf * lax.rsqrt(jnp.mean(xf * xf, axis=-1, keepdims=True) + EPS)
    return (y * w.astype(jnp.float32)).astype(x.dtype)


def _split(u):
    sizes = (ATTN_WIDTH, KV_WIDTH, KV_WIDTH, D_INNER, CONV_DIM, N_HEADS_M, D_MODEL, D_MODEL)
    out = []
    off = 0
    for s in sizes:
        out.append(u[..., off:off + s])
        off += s
    return out


def _sink_attend(q, k, v, mask, sinks):
    scale = HEAD_DIM_A ** -0.5
    s = jnp.einsum("bnqkgd,bnskd->bnkgqs", q, k).astype(jnp.float32) * scale
    s = jnp.where(mask[None, :, None, None], s, -jnp.inf)
    sk = jnp.broadcast_to(sinks.astype(jnp.float32).reshape(N_KV_A, Q_PER_KV, 1, 1), s.shape[:-1] + (1,))
    p = jax.nn.softmax(jnp.concatenate([s, sk], axis=-1), axis=-1)[..., :-1]
    return jnp.einsum("bnkgqs,bnskd->bnqkgd", p.astype(v.dtype), v)


def _swa_prompt(q, k, v, sinks):
    b, L = q.shape[:2]
    nb = L // WINDOW
    qb = q.reshape(b, nb, WINDOW, N_KV_A, Q_PER_KV, HEAD_DIM_A)
    kb = k.reshape(b, nb, WINDOW, N_KV_A, HEAD_DIM_A)
    vb = v.reshape(b, nb, WINDOW, N_KV_A, HEAD_DIM_A)
    padw = ((0, 0), (1, 0), (0, 0), (0, 0), (0, 0))
    kk = jnp.concatenate([jnp.pad(kb, padw)[:, :-1], kb], axis=2)
    vv = jnp.concatenate([jnp.pad(vb, padw)[:, :-1], vb], axis=2)
    qpos = jnp.arange(nb)[:, None] * WINDOW + jnp.arange(WINDOW)[None]
    kpos = (jnp.arange(nb)[:, None] - 1) * WINDOW + jnp.arange(2 * WINDOW)[None]
    d = qpos[:, :, None] - kpos[:, None, :]
    mask = (d >= 0) & (d <= WINDOW) & (kpos[:, None, :] >= 0)
    o = _sink_attend(qb, kk, vv, mask, sinks)
    return o.reshape(b, L, ATTN_WIDTH), k[:, -WINDOW:], v[:, -WINDOW:]


def _swa_sample(q, k, v, k_buf, v_buf, sinks):
    b, L = q.shape[:2]
    kk = jnp.concatenate([k_buf, k], axis=1)
    vv = jnp.concatenate([v_buf, v], axis=1)
    qpos = WINDOW + jnp.arange(L)
    kpos = jnp.arange(WINDOW + L)
    d = qpos[:, None] - kpos[None, :]
    mask = ((d >= 0) & (d <= WINDOW))[None]
    o = _sink_attend(q[:, None], kk[:, None], vv[:, None], mask, sinks)
    return o.reshape(b, L, ATTN_WIDTH), kk[:, -WINDOW:], vv[:, -WINDOW:]


def _causal_conv(xbc, prev, w, bias):
    L = xbc.shape[1]
    xp = jnp.concatenate([prev, xbc], axis=1)
    y = xp[:, 0:L] * w[0]
    for i in range(1, CONV_W):
        y = y + xp[:, i:i + L] * w[i]
    return jax.nn.silu(y + bias), xp[:, -(CONV_W - 1):]


def _segsum_exp(a_cs):
    T = a_cs.shape[-1]
    diff = a_cs[..., :, None] - a_cs[..., None, :]
    mask = jnp.tril(jnp.ones((T, T), dtype=bool))
    return jnp.exp(jnp.where(mask, diff, -jnp.inf))


def _ssd(xh, dt, a, bmat, cmat, h0):
    b, L = xh.shape[:2]
    T = CHUNK if L >= CHUNK else L
    Lp = -(-L // T) * T
    pad = Lp - L
    xf = xh.astype(jnp.float32)
    bf = bmat.astype(jnp.float32)
    cf = cmat.astype(jnp.float32)
    if pad:
        xf = jnp.pad(xf, ((0, 0), (0, pad), (0, 0), (0, 0)))
        dt = jnp.pad(dt, ((0, 0), (0, pad), (0, 0)))
        bf = jnp.pad(bf, ((0, 0), (0, pad), (0, 0), (0, 0)))
        cf = jnp.pad(cf, ((0, 0), (0, pad), (0, 0), (0, 0)))
    nc = Lp // T
    G, HG = N_GROUPS_M, HEADS_PER_GROUP
    x = (xf * dt[..., None]).reshape(b, nc, T, G, HG, HEAD_DIM_M)
    a_cs = jnp.cumsum((dt * a).reshape(b, nc, T, G, HG).transpose(0, 1, 3, 4, 2), axis=-1)
    Bc = bf.reshape(b, nc, T, G, D_STATE)
    Cc = cf.reshape(b, nc, T, G, D_STATE)
    cb = jnp.einsum("bclgn,bcsgn->bcgls", Cc, Bc)
    wmat = cb[:, :, :, None] * _segsum_exp(a_cs)
    y_diag = jnp.einsum("bcghls,bcsghp->bclghp", wmat, x)
    decay = jnp.exp(a_cs[..., -1:] - a_cs)
    st = jnp.einsum("bclgn,bcghl,bclghp->bcghpn", Bc, decay, x)
    chunk_decay = jnp.exp(a_cs[..., -1])

    def step(h, inp):
        s_c, d_c = inp
        return h * d_c[..., None, None] + s_c, h

    h_init = h0.astype(jnp.float32).reshape(b, G, HG, HEAD_DIM_M, D_STATE)
    h_last, h_in = lax.scan(step, h_init, (st.transpose(1, 0, 2, 3, 4, 5), chunk_decay.transpose(1, 0, 2, 3)))
    h_in = h_in.transpose(1, 0, 2, 3, 4, 5)
    y_off = jnp.einsum("bclgn,bcghpn,bcghl->bclghp", Cc, h_in, jnp.exp(a_cs))
    y = (y_diag + y_off).reshape(b, Lp, N_HEADS_M, HEAD_DIM_M)[:, :L]
    return y.astype(xh.dtype), h_last.reshape(b, N_HEADS_M, HEAD_DIM_M, D_STATE).astype(h0.dtype)


def _mamba_branch(z, xbc, dt_raw, conv_prev, ssm_prev, conv_w, conv_b, dt_bias, a_log, d_skip, ssm_norm):
    b, L = z.shape[:2]
    xbc, conv_new = _causal_conv(xbc, conv_prev, conv_w, conv_b)
    xs = xbc[..., :D_INNER]
    bm = xbc[..., D_INNER:D_INNER + N_GROUPS_M * D_STATE].reshape(b, L, N_GROUPS_M, D_STATE)
    cm = xbc[..., D_INNER + N_GROUPS_M * D_STATE:].reshape(b, L, N_GROUPS_M, D_STATE)
    xh = xs.reshape(b, L, N_HEADS_M, HEAD_DIM_M)
    dt = jax.nn.softplus(dt_raw.astype(jnp.float32) + dt_bias.astype(jnp.float32))
    a = -jnp.exp(a_log.astype(jnp.float32))
    y, ssm_new = _ssd(xh, dt, a, bm, cm, ssm_prev)
    y = (y + xh * d_skip[:, None]).reshape(b, L, D_INNER) * jax.nn.silu(z)
    yg = y.astype(jnp.float32).reshape(b, L, N_GROUPS_M, D_INNER // N_GROUPS_M)
    yg = yg * lax.rsqrt(jnp.mean(yg * yg, axis=-1, keepdims=True) + EPS)
    y = (yg.reshape(b, L, D_INNER) * ssm_norm.astype(jnp.float32)).astype(z.dtype)
    return y, conv_new, ssm_new


def _block(x, k_buf, v_buf, conv_prev, ssm_prev, norm1, w_in, sinks, conv_w, conv_b, dt_bias, a_log,
           d_skip, ssm_norm, w_oa, w_ob, w_o, norm2, w_up, w_down):
    b, L, _ = x.shape
    h = _rmsnorm(x, norm1)
    q, k, v, z, xbc, dt_raw, g_a, g_b = _split(h @ w_in)
    q = q.reshape(b, L, N_KV_A, Q_PER_KV, HEAD_DIM_A)
    k = k.reshape(b, L, N_KV_A, HEAD_DIM_A)
    v = v.reshape(b, L, N_KV_A, HEAD_DIM_A)
    if k_buf is None:
        a_out, k_new, v_new = _swa_prompt(q, k, v, sinks)
    else:
        a_out, k_new, v_new = _swa_sample(q, k, v, k_buf, v_buf, sinks)
    m_out, conv_new, ssm_new = _mamba_branch(z, xbc, dt_raw, conv_prev, ssm_prev, conv_w, conv_b,
                                             dt_bias, a_log, d_skip, ssm_norm)
    merged = jax.nn.sigmoid(g_a) * (a_out @ w_oa) + jax.nn.sigmoid(g_b) * (m_out @ w_ob)
    x = x + merged @ w_o
    hm = _rmsnorm(x, norm2)
    x = x + jnp.square(jax.nn.relu(hm @ w_up)) @ w_down
    return x, k_new, v_new, conv_new, ssm_new


def setup_inputs(seed: int = 0) -> dict:
    key = jax.random.key(seed)
    ks = jax.random.split(key, 24)
    f32 = jnp.float32
    nrm = lambda k, shape, s: jax.random.normal(k, shape, f32) * s
    dt0 = jnp.exp(jax.random.uniform(ks[10], (DEPTH, N_HEADS_M), f32, np.log(1e-3), np.log(1e-1)))
    return {
        "x_prompt": nrm(ks[0], (BATCH, SEQ, D_MODEL), 1.0),
        "x_sample": nrm(ks[1], (DEC_BATCH, DEC_SEQ, D_MODEL), 1.0),
        "cache_swa_k": nrm(ks[2], (DEPTH, DEC_BATCH, WINDOW, N_KV_A, HEAD_DIM_A), 1.0),
        "cache_swa_v": nrm(ks[3], (DEPTH, DEC_BATCH, WINDOW, N_KV_A, HEAD_DIM_A), 1.0),
        "state_conv": nrm(ks[4], (DEPTH, DEC_BATCH, CONV_W - 1, CONV_DIM), 1.0),
        "state_ssm": nrm(ks[5], (DEPTH, DEC_BATCH, N_HEADS_M, HEAD_DIM_M, D_STATE), 0.1),
        "norm1": 1.0 + nrm(ks[6], (DEPTH, D_MODEL), 0.05),
        "w_in": nrm(ks[7], (DEPTH, D_MODEL, IN_WIDTH), D_MODEL ** -0.5),
        "sinks": nrm(ks[8], (DEPTH, N_HEADS_A), 0.5),
        "conv_w": nrm(ks[9], (DEPTH, CONV_W, CONV_DIM), CONV_W ** -0.5),
        "conv_b": nrm(ks[11], (DEPTH, CONV_DIM), 0.01),
        "dt_bias": dt0 + jnp.log(-jnp.expm1(-dt0)),
        "a_log": jnp.log(jax.random.uniform(ks[12], (DEPTH, N_HEADS_M), f32, 1.0, 16.0)),
        "d_skip": 1.0 + nrm(ks[13], (DEPTH, N_HEADS_M), 0.1),
        "ssm_norm": 1.0 + nrm(ks[14], (DEPTH, D_INNER), 0.05),
        "w_oa": nrm(ks[15], (DEPTH, ATTN_WIDTH, D_MODEL), ATTN_WIDTH ** -0.5),
        "w_ob": nrm(ks[16], (DEPTH, D_INNER, D_MODEL), D_INNER ** -0.5),
        "w_o": nrm(ks[17], (DEPTH, D_MODEL, D_MODEL), D_MODEL ** -0.5),
        "norm2": 1.0 + nrm(ks[18], (DEPTH, D_MODEL), 0.05),
        "w_up": nrm(ks[19], (DEPTH, D_MODEL, D_FF), D_MODEL ** -0.5),
        "w_down": nrm(ks[20], (DEPTH, D_FF, D_MODEL), D_FF ** -0.5),
        "final_norm": 1.0 + nrm(ks[21], (D_MODEL,), 0.05),
    }


def reference(x_prompt, x_sample, cache_swa_k, cache_swa_v, state_conv, state_ssm, norm1, w_in, sinks,
              conv_w, conv_b, dt_bias, a_log, d_skip, ssm_norm, w_oa, w_ob, w_o, norm2, w_up, w_down,
              final_norm):
    xp, xs = x_prompt, x_sample
    pk, pv, pc, ps = [], [], [], []
    sk, sv, sc, ss = [], [], [], []
    bp = x_prompt.shape[0]
    for l in range(DEPTH):
        w = (norm1[l], w_in[l], sinks[l], conv_w[l], conv_b[l], dt_bias[l], a_log[l], d_skip[l],
             ssm_norm[l], w_oa[l], w_ob[l], w_o[l], norm2[l], w_up[l], w_down[l])
        conv0 = jnp.zeros((bp, CONV_W - 1, CONV_DIM), xp.dtype)
        ssm0 = jnp.zeros((bp, N_HEADS_M, HEAD_DIM_M, D_STATE), state_ssm.dtype)
        xp, k1, v1, c1, s1 = _block(xp, None, None, conv0, ssm0, *w)
        xs, k2, v2, c2, s2 = _block(xs, cache_swa_k[l], cache_swa_v[l], state_conv[l], state_ssm[l], *w)
        pk.append(k1); pv.append(v1); pc.append(c1); ps.append(s1)
        sk.append(k2); sv.append(v2); sc.append(c2); ss.append(s2)
    y_prompt = _rmsnorm(xp, final_norm)
    y_sample = _rmsnorm(xs, final_norm)
    return (y_prompt, y_sample, jnp.stack(pk), jnp.stack(pv), jnp.stack(pc), jnp.stack(ps),
            jnp.stack(sk), jnp.stack(sv), jnp.stack(sc), jnp.stack(ss))
```

```cpp
#include <hip/hip_runtime.h>
#include <hip/hip_cooperative_groups.h>
#include <cstdio>
#include <cstdint>
namespace cg = cooperative_groups;

#define LAS __attribute__((address_space(3)))
typedef unsigned short bf16_t;
typedef short bf16x8 __attribute__((ext_vector_type(8)));
typedef float f32x4 __attribute__((ext_vector_type(4)));
typedef float f32x2 __attribute__((ext_vector_type(2)));
typedef unsigned u32x4 __attribute__((ext_vector_type(4)));
typedef unsigned u32x2 __attribute__((ext_vector_type(2)));

constexpr int DM = 1024, MP = 16384, MS = 512, M = MP + MS, SEQ = 2048, NBATCH = 8, DBATCH = 128;
constexpr int INW = 5392, NPAD = 5632, DFF = 4096, CONVD = 1536;
constexpr int OQ = 0, OKK = 512, OV = 640, OZ = 768, OX = 1792, ODT = 3328, OGA = 3344, OGB = 4368;
constexpr float EPS = 1e-6f;
constexpr size_t O_YP = 0, O_YS = 16777216, O_KP = 17301504, O_VP = 17432576, O_CP = 17563648, O_SP = 17600512,
                 O_KS = 18649088, O_VS = 20746240, O_CS = 22843392, O_SS = 23433216;
constexpr size_t MiB = 1u << 20;
constexpr size_t WS_RSTD1 = 0, WS_SSQ2 = 128 * 1024, WS_SSQF = 256 * 1024, WS_CD = 384 * 1024, WS_BAR = 512 * 1024;
constexpr size_t WS_WIN = 1 * MiB, WS_WOA = 12 * MiB, WS_WOB = 13 * MiB, WS_WO = 15 * MiB, WS_DT = 17 * MiB;
constexpr size_t WS_U = 20 * MiB;
constexpr size_t WS_X1B = 20 * MiB, WS_ACT = 54 * MiB;
constexpr size_t WS_XC = 194 * MiB;
constexpr size_t WS_MERGED = 194 * MiB, WS_WUP = 227 * MiB, WS_WDN = 235 * MiB;
constexpr int LDS_BYTES = 163840;

__device__ __forceinline__ int opaque(int x) { asm volatile("" : "+v"(x)); return x; }
__device__ __forceinline__ unsigned f2bf(float f) { unsigned u = __builtin_bit_cast(unsigned, f); return (u + 0x7fffu + ((u >> 16) & 1u)) >> 16; }
__device__ __forceinline__ unsigned pk2(float lo, float hi) { return f2bf(lo) | (f2bf(hi) << 16); }
__device__ __forceinline__ unsigned cvt_pk_bf16(float lo, float hi) { unsigned r; asm volatile("v_cvt_pk_bf16_f32 %0, %1, %2" : "=v"(r) : "v"(lo), "v"(hi)); return r; }
__device__ __forceinline__ float bflo(unsigned w) { return __builtin_bit_cast(float, w << 16); }
__device__ __forceinline__ float bfhi(unsigned w) { return __builtin_bit_cast(float, w & 0xffff0000u); }
__device__ __forceinline__ float bf1(bf16_t h) { return __builtin_bit_cast(float, (unsigned)h << 16); }
__device__ __forceinline__ float sigmoidf_(float x) { return 1.f / (1.f + __expf(-x)); }
__device__ __forceinline__ float siluf_(float x) { return x / (1.f + __expf(-x)); }
__device__ __forceinline__ float wave_sum(float v) {
#pragma unroll
    for (int o = 1; o < 64; o <<= 1) v += __shfl_xor(v, o);
    return v;
}
#define LDS_WAIT() asm volatile("s_waitcnt lgkmcnt(0)" ::: "memory")
#define MFMA16(a, b, c) __builtin_amdgcn_mfma_f32_16x16x32_bf16(a, b, c, 0, 0, 0)

namespace pg8 {
constexpr int BM = 256, BK = 64, HALF = 128, HTB = HALF * BK * 2, STAGE_BYTES = 8 * HTB, NXCD = 8, WGM = 8;
__host__ __device__ __forceinline__ int lds_byte(int r, int c) { const int st = (r >> 4) * 2 + (c >> 5), rr = r & 15, cc = c & 31, ob = rr * 64 + cc * 2; return st * 1024 + (ob ^ (((ob >> 9) & 1) << 5)); }
__host__ __device__ __forceinline__ void stage_rc(int b, int& R, int& C) { const int st = b / 1024, sb = b % 1024, swz = sb ^ (((sb >> 9) & 1) << 5); R = (st >> 1) * 16 + swz / 64; C = (st & 1) * 32 + (swz % 64) / 2; }
__host__ __device__ __forceinline__ int perm32(int rho) { const int n = rho >> 4, i = rho & 15; return 8 * (i >> 2) + 4 * n + (i & 3); }
struct Unit { int pm, pn; };
struct Gemm { const bf16_t* A; const bf16_t* Bt; int M, N, K, lda, ldb; };
struct StaticOrder {
    int nM, nN, nwg, G, c;
    __device__ void init(int M_, int N_, int G_, int c_) { nM = M_ / BM; nN = N_ / BM; nwg = nM * nN; G = G_; c = c_; }
    __device__ bool next(int i, Unit& u) const {
        const long L = (long)i * G + c; if (L >= nwg) return false;
        int wgid = (int)L; { const int q = nwg / NXCD, r = nwg % NXCD, xcd = wgid % NXCD, off = wgid / NXCD; wgid = (xcd < r ? xcd * (q + 1) : r * (q + 1) + (xcd - r) * q) + off; }
        const int nig = WGM * nN, gid = wgid / nig, fm = gid * WGM, gsz = (nM - fm) < WGM ? (nM - fm) : WGM;
        u.pm = fm + ((wgid % nig) % gsz); u.pn = (wgid % nig) / gsz; return true;
    }
};
template <class Epi>
__device__ __forceinline__ void gemm_phase(LAS unsigned char* lds, const Gemm g, const StaticOrder& S, const Epi& E) {
    const int tid = opaque((int)threadIdx.x), wid = __builtin_amdgcn_readfirstlane(tid >> 6), lane = tid & 63, wr = wid >> 2, wc = wid & 3, fr = lane & 15, fq = lane >> 4;
    const int K = g.K, nt = K / BK;
    unsigned voffA[2], voffB[2];
#pragma unroll
    for (int i = 0; i < 2; ++i) { int R, C; stage_rc(tid * 16 + i * 8192, R, C); const int Rb = (R & ~31) + perm32(R & 31);
        voffA[i] = (unsigned)(R * g.lda + C) * 2u; voffB[i] = (unsigned)(Rb * g.ldb + C) * 2u; }
    const size_t kstep = (size_t)(BK * 2);
    const size_t hstepA = (size_t)HALF * g.lda * 2, hstepB = (size_t)HALF * g.ldb * 2;
    const size_t tstepA = 2 * hstepA, tstepB = 2 * hstepB;
    const unsigned ldsw = (unsigned)wid * 1024u;
    const int aoff = lds_byte(wr * 64 + fr, fq * 8), boff = lds_byte(wc * 32 + fr, fq * 8);
#define PG8_SA(b, h) (((b) * 2 + (h)) * HTB)
#define PG8_SB(b, h) ((4 + (b) * 2 + (h)) * HTB)
#define PG8_STAGE(bufoff, gbase, voff) do { _Pragma("unroll") for (int _i = 0; _i < 2; ++_i) \
        __builtin_amdgcn_global_load_lds((const unsigned*)((const char*)(gbase) + (voff)[_i]), (LAS unsigned*)(lds + (bufoff) + ldsw + _i * 8192), 16, 0, 0); } while (0)
#define PG8_LDA(dst, b, h) do { _Pragma("unroll") for (int m = 0; m < 4; ++m) _Pragma("unroll") for (int k = 0; k < 2; ++k) dst[m][k] = *(const LAS bf16x8*)(lds + PG8_SA(b, h) + aoff + m * 2048 + k * 1024); } while (0)
#define PG8_LDB(dst, b, h) do { _Pragma("unroll") for (int n = 0; n < 2; ++n) _Pragma("unroll") for (int k = 0; k < 2; ++k) dst[n][k] = *(const LAS bf16x8*)(lds + PG8_SB(b, h) + boff + n * 2048 + k * 1024); } while (0)
#define PG8_MMA(ai, bj, At, Bt) do { __builtin_amdgcn_s_setprio(1); _Pragma("unroll") for (int m = 0; m < 4; ++m) _Pragma("unroll") for (int n = 0; n < 2; ++n) _Pragma("unroll") for (int k = 0; k < 2; ++k) \
        acc[ai][bj][m][n] = __builtin_amdgcn_mfma_f32_16x16x32_bf16(Bt[n][k], At[m][k], acc[ai][bj][m][n], 0, 0, 0); __builtin_amdgcn_s_setprio(0); } while (0)
#define PG8_WAIT_V(n) asm volatile("s_waitcnt vmcnt(" #n ")" ::: "memory")
#define PG8_WAIT_L(n) asm volatile("s_waitcnt lgkmcnt(" #n ")" ::: "memory")
#define PG8_BAR __builtin_amdgcn_s_barrier()
#define PG8_SCHED __builtin_amdgcn_sched_barrier(0)
    Unit cur, nxt; int ui = 0;
    if (!S.next(0, cur)) return;
    f32x4 acc[2][2][4][2];
#pragma unroll
    for (int a = 0; a < 2; ++a)
#pragma unroll
        for (int b = 0; b < 2; ++b)
#pragma unroll
            for (int m = 0; m < 4; ++m)
#pragma unroll
                for (int n = 0; n < 2; ++n) acc[a][b][m][n] = (f32x4){0.f, 0.f, 0.f, 0.f};
    bf16x8 At[4][2], B0[2][2], B1[2][2];
    const char* cA = (const char*)g.A + (size_t)cur.pm * tstepA; const char* cB = (const char*)g.Bt + (size_t)cur.pn * tstepB;
    PG8_STAGE(PG8_SB(0, 0), cB, voffB); PG8_STAGE(PG8_SB(0, 1), cB + hstepB, voffB); PG8_STAGE(PG8_SA(0, 0), cA, voffA); PG8_STAGE(PG8_SA(0, 1), cA + hstepA, voffA);
    if (wr == 1) PG8_BAR;
    PG8_WAIT_V(2); PG8_BAR;
    PG8_STAGE(PG8_SB(1, 0), cB + kstep, voffB); PG8_STAGE(PG8_SA(1, 0), cA + kstep, voffA); PG8_STAGE(PG8_SB(1, 1), cB + hstepB + kstep, voffB);
    PG8_WAIT_V(6); PG8_BAR;
    for (;;) {
        const bool has_next = S.next(ui + 1, nxt);
        const char* nA = has_next ? (const char*)g.A + (size_t)nxt.pm * tstepA : cA; const char* nB = has_next ? (const char*)g.Bt + (size_t)nxt.pn * tstepB : cB;
        for (int t = 0; t < nt; t += 2) {
            const bool last = (t == nt - 2);
            const char* a1 = cA + (size_t)(t + 1) * kstep;
            const char* a2 = last ? nA : cA + (size_t)(t + 2) * kstep; const char* b2 = last ? nB : cB + (size_t)(t + 2) * kstep;
            const char* a3 = a2 + kstep; const char* b3 = b2 + kstep;
            PG8_LDB(B0, 0, 0); PG8_LDB(B1, 0, 1); PG8_SCHED; PG8_LDA(At, 0, 0); PG8_STAGE(PG8_SA(1, 1), a1 + hstepA, voffA);
            PG8_WAIT_V(8); PG8_WAIT_L(0); PG8_BAR; PG8_MMA(0, 0, At, B0); PG8_MMA(0, 1, At, B1); PG8_BAR; PG8_SCHED;
            PG8_LDA(At, 0, 1); PG8_STAGE(PG8_SB(0, 0), b2, voffB); PG8_STAGE(PG8_SB(0, 1), b2 + hstepB, voffB); PG8_STAGE(PG8_SA(0, 0), a2, voffA);
            PG8_WAIT_V(8); PG8_WAIT_L(0); PG8_BAR; PG8_MMA(1, 0, At, B0); PG8_MMA(1, 1, At, B1); PG8_BAR; PG8_SCHED;
            PG8_LDB(B0, 1, 0); PG8_LDB(B1, 1, 1); PG8_SCHED; PG8_LDA(At, 1, 0); PG8_STAGE(PG8_SA(0, 1), a2 + hstepA, voffA);
            PG8_WAIT_V(8); PG8_WAIT_L(0); PG8_BAR; PG8_MMA(0, 0, At, B0); PG8_MMA(0, 1, At, B1); PG8_BAR; PG8_SCHED;
            PG8_LDA(At, 1, 1); PG8_STAGE(PG8_SB(1, 0), b3, voffB); PG8_STAGE(PG8_SB(1, 1), b3 + hstepB, voffB); PG8_STAGE(PG8_SA(1, 0), a3, voffA);
            PG8_WAIT_V(8); PG8_WAIT_L(0); PG8_BAR; PG8_MMA(1, 0, At, B0); PG8_MMA(1, 1, At, B1); PG8_BAR; PG8_SCHED;
        }
        if (wr == 0) PG8_BAR;
        E(acc, cur, wr, wc, fr, fq);
        if (!has_next) break;
#pragma unroll
        for (int a = 0; a < 2; ++a)
#pragma unroll
            for (int b = 0; b < 2; ++b)
#pragma unroll
                for (int m = 0; m < 4; ++m)
#pragma unroll
                    for (int n = 0; n < 2; ++n) acc[a][b][m][n] = (f32x4){0.f, 0.f, 0.f, 0.f};
        cur = nxt; cA = nA; cB = nB; ++ui;
        if (wr == 1) PG8_BAR;
    }
    PG8_WAIT_V(0);
    PG8_BAR;
#undef PG8_SA
#undef PG8_SB
#undef PG8_STAGE
#undef PG8_LDA
#undef PG8_LDB
#undef PG8_MMA
#undef PG8_WAIT_V
#undef PG8_WAIT_L
#undef PG8_BAR
#undef PG8_SCHED
}
}
typedef f32x4 AccT[2][2][4][2];
#define EPI_LOOP_ROWS for (int ai = 0; ai < 2; ++ai) _Pragma("unroll") for (int m = 0; m < 4; ++m)

struct EpiIn {
    static constexpr bool PERM = true;
    bf16_t* U; float* DT; const float* rstd; const float* dtb;
    __device__ __forceinline__ void operator()(const AccT& acc, const pg8::Unit& u, int wr, int wc, int fr, int fq) const {
#pragma unroll
        EPI_LOOP_ROWS {
            const int row = u.pm * 256 + ai * 128 + wr * 64 + m * 16 + fr; const float rs = rstd[row]; bf16_t* rowp = U + (size_t)row * INW;
#pragma unroll
            for (int bj = 0; bj < 2; ++bj) { const int col0 = u.pn * 256 + bj * 128 + wc * 32 + 8 * fq;
                if (col0 < INW) { const f32x4 v0 = acc[ai][bj][m][0] * rs, v1 = acc[ai][bj][m][1] * rs;
                    u32x4 w; w.x = cvt_pk_bf16(v0[0], v0[1]); w.y = cvt_pk_bf16(v0[2], v0[3]); w.z = cvt_pk_bf16(v1[0], v1[1]); w.w = cvt_pk_bf16(v1[2], v1[3]);
                    *(u32x4*)(rowp + col0) = w;
                    if (col0 >= ODT && col0 < ODT + 16) { const int d0 = col0 - ODT; float* dp = DT + (size_t)row * 16 + d0;
#pragma unroll
                        for (int i = 0; i < 4; ++i) { float x = v0[i] + dtb[d0 + i]; dp[i] = x > 20.f ? x : log1pf(__expf(x)); x = v1[i] + dtb[d0 + 4 + i]; dp[4 + i] = x > 20.f ? x : log1pf(__expf(x)); } } } }
        }
    }
};
template <int SECOND> struct EpiGate {
    static constexpr bool PERM = true;
    const bf16_t* U; bf16_t* MG;
    __device__ __forceinline__ void operator()(const AccT& acc, const pg8::Unit& u, int wr, int wc, int fr, int fq) const {
#pragma unroll
        EPI_LOOP_ROWS {
            const int row = u.pm * 256 + ai * 128 + wr * 64 + m * 16 + fr; const bf16_t* gp = U + (size_t)row * INW + (SECOND ? OGB : OGA); bf16_t* op = MG + (size_t)row * DM;
#pragma unroll
            for (int bj = 0; bj < 2; ++bj) { const int col0 = u.pn * 256 + bj * 128 + wc * 32 + 8 * fq;
                const u32x4 gv = *(const u32x4*)(gp + col0); const f32x4 a0 = acc[ai][bj][m][0], a1 = acc[ai][bj][m][1];
                float r[8];
                r[0] = sigmoidf_(bflo(gv.x)) * a0[0]; r[1] = sigmoidf_(bfhi(gv.x)) * a0[1]; r[2] = sigmoidf_(bflo(gv.y)) * a0[2]; r[3] = sigmoidf_(bfhi(gv.y)) * a0[3];
                r[4] = sigmoidf_(bflo(gv.z)) * a1[0]; r[5] = sigmoidf_(bfhi(gv.z)) * a1[1]; r[6] = sigmoidf_(bflo(gv.w)) * a1[2]; r[7] = sigmoidf_(bfhi(gv.w)) * a1[3];
                if (SECOND) { const u32x4 pv = *(const u32x4*)(op + col0);
                    r[0] += bflo(pv.x); r[1] += bfhi(pv.x); r[2] += bflo(pv.y); r[3] += bfhi(pv.y); r[4] += bflo(pv.z); r[5] += bfhi(pv.z); r[6] += bflo(pv.w); r[7] += bfhi(pv.w); }
                u32x4 w; w.x = cvt_pk_bf16(r[0], r[1]); w.y = cvt_pk_bf16(r[2], r[3]); w.z = cvt_pk_bf16(r[4], r[5]); w.w = cvt_pk_bf16(r[6], r[7]);
                *(u32x4*)(op + col0) = w; }
        }
    }
};
template <int WITH_BF> struct EpiRes {
    static constexpr bool PERM = true;
    const float* base_p; const float* base_s; float* X; bf16_t* XB; float* ssq;
    __device__ __forceinline__ void operator()(const AccT& acc, const pg8::Unit& u, int wr, int wc, int fr, int fq) const {
#pragma unroll
        EPI_LOOP_ROWS {
            const int row = u.pm * 256 + ai * 128 + wr * 64 + m * 16 + fr;
            const float* bp = row < MP ? base_p + (size_t)row * DM : base_s + (size_t)(row - MP) * DM; float* xp = X + (size_t)row * DM;
            float ss = 0.f;
#pragma unroll
            for (int bj = 0; bj < 2; ++bj) { const int col0 = u.pn * 256 + bj * 128 + wc * 32 + 8 * fq;
                const f32x4 b0 = *(const f32x4*)(bp + col0), b1 = *(const f32x4*)(bp + col0 + 4);
                const f32x4 v0 = b0 + acc[ai][bj][m][0], v1 = b1 + acc[ai][bj][m][1];
                *(f32x4*)(xp + col0) = v0; *(f32x4*)(xp + col0 + 4) = v1;
                ss += (v0[0] * v0[0] + v0[1] * v0[1]) + (v0[2] * v0[2] + v0[3] * v0[3]) + (v1[0] * v1[0] + v1[1] * v1[1]) + (v1[2] * v1[2] + v1[3] * v1[3]);
                if (WITH_BF) { u32x4 w; w.x = cvt_pk_bf16(v0[0], v0[1]); w.y = cvt_pk_bf16(v0[2], v0[3]); w.z = cvt_pk_bf16(v1[0], v1[1]); w.w = cvt_pk_bf16(v1[2], v1[3]);
                    *(u32x4*)(XB + (size_t)row * DM + col0) = w; } }
            ss += __shfl_xor(ss, 16); ss += __shfl_xor(ss, 32);
            if (fq == 0) atomicAdd(ssq + row, ss);
        }
    }
};
struct EpiUp {
    static constexpr bool PERM = true;
    const float* ssq2; bf16_t* ACT;
    __device__ __forceinline__ void operator()(const AccT& acc, const pg8::Unit& u, int wr, int wc, int fr, int fq) const {
#pragma unroll
        EPI_LOOP_ROWS {
            const int row = u.pm * 256 + ai * 128 + wr * 64 + m * 16 + fr; const float rs = rsqrtf(ssq2[row] * (1.f / DM) + EPS); bf16_t* op = ACT + (size_t)row * DFF;
#pragma unroll
            for (int bj = 0; bj < 2; ++bj) { const int col0 = u.pn * 256 + bj * 128 + wc * 32 + 8 * fq;
                f32x4 v0 = acc[ai][bj][m][0] * rs, v1 = acc[ai][bj][m][1] * rs;
#pragma unroll
                for (int i = 0; i < 4; ++i) { const float a = fmaxf(v0[i], 0.f), b = fmaxf(v1[i], 0.f); v0[i] = a * a; v1[i] = b * b; }
                u32x4 w; w.x = cvt_pk_bf16(v0[0], v0[1]); w.y = cvt_pk_bf16(v0[2], v0[3]); w.z = cvt_pk_bf16(v1[0], v1[1]); w.w = cvt_pk_bf16(v1[2], v1[3]);
                *(u32x4*)(op + col0) = w; }
        }
    }
};

__device__ __forceinline__ void transpose_item(const float* W, int K, int N, const float* scale, bf16_t* WT, LAS float* scr, int item, int nblk, int lane) {
    const int kb = item / nblk, nb = item % nblk, k0 = 64 * kb, n0 = 32 * nb;
    const int n = n0 + (lane & 31);
#pragma unroll 8
    for (int i = 0; i < 32; ++i) { const int kk = 2 * i + (lane >> 5); float v = 0.f; if (n < N) { v = W[(size_t)(k0 + kk) * N + n]; if (scale) v *= scale[k0 + kk]; } scr[kk * 33 + (lane & 31)] = v; }
    LDS_WAIT();
    const int c = lane & 7;
#pragma unroll
    for (int j = 0; j < 4; ++j) { const int nn = (lane >> 3) + 8 * j; const LAS float* s = scr + (8 * c) * 33 + nn;
        u32x4 o; o.x = pk2(s[0 * 33], s[1 * 33]); o.y = pk2(s[2 * 33], s[3 * 33]); o.z = pk2(s[4 * 33], s[5 * 33]); o.w = pk2(s[6 * 33], s[7 * 33]);
        *(u32x4*)(WT + (size_t)(n0 + nn) * K + k0 + 8 * c) = o; }
    LDS_WAIT();
}

constexpr int KS_LD = 72, VT_LD = 280;
__device__ __forceinline__ void attn_tile(const LAS bf16_t* Ks, const LAS bf16_t* Vt, bf16_t* qptr, int kt0, int rq, int kmin, float sink, int lane) {
    const int c16 = lane & 15, quad = lane >> 4;
    bf16x8 qf[2];
    qf[0] = *(const bf16x8*)(qptr + quad * 8); qf[1] = *(const bf16x8*)(qptr + 32 + quad * 8);
    f32x4 s[10];
#pragma unroll
    for (int j = 0; j < 10; ++j) { s[j] = (f32x4){0.f, 0.f, 0.f, 0.f};
#pragma unroll
        for (int ks = 0; ks < 2; ++ks) { const bf16x8 kf = *(const LAS bf16x8*)(Ks + ((kt0 + j) * 16 + c16) * KS_LD + ks * 32 + quad * 8); s[j] = MFMA16(kf, qf[ks], s[j]); } }
    float mx = sink;
#pragma unroll
    for (int j = 0; j < 10; ++j)
#pragma unroll
        for (int jj = 0; jj < 4; ++jj) { const int kidx = (kt0 + j) * 16 + quad * 4 + jj; const bool ok = (kidx >= rq) && (kidx <= rq + 128) && (kidx >= kmin);
            const float v = ok ? s[j][jj] * 0.125f : -INFINITY; s[j][jj] = v; mx = fmaxf(mx, v); }
    mx = fmaxf(mx, __shfl_xor(mx, 16)); mx = fmaxf(mx, __shfl_xor(mx, 32));
    float sum = 0.f;
#pragma unroll
    for (int j = 0; j < 10; ++j)
#pragma unroll
        for (int jj = 0; jj < 4; ++jj) { const float p = __expf(s[j][jj] - mx); s[j][jj] = p; sum += p; }
    sum += __shfl_xor(sum, 16); sum += __shfl_xor(sum, 32); sum += __expf(sink - mx);
    const float inv = 1.f / sum;
    f32x4 o[4];
#pragma unroll
    for (int dt = 0; dt < 4; ++dt) o[dt] = (f32x4){0.f, 0.f, 0.f, 0.f};
#pragma unroll
    for (int st = 0; st < 5; ++st) {
        u32x4 pw; pw.x = pk2(s[2 * st][0] * inv, s[2 * st][1] * inv); pw.y = pk2(s[2 * st][2] * inv, s[2 * st][3] * inv);
        pw.z = pk2(s[2 * st + 1][0] * inv, s[2 * st + 1][1] * inv); pw.w = pk2(s[2 * st + 1][2] * inv, s[2 * st + 1][3] * inv);
        const bf16x8 pf = __builtin_bit_cast(bf16x8, pw);
#pragma unroll
        for (int dt = 0; dt < 4; ++dt) { const LAS bf16_t* vp = Vt + (dt * 16 + c16) * VT_LD + (kt0 + 2 * st) * 16 + quad * 4;
            const u32x2 lo = *(const LAS u32x2*)vp, hi = *(const LAS u32x2*)(vp + 16);
            u32x4 vw; vw.x = lo.x; vw.y = lo.y; vw.z = hi.x; vw.w = hi.y;
            o[dt] = MFMA16(__builtin_bit_cast(bf16x8, vw), pf, o[dt]); }
    }
#pragma unroll
    for (int dt = 0; dt < 4; ++dt) { u32x2 w; w.x = pk2(o[dt][0], o[dt][1]); w.y = pk2(o[dt][2], o[dt][3]); *(u32x2*)(qptr + dt * 16 + quad * 4) = w; }
}

struct Args { const float* in[22]; float* out; unsigned char* ws; int ph_lo, ph_hi; };

__global__ void __launch_bounds__(512, 2) mega(Args a) {
    extern __shared__ __attribute__((aligned(16))) unsigned char lds_raw[];
    LAS unsigned char* lds = (LAS unsigned char*)lds_raw;
    cg::grid_group grid = cg::this_grid();
    const int tid0 = threadIdx.x, w = __builtin_amdgcn_readfirstlane(tid0 >> 6), G = gridDim.x, bx = blockIdx.x;
    const int gw = bx * 8 + w, NGW = G * 8, NGT = G * 512;
#define LOCAL_IDS const int tid = opaque(tid0), lane = tid & 63, c16 = lane & 15, quad = lane >> 4; (void)c16; (void)quad; (void)lane;
    unsigned char* ws = a.ws; float* out = a.out;
    const float* x_p = a.in[0]; const float* x_s = a.in[1]; const float* cache_k = a.in[2]; const float* cache_v = a.in[3];
    const float* state_conv = a.in[4]; const float* state_ssm = a.in[5]; const float* norm1 = a.in[6]; const float* w_in = a.in[7];
    const float* sinks = a.in[8]; const float* conv_w = a.in[9]; const float* conv_b = a.in[10]; const float* dt_bias = a.in[11];
    const float* a_log = a.in[12]; const float* d_skip = a.in[13]; const float* ssm_norm = a.in[14]; const float* w_oa = a.in[15];
    const float* w_ob = a.in[16]; const float* w_o = a.in[17]; const float* norm2 = a.in[18]; const float* w_up = a.in[19];
    const float* w_down = a.in[20]; const float* final_norm = a.in[21];
    float* RSTD1 = (float*)(ws + WS_RSTD1); float* SSQ2 = (float*)(ws + WS_SSQ2); float* SSQF = (float*)(ws + WS_SSQF); float* CD = (float*)(ws + WS_CD);
    bf16_t* WIN = (bf16_t*)(ws + WS_WIN); bf16_t* WOA = (bf16_t*)(ws + WS_WOA); bf16_t* WOB = (bf16_t*)(ws + WS_WOB); bf16_t* WO = (bf16_t*)(ws + WS_WO);
    bf16_t* WUP = (bf16_t*)(ws + WS_WUP); bf16_t* WDN = (bf16_t*)(ws + WS_WDN);
    float* DT = (float*)(ws + WS_DT); bf16_t* U = (bf16_t*)(ws + WS_U); bf16_t* XC = (bf16_t*)(ws + WS_XC);
    bf16_t* MERGED = (bf16_t*)(ws + WS_MERGED); bf16_t* X1B = (bf16_t*)(ws + WS_X1B); bf16_t* ACT = (bf16_t*)(ws + WS_ACT);
    bf16_t* XB = (bf16_t*)(out + O_SS);
    float* ST = out + O_YP;
    float* X1 = out + O_YP;
    const int lo = a.ph_lo, hi = a.ph_hi;
#ifndef PHMASK
#define PHMASK 0x7ff
#endif
#define IN(k) (((PHMASK >> (k)) & 1) && lo <= (k) && (k) < hi)
    unsigned* BARW = (unsigned*)(ws + WS_BAR);
    if (lo < 0) grid.sync();
    unsigned bar_target = 0;
#define SEAM(k) do { if (IN(k) && IN((k) + 1)) { bar_target += (unsigned)G; \
        asm volatile("s_waitcnt vmcnt(0) lgkmcnt(0)" ::: "memory"); __syncthreads(); \
        if (tid0 == 0) { __builtin_amdgcn_fence(__ATOMIC_RELEASE, "agent"); asm volatile("s_waitcnt vmcnt(0)" ::: "memory"); \
            __hip_atomic_fetch_add(BARW, 1u, __ATOMIC_RELAXED, __HIP_MEMORY_SCOPE_AGENT); unsigned sp_ = 0; \
            while (__hip_atomic_load(BARW, __ATOMIC_RELAXED, __HIP_MEMORY_SCOPE_AGENT) < bar_target) { __builtin_amdgcn_s_sleep(2); if (++sp_ > (1u << 24)) break; } \
            __builtin_amdgcn_fence(__ATOMIC_ACQUIRE, "agent"); asm volatile("s_waitcnt vmcnt(0)" ::: "memory"); } \
        __syncthreads(); } } while (0)

    if (IN(0)) {
        LOCAL_IDS const int gtid = bx * 512 + tid;
        LAS float* scr = (LAS float*)(lds + w * 8448);
        constexpr int I_IN = 16 * 176, I_OA = 8 * 32, I_OB = 16 * 32, I_O = 16 * 32;
        for (int it = gw; it < I_IN + I_OA + I_OB + I_O; it += NGW) {
            int r = it;
            if (r < I_IN) { transpose_item(w_in, DM, INW, norm1, WIN, scr, r, 176, lane); continue; } r -= I_IN;
            if (r < I_OA) { transpose_item(w_oa, 512, DM, nullptr, WOA, scr, r, 32, lane); continue; } r -= I_OA;
            if (r < I_OB) { transpose_item(w_ob, DM, DM, ssm_norm, WOB, scr, r, 32, lane); continue; } r -= I_OB;
            transpose_item(w_o, DM, DM, nullptr, WO, scr, r, 32, lane);
        }
        for (int m = gw; m < M; m += NGW) {
            const float* xr = m < MP ? x_p + (size_t)m * DM : x_s + (size_t)(m - MP) * DM;
            f32x4 v[4]; float ss = 0.f;
#pragma unroll
            for (int j = 0; j < 4; ++j) { v[j] = *(const f32x4*)(xr + lane * 4 + 256 * j); ss += (v[j][0] * v[j][0] + v[j][1] * v[j][1]) + (v[j][2] * v[j][2] + v[j][3] * v[j][3]); }
            ss = wave_sum(ss);
            if (lane == 0) RSTD1[m] = rsqrtf(ss * (1.f / DM) + EPS);
#pragma unroll
            for (int j = 0; j < 4; ++j) { u32x2 o; o.x = pk2(v[j][0], v[j][1]); o.y = pk2(v[j][2], v[j][3]); *(u32x2*)(XB + (size_t)m * DM + lane * 4 + 256 * j) = o; }
        }
        for (int i = gtid; i < M; i += NGT) { SSQ2[i] = 0.f; SSQF[i] = 0.f; }
    }
    SEAM(0);
    if (IN(1)) {
        pg8::Gemm g{XB, WIN, M, NPAD, DM, DM, DM}; pg8::StaticOrder S; S.init(M, NPAD, G, bx);
        EpiIn E{U, DT, RSTD1, dt_bias};
        pg8::gemm_phase<EpiIn>(lds, g, S, E);
    }
    SEAM(1);
    if (IN(2)) {
        for (int item = bx; item < 576; item += G) {
            LOCAL_IDS
            if (tid < 384) {
                const int cgi = tid % 192, half = tid / 192, ch0 = cgi * 8;
                float wv[4][8], bias[8];
#pragma unroll
                for (int i = 0; i < 4; ++i) { const f32x4 t0 = *(const f32x4*)(conv_w + i * CONVD + ch0), t1 = *(const f32x4*)(conv_w + i * CONVD + ch0 + 4);
#pragma unroll
                    for (int k = 0; k < 4; ++k) { wv[i][k] = t0[k]; wv[i][4 + k] = t1[k]; } }
                { const f32x4 t0 = *(const f32x4*)(conv_b + ch0), t1 = *(const f32x4*)(conv_b + ch0 + 4);
#pragma unroll
                  for (int k = 0; k < 4; ++k) { bias[k] = t0[k]; bias[4 + k] = t1[k]; } }
                float x0[8], x1[8], x2[8], x3[8];
                int nrows, rowbase; bool prompt = item < 512; int b, t0;
                if (prompt) { b = item >> 6; t0 = (item & 63) * 32 + half * 16; nrows = 16; rowbase = b * SEQ + t0;
#pragma unroll
                    for (int k = 0; k < 8; ++k) { x0[k] = 0.f; x1[k] = 0.f; x2[k] = 0.f; }
                    if (t0 > 0) { const u32x4 r0 = *(const u32x4*)(U + (size_t)(rowbase - 3) * INW + OX + ch0), r1 = *(const u32x4*)(U + (size_t)(rowbase - 2) * INW + OX + ch0), r2 = *(const u32x4*)(U + (size_t)(rowbase - 1) * INW + OX + ch0);
                        x0[0] = bflo(r0.x); x0[1] = bfhi(r0.x); x0[2] = bflo(r0.y); x0[3] = bfhi(r0.y); x0[4] = bflo(r0.z); x0[5] = bfhi(r0.z); x0[6] = bflo(r0.w); x0[7] = bfhi(r0.w);
                        x1[0] = bflo(r1.x); x1[1] = bfhi(r1.x); x1[2] = bflo(r1.y); x1[3] = bfhi(r1.y); x1[4] = bflo(r1.z); x1[5] = bfhi(r1.z); x1[6] = bflo(r1.w); x1[7] = bfhi(r1.w);
                        x2[0] = bflo(r2.x); x2[1] = bfhi(r2.x); x2[2] = bflo(r2.y); x2[3] = bfhi(r2.y); x2[4] = bflo(r2.z); x2[5] = bfhi(r2.z); x2[6] = bflo(r2.w); x2[7] = bfhi(r2.w); }
                } else { b = (item - 512) * 2 + half; t0 = 0; nrows = 4; rowbase = MP + b * 4;
                    const float* sp = state_conv + (size_t)b * 3 * CONVD + ch0;
#pragma unroll
                    for (int k = 0; k < 8; ++k) { x0[k] = sp[k]; x1[k] = sp[CONVD + k]; x2[k] = sp[2 * CONVD + k]; }
                }
                for (int tt = 0; tt < nrows; ++tt) {
                    const u32x4 r3 = *(const u32x4*)(U + (size_t)(rowbase + tt) * INW + OX + ch0);
                    x3[0] = bflo(r3.x); x3[1] = bfhi(r3.x); x3[2] = bflo(r3.y); x3[3] = bfhi(r3.y); x3[4] = bflo(r3.z); x3[5] = bfhi(r3.z); x3[6] = bflo(r3.w); x3[7] = bfhi(r3.w);
                    float y[8];
#pragma unroll
                    for (int k = 0; k < 8; ++k) { const float s = bias[k] + x0[k] * wv[0][k] + x1[k] * wv[1][k] + x2[k] * wv[2][k] + x3[k] * wv[3][k]; y[k] = siluf_(s); }
                    u32x4 o; o.x = pk2(y[0], y[1]); o.y = pk2(y[2], y[3]); o.z = pk2(y[4], y[5]); o.w = pk2(y[6], y[7]);
                    *(u32x4*)(XC + (size_t)(rowbase + tt) * CONVD + ch0) = o;
                    int oj = -1; float* obase = nullptr;
                    if (prompt) { if (t0 + tt >= SEQ - 3) { oj = t0 + tt - (SEQ - 3); obase = out + O_CP + (size_t)b * 3 * CONVD; } }
                    else { if (tt >= 1) { oj = tt - 1; obase = out + O_CS + (size_t)b * 3 * CONVD; } }
                    if (oj >= 0) { float* op = obase + (size_t)oj * CONVD + ch0; *(f32x4*)op = (f32x4){x3[0], x3[1], x3[2], x3[3]}; *(f32x4*)(op + 4) = (f32x4){x3[4], x3[5], x3[6], x3[7]}; }
#pragma unroll
                    for (int k = 0; k < 8; ++k) { x0[k] = x1[k]; x1[k] = x2[k]; x2[k] = x3[k]; }
                }
            }
        }
        LAS bf16_t* Ks = (LAS bf16_t*)lds; LAS bf16_t* Vt = (LAS bf16_t*)(lds + 272 * KS_LD * 2);
        for (int unit = bx; unit < 256; unit += G) {
            LOCAL_IDS const int b = unit >> 5, qblk = (unit >> 1) & 15, kvh = unit & 1;
            __syncthreads();
            for (int pc = tid; pc < 272 * 8; pc += 512) { const int kidx = pc >> 3, part = pc & 7; const int tok = (qblk - 1) * 128 + kidx;
                u32x4 kv = (u32x4){0u, 0u, 0u, 0u}, vv = (u32x4){0u, 0u, 0u, 0u};
                if (kidx < 256 && tok >= 0) { const bf16_t* rp = U + (size_t)(b * SEQ + tok) * INW + kvh * 64 + part * 8; kv = *(const u32x4*)(rp + OKK); vv = *(const u32x4*)(rp + OV);
                    if (qblk == 15 && kidx >= 128) { const size_t oo = ((size_t)(b * 128 + kidx - 128) * 2 + kvh) * 64 + part * 8;
                        *(f32x4*)(out + O_KP + oo) = (f32x4){bflo(kv.x), bfhi(kv.x), bflo(kv.y), bfhi(kv.y)}; *(f32x4*)(out + O_KP + oo + 4) = (f32x4){bflo(kv.z), bfhi(kv.z), bflo(kv.w), bfhi(kv.w)};
                        *(f32x4*)(out + O_VP + oo) = (f32x4){bflo(vv.x), bfhi(vv.x), bflo(vv.y), bfhi(vv.y)}; *(f32x4*)(out + O_VP + oo + 4) = (f32x4){bflo(vv.z), bfhi(vv.z), bflo(vv.w), bfhi(vv.w)}; } }
                *(LAS u32x4*)(Ks + kidx * KS_LD + part * 8) = kv;
                LAS bf16_t* vp = Vt + (part * 8) * VT_LD + kidx;
                vp[0] = (bf16_t)(vv.x & 0xffffu); vp[VT_LD] = (bf16_t)(vv.x >> 16); vp[2 * VT_LD] = (bf16_t)(vv.y & 0xffffu); vp[3 * VT_LD] = (bf16_t)(vv.y >> 16);
                vp[4 * VT_LD] = (bf16_t)(vv.z & 0xffffu); vp[5 * VT_LD] = (bf16_t)(vv.z >> 16); vp[6 * VT_LD] = (bf16_t)(vv.w & 0xffffu); vp[7 * VT_LD] = (bf16_t)(vv.w >> 16); }
            __syncthreads();
            const int hq = kvh * 4 + (w >> 1), qh = w & 1; const float sink = sinks[hq];
            for (int i = 0; i < 4; ++i) { const int r0 = qh * 64 + i * 16;
                bf16_t* qp = U + (size_t)(b * SEQ + qblk * 128 + r0 + c16) * INW + hq * 64;
                attn_tile(Ks, Vt, qp, r0 >> 4, r0 + c16, qblk == 0 ? 128 : 0, sink, lane); }
        }
        for (int unit = bx; unit < 256; unit += G) {
            LOCAL_IDS const int b = unit >> 1, kvh = unit & 1;
            __syncthreads();
            for (int pc = tid; pc < 160 * 8; pc += 512) { const int kidx = pc >> 3, part = pc & 7;
                float kf[8], vf[8];
#pragma unroll
                for (int i = 0; i < 8; ++i) { kf[i] = 0.f; vf[i] = 0.f; }
                if (kidx < 128) { const size_t io = ((size_t)(b * 128 + kidx) * 2 + kvh) * 64 + part * 8;
                    const f32x4 k0 = *(const f32x4*)(cache_k + io), k1 = *(const f32x4*)(cache_k + io + 4), v0 = *(const f32x4*)(cache_v + io), v1 = *(const f32x4*)(cache_v + io + 4);
#pragma unroll
                    for (int i = 0; i < 4; ++i) { kf[i] = k0[i]; kf[4 + i] = k1[i]; vf[i] = v0[i]; vf[4 + i] = v1[i]; }
                } else if (kidx < 132) { const bf16_t* rp = U + (size_t)(MP + b * 4 + kidx - 128) * INW + kvh * 64 + part * 8; const u32x4 kv = *(const u32x4*)(rp + OKK), vv = *(const u32x4*)(rp + OV);
                    kf[0] = bflo(kv.x); kf[1] = bfhi(kv.x); kf[2] = bflo(kv.y); kf[3] = bfhi(kv.y); kf[4] = bflo(kv.z); kf[5] = bfhi(kv.z); kf[6] = bflo(kv.w); kf[7] = bfhi(kv.w);
                    vf[0] = bflo(vv.x); vf[1] = bfhi(vv.x); vf[2] = bflo(vv.y); vf[3] = bfhi(vv.y); vf[4] = bflo(vv.z); vf[5] = bfhi(vv.z); vf[6] = bflo(vv.w); vf[7] = bfhi(vv.w); }
                if (kidx >= 4 && kidx < 132) { const size_t oo = ((size_t)(b * 128 + kidx - 4) * 2 + kvh) * 64 + part * 8;
                    *(f32x4*)(out + O_KS + oo) = (f32x4){kf[0], kf[1], kf[2], kf[3]}; *(f32x4*)(out + O_KS + oo + 4) = (f32x4){kf[4], kf[5], kf[6], kf[7]};
                    *(f32x4*)(out + O_VS + oo) = (f32x4){vf[0], vf[1], vf[2], vf[3]}; *(f32x4*)(out + O_VS + oo + 4) = (f32x4){vf[4], vf[5], vf[6], vf[7]}; }
                u32x4 kw; kw.x = pk2(kf[0], kf[1]); kw.y = pk2(kf[2], kf[3]); kw.z = pk2(kf[4], kf[5]); kw.w = pk2(kf[6], kf[7]);
                *(LAS u32x4*)(Ks + kidx * KS_LD + part * 8) = kw;
                LAS bf16_t* vp = Vt + (part * 8) * VT_LD + kidx;
#pragma unroll
                for (int i = 0; i < 8; ++i) vp[i * VT_LD] = (bf16_t)f2bf(vf[i]); }
            __syncthreads();
            if (w == 0) { const int gq = c16 >> 2, t = c16 & 3, hq = kvh * 4 + gq;
                bf16_t* qp = U + (size_t)(MP + b * 4 + t) * INW + hq * 64;
                attn_tile(Ks, Vt, qp, 0, t, 0, sinks[hq], lane); }
        }
    }
    SEAM(2);
    if (IN(3)) {
        {
            LAS bf16_t* Bt = (LAS bf16_t*)lds;
            LAS bf16_t* Xs = (LAS bf16_t*)(lds + 18432);
            LAS float* scl = (LAS float*)(lds + 18432 + 73728);
            for (int unit = bx; unit < 256; unit += G) {
                LOCAL_IDS const int b = unit >> 5, c = (unit >> 1) & 15, g = unit & 1, row0 = b * SEQ + c * 128, h = 8 * g + w;
                __syncthreads();
                { const float A = -__expf(a_log[h]);
                  const float d0 = DT[(size_t)(row0 + lane) * 16 + h], d1 = DT[(size_t)(row0 + 64 + lane) * 16 + h];
                  float v0 = d0 * A, v1 = d1 * A;
#pragma unroll
                  for (int o = 1; o < 64; o <<= 1) { const float t0 = __shfl_up(v0, o), t1 = __shfl_up(v1, o); if (lane >= o) { v0 += t0; v1 += t1; } }
                  v1 += __shfl(v0, 63); const float last = __shfl(v1, 63);
                  scl[w * 128 + lane] = d0 * __expf(last - v0); scl[w * 128 + 64 + lane] = d1 * __expf(last - v1);
                  if (lane == 0) CD[(b * 16 + c) * 16 + h] = __expf(last); }
                f32x4 acc[8][4];
#pragma unroll
                for (int nt = 0; nt < 8; ++nt)
#pragma unroll
                    for (int pt = 0; pt < 4; ++pt) acc[nt][pt] = (f32x4){0.f, 0.f, 0.f, 0.f};
                for (int half = 0; half < 2; ++half) {
                    __syncthreads();
#pragma unroll 1
                    for (int pc = tid; pc < 1024; pc += 512) { const int lr = pc >> 4, part = pc & 15;
                        const u32x4 v = *(const u32x4*)(XC + (size_t)(row0 + half * 64 + lr) * CONVD + 1024 + g * 128 + part * 8);
                        LAS bf16_t* bp = Bt + (part * 8) * 72 + lr;
                        bp[0] = (bf16_t)(v.x & 0xffffu); bp[72] = (bf16_t)(v.x >> 16); bp[144] = (bf16_t)(v.y & 0xffffu); bp[216] = (bf16_t)(v.y >> 16);
                        bp[288] = (bf16_t)(v.z & 0xffffu); bp[360] = (bf16_t)(v.z >> 16); bp[432] = (bf16_t)(v.w & 0xffffu); bp[504] = (bf16_t)(v.w >> 16); }
#pragma unroll 1
                    for (int pc = tid; pc < 4096; pc += 512) { const int lr = pc >> 6, part = pc & 63, hh = part >> 3, p0 = (part & 7) * 8;
                        const u32x4 v = *(const u32x4*)(XC + (size_t)(row0 + half * 64 + lr) * CONVD + g * 512 + part * 8);
                        const float sc = scl[hh * 128 + half * 64 + lr];
                        LAS bf16_t* xp = Xs + (hh * 64 + p0) * 72 + lr;
                        xp[0] = (bf16_t)f2bf(bflo(v.x) * sc); xp[72] = (bf16_t)f2bf(bfhi(v.x) * sc); xp[144] = (bf16_t)f2bf(bflo(v.y) * sc); xp[216] = (bf16_t)f2bf(bfhi(v.y) * sc);
                        xp[288] = (bf16_t)f2bf(bflo(v.z) * sc); xp[360] = (bf16_t)f2bf(bfhi(v.z) * sc); xp[432] = (bf16_t)f2bf(bflo(v.w) * sc); xp[504] = (bf16_t)f2bf(bfhi(v.w) * sc); }
                    __syncthreads();
#pragma unroll
                    for (int ks = 0; ks < 2; ++ks) { bf16x8 xf[4];
#pragma unroll
                        for (int pt = 0; pt < 4; ++pt) xf[pt] = *(const LAS bf16x8*)(Xs + (w * 64 + pt * 16 + c16) * 72 + ks * 32 + quad * 8);
#pragma unroll
                        for (int nt = 0; nt < 8; ++nt) { const bf16x8 bfr = *(const LAS bf16x8*)(Bt + (nt * 16 + c16) * 72 + ks * 32 + quad * 8);
#pragma unroll
                            for (int pt = 0; pt < 4; ++pt) acc[nt][pt] = MFMA16(bfr, xf[pt], acc[nt][pt]);
                            if (nt & 1) asm volatile("" ::: "memory"); } }
                }
                float* sp = ST + ((size_t)((b * 16 + c) * 16 + h) * 64) * 128;
#pragma unroll
                for (int nt = 0; nt < 8; ++nt)
#pragma unroll
                    for (int pt = 0; pt < 4; ++pt) *(f32x4*)(sp + (size_t)(pt * 16 + c16) * 128 + nt * 16 + quad * 4) = acc[nt][pt];
            }
        }
        {
            LAS float* xr = (LAS float*)lds;
            LAS float* xdt = (LAS float*)(lds + 8192);
            LAS float* vals = (LAS float*)(lds + 16384);
            LAS float* rs = (LAS float*)(lds + 24576);
            for (int unit = bx; unit < 256; unit += G) {
                LOCAL_IDS const int b = unit >> 1, g = unit & 1, h = 8 * g + w, R0 = MP + b * 4;
                __syncthreads();
                const float A = -__expf(a_log[h]); float dtv[4], dA[4];
#pragma unroll
                for (int t = 0; t < 4; ++t) { dtv[t] = DT[(size_t)(R0 + t) * 16 + h]; dA[t] = __expf(dtv[t] * A); }
                { const int t = quad, p0 = c16 * 4; const u32x2 v = *(const u32x2*)(XC + (size_t)(R0 + t) * CONVD + h * 64 + p0);
                  const float dtt = t == 0 ? dtv[0] : (t == 1 ? dtv[1] : (t == 2 ? dtv[2] : dtv[3]));
                  const float f0 = bflo(v.x), f1 = bfhi(v.x), f2 = bflo(v.y), f3 = bfhi(v.y);
                  LAS float* p = xr + (w * 4 + t) * 64 + p0; p[0] = f0; p[1] = f1; p[2] = f2; p[3] = f3;
                  LAS float* q = xdt + (w * 4 + t) * 64 + p0; q[0] = f0 * dtt; q[1] = f1 * dtt; q[2] = f2 * dtt; q[3] = f3 * dtt; }
                float Bv[4][8], Cv[4][8];
#pragma unroll
                for (int t = 0; t < 4; ++t) { const bf16_t* rp = XC + (size_t)(R0 + t) * CONVD + 1024 + g * 128 + c16 * 4;
                    const u32x2 b0 = *(const u32x2*)rp, b1 = *(const u32x2*)(rp + 64), c0 = *(const u32x2*)(rp + 256), c1 = *(const u32x2*)(rp + 320);
                    Bv[t][0] = bflo(b0.x); Bv[t][1] = bfhi(b0.x); Bv[t][2] = bflo(b0.y); Bv[t][3] = bfhi(b0.y); Bv[t][4] = bflo(b1.x); Bv[t][5] = bfhi(b1.x); Bv[t][6] = bflo(b1.y); Bv[t][7] = bfhi(b1.y);
                    Cv[t][0] = bflo(c0.x); Cv[t][1] = bfhi(c0.x); Cv[t][2] = bflo(c0.y); Cv[t][3] = bfhi(c0.y); Cv[t][4] = bflo(c1.x); Cv[t][5] = bfhi(c1.x); Cv[t][6] = bflo(c1.y); Cv[t][7] = bfhi(c1.y); }
                const float Dh = d_skip[h];
                LDS_WAIT();
                const float* sin_ = state_ssm + (size_t)(b * 16 + h) * 8192; float* sout = out + O_SS + (size_t)(b * 16 + h) * 8192;
#pragma unroll 2
                for (int i = 0; i < 16; ++i) { const int p = 4 * i + quad;
                    f32x4 h0 = *(const f32x4*)(sin_ + p * 128 + c16 * 4), h1 = *(const f32x4*)(sin_ + p * 128 + 64 + c16 * 4);
                    float yk = 0.f;
#pragma unroll
                    for (int t = 0; t < 4; ++t) { const float xd = xdt[(w * 4 + t) * 64 + p]; float y = 0.f;
#pragma unroll
                        for (int k = 0; k < 4; ++k) { h0[k] = h0[k] * dA[t] + xd * Bv[t][k]; y += h0[k] * Cv[t][k]; h1[k] = h1[k] * dA[t] + xd * Bv[t][4 + k]; y += h1[k] * Cv[t][4 + k]; }
                        y += __shfl_xor(y, 1); y += __shfl_xor(y, 2); y += __shfl_xor(y, 4); y += __shfl_xor(y, 8);
                        if (c16 == t) yk = y + Dh * xr[(w * 4 + t) * 64 + p]; }
                    *(f32x4*)(sout + p * 128 + c16 * 4) = h0; *(f32x4*)(sout + p * 128 + 64 + c16 * 4) = h1;
                    if (c16 < 4) { const float z = bf1(U[(size_t)(R0 + c16) * INW + OZ + h * 64 + p]); vals[(w * 4 + c16) * 64 + p] = yk * siluf_(z); } }
                __syncthreads();
                if (w < 4) { float s = 0.f;
#pragma unroll
                    for (int hh = 0; hh < 8; ++hh) { const float v = vals[(hh * 4 + w) * 64 + lane]; s += v * v; }
                    s = wave_sum(s); if (lane == 0) rs[w] = rsqrtf(s * (1.f / 512.f) + EPS); }
                __syncthreads();
                { const int t = tid >> 7, ch4 = (tid & 127) * 4, hh = ch4 >> 6, p = ch4 & 63; const float r = rs[t]; const LAS float* vp = vals + (hh * 4 + t) * 64 + p;
                  u32x2 o; o.x = pk2(vp[0] * r, vp[1] * r); o.y = pk2(vp[2] * r, vp[3] * r);
                  *(u32x2*)(U + (size_t)(R0 + t) * INW + OZ + g * 512 + ch4) = o; }
            }
        }
    }
    SEAM(3);
    if (IN(4)) {
        LOCAL_IDS const int gtid = bx * 512 + tid;
        for (int idx = gtid; idx < 262144; idx += NGT) { const int n4 = idx & 31, p = (idx >> 5) & 63, h = (idx >> 11) & 15, b = idx >> 15;
            f32x4 hc = (f32x4){0.f, 0.f, 0.f, 0.f};
#pragma unroll
            for (int c = 0; c < 16; ++c) { float* ptr = ST + ((size_t)((b * 16 + c) * 16 + h) * 64 + p) * 128 + n4 * 4; const f32x4 s = *(const f32x4*)ptr; *(f32x4*)ptr = hc; const float d = CD[(b * 16 + c) * 16 + h]; hc = hc * d + s; }
            *(f32x4*)(out + O_SP + ((size_t)(b * 16 + h) * 64 + p) * 128 + n4 * 4) = hc; }
    }
    SEAM(4);
    if (IN(5)) {
        LAS bf16_t* Cs = (LAS bf16_t*)lds; LAS bf16_t* Bs = (LAS bf16_t*)(lds + 34816); LAS bf16_t* CBs = (LAS bf16_t*)(lds + 69632);
        LAS bf16_t* Xt = (LAS bf16_t*)(lds + 104448 + w * 5120);
        LAS float* acs = (LAS float*)(lds + 145408); LAS float* dts = (LAS float*)(lds + 149504); LAS float* ssq = (LAS float*)(lds + 153600);
        for (int unit = bx; unit < 256; unit += G) {
            LOCAL_IDS const int b = unit >> 5, c = (unit >> 1) & 15, g = unit & 1, row0 = b * SEQ + c * 128, h = 8 * g + w;
            __syncthreads();
            { const float A = -__expf(a_log[h]);
              const float d0 = DT[(size_t)(row0 + lane) * 16 + h], d1 = DT[(size_t)(row0 + 64 + lane) * 16 + h];
              float v0 = d0 * A, v1 = d1 * A;
#pragma unroll
              for (int o = 1; o < 64; o <<= 1) { const float t0 = __shfl_up(v0, o), t1 = __shfl_up(v1, o); if (lane >= o) { v0 += t0; v1 += t1; } }
              v1 += __shfl(v0, 63);
              acs[w * 128 + lane] = v0; acs[w * 128 + 64 + lane] = v1; dts[w * 128 + lane] = d0; dts[w * 128 + 64 + lane] = d1; }
#pragma unroll 1
            for (int pc = tid; pc < 2048; pc += 512) { const int lr = pc >> 4, part = pc & 15; const bf16_t* rp = XC + (size_t)(row0 + lr) * CONVD + 1024 + g * 128 + part * 8;
                *(LAS u32x4*)(Bs + lr * 136 + part * 8) = *(const u32x4*)rp; *(LAS u32x4*)(Cs + lr * 136 + part * 8) = *(const u32x4*)(rp + 256); }
            __syncthreads();
            {
                bf16x8 bfr[4];
#pragma unroll
                for (int ks = 0; ks < 4; ++ks) bfr[ks] = *(const LAS bf16x8*)(Bs + (16 * w + c16) * 136 + ks * 32 + quad * 8);
#pragma unroll
                for (int lt = 0; lt < 8; ++lt) { f32x4 d = (f32x4){0.f, 0.f, 0.f, 0.f};
#pragma unroll
                    for (int ks = 0; ks < 4; ++ks) { const bf16x8 cfr = *(const LAS bf16x8*)(Cs + (lt * 16 + c16) * 136 + ks * 32 + quad * 8); d = MFMA16(bfr[ks], cfr, d); }
                    u32x2 o; o.x = pk2(d[0], d[1]); o.y = pk2(d[2], d[3]); *(LAS u32x2*)(CBs + (lt * 16 + c16) * 136 + 16 * w + quad * 4) = o; }
            }
            __syncthreads();
            f32x4 acc[4][8];
#pragma unroll
            for (int pt = 0; pt < 4; ++pt)
#pragma unroll
                for (int lt = 0; lt < 8; ++lt) acc[pt][lt] = (f32x4){0.f, 0.f, 0.f, 0.f};
            const float* Hp = ST + (size_t)((b * 16 + c) * 16 + h) * 8192;
#pragma unroll
            for (int ks = 0; ks < 4; ++ks) { bf16x8 hf[4];
#pragma unroll
                for (int pt = 0; pt < 4; ++pt) { const float* hp = Hp + (pt * 16 + c16) * 128 + ks * 32 + quad * 8; const f32x4 a0 = *(const f32x4*)hp, a1 = *(const f32x4*)(hp + 4);
                    u32x4 hw; hw.x = pk2(a0[0], a0[1]); hw.y = pk2(a0[2], a0[3]); hw.z = pk2(a1[0], a1[1]); hw.w = pk2(a1[2], a1[3]); hf[pt] = __builtin_bit_cast(bf16x8, hw); }
#pragma unroll
                for (int lt = 0; lt < 8; ++lt) { const bf16x8 cfr = *(const LAS bf16x8*)(Cs + (lt * 16 + c16) * 136 + ks * 32 + quad * 8);
#pragma unroll
                    for (int pt = 0; pt < 4; ++pt) acc[pt][lt] = MFMA16(hf[pt], cfr, acc[pt][lt]); }
                asm volatile("" ::: "memory"); }
#pragma unroll
            for (int lt = 0; lt < 8; ++lt) { const float e = __expf(acs[w * 128 + lt * 16 + c16]);
#pragma unroll
                for (int pt = 0; pt < 4; ++pt) acc[pt][lt] = acc[pt][lt] * e; }
#pragma unroll
            for (int sq = 0; sq < 4; ++sq) {
                asm volatile("s_waitcnt lgkmcnt(0)" ::: "memory");
#pragma unroll
                for (int k = 0; k < 4; ++k) { const int pc = lane + 64 * k, sr = pc >> 3, part = pc & 7;
                    const u32x4 v = *(const u32x4*)(XC + (size_t)(row0 + sq * 32 + sr) * CONVD + h * 64 + part * 8);
                    LAS bf16_t* xp = Xt + (part * 8) * 40 + sr;
                    xp[0] = (bf16_t)(v.x & 0xffffu); xp[40] = (bf16_t)(v.x >> 16); xp[80] = (bf16_t)(v.y & 0xffffu); xp[120] = (bf16_t)(v.y >> 16);
                    xp[160] = (bf16_t)(v.z & 0xffffu); xp[200] = (bf16_t)(v.z >> 16); xp[240] = (bf16_t)(v.w & 0xffffu); xp[280] = (bf16_t)(v.w >> 16); }
                asm volatile("s_waitcnt lgkmcnt(0)" ::: "memory");
                bf16x8 xf[4];
#pragma unroll
                for (int pt = 0; pt < 4; ++pt) xf[pt] = *(const LAS bf16x8*)(Xt + (pt * 16 + c16) * 40 + quad * 8);
                const f32x4 as0 = *(const LAS f32x4*)(acs + w * 128 + sq * 32 + quad * 8), as1 = *(const LAS f32x4*)(acs + w * 128 + sq * 32 + quad * 8 + 4);
                const f32x4 ds0 = *(const LAS f32x4*)(dts + w * 128 + sq * 32 + quad * 8), ds1 = *(const LAS f32x4*)(dts + w * 128 + sq * 32 + quad * 8 + 4);
#pragma unroll
                for (int lt = 0; lt < 8; ++lt) { if (lt >= 2 * sq) {
                    const int l = lt * 16 + c16; const float al = acs[w * 128 + l];
                    const u32x4 cb = *(const LAS u32x4*)(CBs + l * 136 + sq * 32 + quad * 8);
                    const int s0 = sq * 32 + quad * 8;
                    float wv[8];
                    wv[0] = bflo(cb.x); wv[1] = bfhi(cb.x); wv[2] = bflo(cb.y); wv[3] = bfhi(cb.y); wv[4] = bflo(cb.z); wv[5] = bfhi(cb.z); wv[6] = bflo(cb.w); wv[7] = bfhi(cb.w);
#pragma unroll
                    for (int i = 0; i < 4; ++i) { wv[i] = (s0 + i <= l) ? wv[i] * __expf(fminf(al - as0[i], 0.f)) * ds0[i] : 0.f; wv[4 + i] = (s0 + 4 + i <= l) ? wv[4 + i] * __expf(fminf(al - as1[i], 0.f)) * ds1[i] : 0.f; }
                    u32x4 ww; ww.x = pk2(wv[0], wv[1]); ww.y = pk2(wv[2], wv[3]); ww.z = pk2(wv[4], wv[5]); ww.w = pk2(wv[6], wv[7]);
                    const bf16x8 wf = __builtin_bit_cast(bf16x8, ww);
#pragma unroll
                    for (int pt = 0; pt < 4; ++pt) acc[pt][lt] = MFMA16(xf[pt], wf, acc[pt][lt]); } }
            }
            const float Dh = d_skip[h];
#pragma unroll
            for (int lt = 0; lt < 8; ++lt) { const int l = lt * 16 + c16; const size_t tok = (size_t)(row0 + l); float ss = 0.f;
#pragma unroll
                for (int pt = 0; pt < 4; ++pt) { const int pb = pt * 16 + quad * 4;
                    const u32x2 xv = *(const u32x2*)(XC + tok * CONVD + h * 64 + pb), zv = *(const u32x2*)(U + tok * INW + OZ + h * 64 + pb);
                    const float xf0 = bflo(xv.x), xf1 = bfhi(xv.x), xf2 = bflo(xv.y), xf3 = bfhi(xv.y);
                    const float z0 = bflo(zv.x), z1 = bfhi(zv.x), z2 = bflo(zv.y), z3 = bfhi(zv.y);
                    f32x4 v = acc[pt][lt];
                    v[0] = (v[0] + Dh * xf0) * siluf_(z0); v[1] = (v[1] + Dh * xf1) * siluf_(z1); v[2] = (v[2] + Dh * xf2) * siluf_(z2); v[3] = (v[3] + Dh * xf3) * siluf_(z3);
                    acc[pt][lt] = v; ss += (v[0] * v[0] + v[1] * v[1]) + (v[2] * v[2] + v[3] * v[3]); }
                ss += __shfl_xor(ss, 16); ss += __shfl_xor(ss, 32);
                if (quad == 0) ssq[w * 128 + l] = ss;
                asm volatile("" ::: "memory"); }
            __syncthreads();
#pragma unroll
            for (int lt = 0; lt < 8; ++lt) { const int l = lt * 16 + c16; const size_t tok = (size_t)(row0 + l); float s = 0.f;
#pragma unroll
                for (int ww = 0; ww < 8; ++ww) s += ssq[ww * 128 + l];
                const float r = rsqrtf(s * (1.f / 512.f) + EPS);
#pragma unroll
                for (int pt = 0; pt < 4; ++pt) { const f32x4 v = acc[pt][lt] * r; u32x2 o; o.x = pk2(v[0], v[1]); o.y = pk2(v[2], v[3]);
                    *(u32x2*)(U + tok * INW + OZ + h * 64 + pt * 16 + quad * 4) = o; }
                asm volatile("" ::: "memory"); }
        }
    }
    SEAM(5);
    if (IN(6)) {
        { LOCAL_IDS LAS float* scr = (LAS float*)(lds + w * 8448);
          for (int it = gw; it < 4096; it += NGW) { if (it < 2048) transpose_item(w_up, DM, DFF, norm2, WUP, scr, it, 128, lane); else transpose_item(w_down, DFF, DM, nullptr, WDN, scr, it - 2048, 32, lane); }
          __syncthreads(); }
        { pg8::Gemm g{U + OQ, WOA, M, DM, 512, INW, 512}; pg8::StaticOrder S; S.init(M, DM, G, bx); EpiGate<0> E{U, MERGED}; pg8::gemm_phase<EpiGate<0>>(lds, g, S, E); }
        { pg8::Gemm g{U + OZ, WOB, M, DM, DM, INW, DM}; pg8::StaticOrder S; S.init(M, DM, G, bx); EpiGate<1> E{U, MERGED}; pg8::gemm_phase<EpiGate<1>>(lds, g, S, E); }
    }
    SEAM(6);
    if (IN(7)) {
        pg8::Gemm g{MERGED, WO, M, DM, DM, DM, DM}; pg8::StaticOrder S; S.init(M, DM, G, bx);
        EpiRes<1> E{x_p, x_s, X1, X1B, SSQ2}; pg8::gemm_phase<EpiRes<1>>(lds, g, S, E);
    }
    SEAM(7);
    if (IN(8)) {
        pg8::Gemm g{X1B, WUP, M, DFF, DM, DM, DM}; pg8::StaticOrder S; S.init(M, DFF, G, bx);
        EpiUp E{SSQ2, ACT}; pg8::gemm_phase<EpiUp>(lds, g, S, E);
    }
    SEAM(8);
    if (IN(9)) {
        pg8::Gemm g{ACT, WDN, M, DM, DFF, DFF, DFF}; pg8::StaticOrder S; S.init(M, DM, G, bx);
        EpiRes<0> E{X1, X1 + (size_t)MP * DM, X1, nullptr, SSQF}; pg8::gemm_phase<EpiRes<0>>(lds, g, S, E);
    }
    SEAM(9);
    if (IN(10)) {
        LOCAL_IDS
        for (int m = gw; m < M; m += NGW) { float* xr = X1 + (size_t)m * DM; const float r = rsqrtf(SSQF[m] * (1.f / DM) + EPS);
#pragma unroll
            for (int j = 0; j < 4; ++j) { const int cidx = lane * 4 + 256 * j; f32x4 v = *(const f32x4*)(xr + cidx); const f32x4 fw = *(const f32x4*)(final_norm + cidx); v = v * r * fw; *(f32x4*)(xr + cidx) = v; } }
    }
#undef IN
#undef SEAM
}

#ifndef N_LAUNCH_MODE
#define N_LAUNCH_MODE 1
#endif
extern "C" void kernel_launch(void* const* d_in, const int* in_sizes, int n_in, void* d_out, int out_size, void* d_ws, size_t ws_size, hipStream_t stream) {
    static int grid = 0;
    if (grid == 0) {
        int dev = 0, cus = 0, per_cu = 0;
        hipGetDevice(&dev); hipDeviceGetAttribute(&cus, hipDeviceAttributeMultiprocessorCount, dev);
        if (hipFuncSetAttribute((const void*)mega, hipFuncAttributeMaxDynamicSharedMemorySize, LDS_BYTES) != hipSuccess) { fprintf(stderr, "hipFuncSetAttribute failed\n"); }
        if (hipOccupancyMaxActiveBlocksPerMultiprocessor(&per_cu, (const void*)mega, 512, LDS_BYTES) != hipSuccess || per_cu < 1) { fprintf(stderr, "occupancy query: %d\n", per_cu); per_cu = 1; }
        (void)hipGetLastError();
        grid = cus * 1;
        if (grid <= 0) grid = 256;
    }
    (void)hipMemsetAsync((unsigned char*)d_ws + WS_BAR, 0, 256, stream);
    Args a{};
    for (int i = 0; i < 22; ++i) a.in[i] = (const float*)d_in[i];
    a.out = (float*)d_out; a.ws = (unsigned char*)d_ws;
#if N_LAUNCH_MODE == 1
    a.ph_lo = 0; a.ph_hi = 11;
    void* args[] = {&a};
    hipError_t e = hipLaunchCooperativeKernel((const void*)mega, dim3(grid), dim3(512), args, LDS_BYTES, stream);
    if (e != hipSuccess) fprintf(stderr, "cooperative launch failed: %s (grid %d)\n", hipGetErrorString(e), grid);
#else
    for (int p = 0; p < 11; ++p) { a.ph_lo = p; a.ph_hi = p + 1; hipLaunchKernelGGL(mega, dim3(grid), dim3(512), LDS_BYTES, stream, a); }
#endif
}
```

```cpp
#include <hip/hip_runtime.h>
#include <hip/hip_cooperative_groups.h>
#include <cstdio>
#include <cstdint>
namespace cg = cooperative_groups;

#define LAS __attribute__((address_space(3)))
typedef unsigned short bf16_t;
typedef short bf16x8 __attribute__((ext_vector_type(8)));
typedef float f32x4 __attribute__((ext_vector_type(4)));
typedef float f32x2 __attribute__((ext_vector_type(2)));
typedef unsigned u32x4 __attribute__((ext_vector_type(4)));
typedef unsigned u32x2 __attribute__((ext_vector_type(2)));

constexpr int DM = 1024, MP = 16384, MS = 512, M = MP + MS, SEQ = 2048, NBATCH = 8, DBATCH = 128;
constexpr int INW = 5392, NPAD = 5632, DFF = 4096, CONVD = 1536;
constexpr int OQ = 0, OKK = 512, OV = 640, OZ = 768, OX = 1792, ODT = 3328, OGA = 3344, OGB = 4368;
constexpr float EPS = 1e-6f;
constexpr size_t O_YP = 0, O_YS = 16777216, O_KP = 17301504, O_VP = 17432576, O_CP = 17563648, O_SP = 17600512,
                 O_KS = 18649088, O_VS = 20746240, O_CS = 22843392, O_SS = 23433216;
constexpr size_t MiB = 1u << 20;
constexpr size_t WS_RSTD1 = 0, WS_SSQ2 = 128 * 1024, WS_SSQF = 256 * 1024, WS_CD = 384 * 1024, WS_BAR = 512 * 1024;
constexpr size_t WS_WIN = 1 * MiB, WS_WOA = 12 * MiB, WS_WOB = 13 * MiB, WS_WO = 15 * MiB, WS_DT = 17 * MiB;
constexpr size_t WS_U = 20 * MiB;
constexpr size_t WS_X1B = 20 * MiB, WS_ACT = 54 * MiB;
constexpr size_t WS_XC = 194 * MiB;
constexpr size_t WS_MERGED = 194 * MiB, WS_WUP = 227 * MiB, WS_WDN = 235 * MiB;
constexpr int LDS_BYTES = 163840;

__device__ __forceinline__ int opaque(int x) { asm volatile("" : "+v"(x)); return x; }
__device__ __forceinline__ unsigned f2bf(float f) { unsigned u = __builtin_bit_cast(unsigned, f); return (u + 0x7fffu + ((u >> 16) & 1u)) >> 16; }
__device__ __forceinline__ unsigned pk2(float lo, float hi) { return f2bf(lo) | (f2bf(hi) << 16); }
__device__ __forceinline__ unsigned cvt_pk_bf16(float lo, float hi) { unsigned r; asm volatile("v_cvt_pk_bf16_f32 %0, %1, %2" : "=v"(r) : "v"(lo), "v"(hi)); return r; }
__device__ __forceinline__ float bflo(unsigned w) { return __builtin_bit_cast(float, w << 16); }
__device__ __forceinline__ float bfhi(unsigned w) { return __builtin_bit_cast(float, w & 0xffff0000u); }
__device__ __forceinline__ float bf1(bf16_t h) { return __builtin_bit_cast(float, (unsigned)h << 16); }
__device__ __forceinline__ float sigmoidf_(float x) { return 1.f / (1.f + __expf(-x)); }
__device__ __forceinline__ float siluf_(float x) { return x / (1.f + __expf(-x)); }
__device__ __forceinline__ float wave_sum(float v) {
#pragma unroll
    for (int o = 1; o < 64; o <<= 1) v += __shfl_xor(v, o);
    return v;
}
#define LDS_WAIT() asm volatile("s_waitcnt lgkmcnt(0)" ::: "memory")
#define MFMA16(a, b, c) __builtin_amdgcn_mfma_f32_16x16x32_bf16(a, b, c, 0, 0, 0)

template <int O0, int O1, int O2, int O3, int D> __device__ __forceinline__ void tr_frag4(unsigned addr, bf16x8 (&f)[4]) {
    u32x2 a0, b0, a1, b1, a2, b2, a3, b3;
    asm volatile("ds_read_b64_tr_b16 %0, %8 offset:%9\n\tds_read_b64_tr_b16 %1, %8 offset:%10\n\tds_read_b64_tr_b16 %2, %8 offset:%11\n\tds_read_b64_tr_b16 %3, %8 offset:%12\n\t"
                 "ds_read_b64_tr_b16 %4, %8 offset:%13\n\tds_read_b64_tr_b16 %5, %8 offset:%14\n\tds_read_b64_tr_b16 %6, %8 offset:%15\n\tds_read_b64_tr_b16 %7, %8 offset:%16\n\ts_waitcnt lgkmcnt(0)"
                 : "=&v"(a0), "=&v"(b0), "=&v"(a1), "=&v"(b1), "=&v"(a2), "=&v"(b2), "=&v"(a3), "=&v"(b3)
                 : "v"(addr), "i"(O0), "i"(O0 + D), "i"(O1), "i"(O1 + D), "i"(O2), "i"(O2 + D), "i"(O3), "i"(O3 + D) : "memory");
    f[0] = __builtin_bit_cast(bf16x8, (u32x4){a0.x, a0.y, b0.x, b0.y}); f[1] = __builtin_bit_cast(bf16x8, (u32x4){a1.x, a1.y, b1.x, b1.y});
    f[2] = __builtin_bit_cast(bf16x8, (u32x4){a2.x, a2.y, b2.x, b2.y}); f[3] = __builtin_bit_cast(bf16x8, (u32x4){a3.x, a3.y, b3.x, b3.y});
}
#define LDSADDR(p) ((unsigned)(size_t)(p))

namespace pg8 {
constexpr int BM = 256, BK = 64, HALF = 128, HTB = HALF * BK * 2, STAGE_BYTES = 8 * HTB, NXCD = 8, WGM = 8;
__host__ __device__ __forceinline__ int lds_byte(int r, int c) { const int st = (r >> 4) * 2 + (c >> 5), rr = r & 15, cc = c & 31, ob = rr * 64 + cc * 2; return st * 1024 + (ob ^ (((ob >> 9) & 1) << 5)); }
__host__ __device__ __forceinline__ void stage_rc(int b, int& R, int& C) { const int st = b / 1024, sb = b % 1024, swz = sb ^ (((sb >> 9) & 1) << 5); R = (st >> 1) * 16 + swz / 64; C = (st & 1) * 32 + (swz % 64) / 2; }
__host__ __device__ __forceinline__ int perm32(int rho) { const int n = rho >> 4, i = rho & 15; return 8 * (i >> 2) + 4 * n + (i & 3); }
struct Unit { int pm, pn; };
struct Gemm { const bf16_t* A; const bf16_t* Bt; int M, N, K, lda, ldb; };
struct StaticOrder {
    int nM, nN, nwg, G, c;
    __device__ void init(int M_, int N_, int G_, int c_) { nM = M_ / BM; nN = N_ / BM; nwg = nM * nN; G = G_; c = c_; }
    __device__ bool next(int i, Unit& u) const {
        const long L = (long)i * G + c; if (L >= nwg) return false;
        int wgid = (int)L; { const int q = nwg / NXCD, r = nwg % NXCD, xcd = wgid % NXCD, off = wgid / NXCD; wgid = (xcd < r ? xcd * (q + 1) : r * (q + 1) + (xcd - r) * q) + off; }
        const int nig = WGM * nN, gid = wgid / nig, fm = gid * WGM, gsz = (nM - fm) < WGM ? (nM - fm) : WGM;
        u.pm = fm + ((wgid % nig) % gsz); u.pn = (wgid % nig) / gsz; return true;
    }
};
template <class Epi>
__device__ __forceinline__ void gemm_phase(LAS unsigned char* lds, const Gemm g, const StaticOrder& S, const Epi& E) {
    const int tid = opaque((int)threadIdx.x), wid = __builtin_amdgcn_readfirstlane(tid >> 6), lane = tid & 63, wr = wid >> 2, wc = wid & 3, fr = lane & 15, fq = lane >> 4;
    const int K = g.K, nt = K / BK;
    unsigned voffA[2], voffB[2];
#pragma unroll
    for (int i = 0; i < 2; ++i) { int R, C; stage_rc(tid * 16 + i * 8192, R, C); const int Rb = (R & ~31) + perm32(R & 31);
        voffA[i] = (unsigned)(R * g.lda + C) * 2u; voffB[i] = (unsigned)(Rb * g.ldb + C) * 2u; }
    const size_t kstep = (size_t)(BK * 2);
    const size_t hstepA = (size_t)HALF * g.lda * 2, hstepB = (size_t)HALF * g.ldb * 2;
    const size_t tstepA = 2 * hstepA, tstepB = 2 * hstepB;
    const unsigned ldsw = (unsigned)wid * 1024u;
    const int aoff = lds_byte(wr * 64 + fr, fq * 8), boff = lds_byte(wc * 32 + fr, fq * 8);
#define PG8_SA(b, h) (((b) * 2 + (h)) * HTB)
#define PG8_SB(b, h) ((4 + (b) * 2 + (h)) * HTB)
#define PG8_STAGE(bufoff, gbase, voff) do { _Pragma("unroll") for (int _i = 0; _i < 2; ++_i) \
        __builtin_amdgcn_global_load_lds((const unsigned*)((const char*)(gbase) + (voff)[_i]), (LAS unsigned*)(lds + (bufoff) + ldsw + _i * 8192), 16, 0, 0); } while (0)
#define PG8_LDA(dst, b, h) do { _Pragma("unroll") for (int m = 0; m < 4; ++m) _Pragma("unroll") for (int k = 0; k < 2; ++k) dst[m][k] = *(const LAS bf16x8*)(lds + PG8_SA(b, h) + aoff + m * 2048 + k * 1024); } while (0)
#define PG8_LDB(dst, b, h) do { _Pragma("unroll") for (int n = 0; n < 2; ++n) _Pragma("unroll") for (int k = 0; k < 2; ++k) dst[n][k] = *(const LAS bf16x8*)(lds + PG8_SB(b, h) + boff + n * 2048 + k * 1024); } while (0)
#define PG8_MMA(ai, bj, At, Bt) do { __builtin_amdgcn_s_setprio(1); _Pragma("unroll") for (int m = 0; m < 4; ++m) _Pragma("unroll") for (int n = 0; n < 2; ++n) _Pragma("unroll") for (int k = 0; k < 2; ++k) \
        acc[ai][bj][m][n] = __builtin_amdgcn_mfma_f32_16x16x32_bf16(Bt[n][k], At[m][k], acc[ai][bj][m][n], 0, 0, 0); __builtin_amdgcn_s_setprio(0); } while (0)
#define PG8_WAIT_V(n) asm volatile("s_waitcnt vmcnt(" #n ")" ::: "memory")
#define PG8_WAIT_L(n) asm volatile("s_waitcnt lgkmcnt(" #n ")" ::: "memory")
#define PG8_BAR __builtin_amdgcn_s_barrier()
#define PG8_SCHED __builtin_amdgcn_sched_barrier(0)
    Unit cur, nxt; int ui = 0;
    if (!S.next(0, cur)) return;
    f32x4 acc[2][2][4][2];
#pragma unroll
    for (int a = 0; a < 2; ++a)
#pragma unroll
        for (int b = 0; b < 2; ++b)
#pragma unroll
            for (int m = 0; m < 4; ++m)
#pragma unroll
                for (int n = 0; n < 2; ++n) acc[a][b][m][n] = (f32x4){0.f, 0.f, 0.f, 0.f};
    bf16x8 At[4][2], B0[2][2], B1[2][2];
    const char* cA = (const char*)g.A + (size_t)cur.pm * tstepA; const char* cB = (const char*)g.Bt + (size_t)cur.pn * tstepB;
    PG8_STAGE(PG8_SB(0, 0), cB, voffB); PG8_STAGE(PG8_SB(0, 1), cB + hstepB, voffB); PG8_STAGE(PG8_SA(0, 0), cA, voffA); PG8_STAGE(PG8_SA(0, 1), cA + hstepA, voffA);
    if (wr == 1) PG8_BAR;
    PG8_WAIT_V(2); PG8_BAR;
    PG8_STAGE(PG8_SB(1, 0), cB + kstep, voffB); PG8_STAGE(PG8_SA(1, 0), cA + kstep, voffA); PG8_STAGE(PG8_SB(1, 1), cB + hstepB + kstep, voffB);
    PG8_WAIT_V(6); PG8_BAR;
    for (;;) {
        const bool has_next = S.next(ui + 1, nxt);
        const char* nA = has_next ? (const char*)g.A + (size_t)nxt.pm * tstepA : cA; const char* nB = has_next ? (const char*)g.Bt + (size_t)nxt.pn * tstepB : cB;
        for (int t = 0; t < nt; t += 2) {
            const bool last = (t == nt - 2);
            const char* a1 = cA + (size_t)(t + 1) * kstep;
            const char* a2 = last ? nA : cA + (size_t)(t + 2) * kstep; const char* b2 = last ? nB : cB + (size_t)(t + 2) * kstep;
            const char* a3 = a2 + kstep; const char* b3 = b2 + kstep;
            PG8_LDB(B0, 0, 0); PG8_LDB(B1, 0, 1); PG8_SCHED; PG8_LDA(At, 0, 0); PG8_STAGE(PG8_SA(1, 1), a1 + hstepA, voffA);
            PG8_WAIT_V(8); PG8_WAIT_L(0); PG8_BAR; PG8_MMA(0, 0, At, B0); PG8_MMA(0, 1, At, B1); PG8_BAR; PG8_SCHED;
            PG8_LDA(At, 0, 1); PG8_STAGE(PG8_SB(0, 0), b2, voffB); PG8_STAGE(PG8_SB(0, 1), b2 + hstepB, voffB); PG8_STAGE(PG8_SA(0, 0), a2, voffA);
            PG8_WAIT_V(8); PG8_WAIT_L(0); PG8_BAR; PG8_MMA(1, 0, At, B0); PG8_MMA(1, 1, At, B1); PG8_BAR; PG8_SCHED;
            PG8_LDB(B0, 1, 0); PG8_LDB(B1, 1, 1); PG8_SCHED; PG8_LDA(At, 1, 0); PG8_STAGE(PG8_SA(0, 1), a2 + hstepA, voffA);
            PG8_WAIT_V(8); PG8_WAIT_L(0); PG8_BAR; PG8_MMA(0, 0, At, B0); PG8_MMA(0, 1, At, B1); PG8_BAR; PG8_SCHED;
            PG8_LDA(At, 1, 1); PG8_STAGE(PG8_SB(1, 0), b3, voffB); PG8_STAGE(PG8_SB(1, 1), b3 + hstepB, voffB); PG8_STAGE(PG8_SA(1, 0), a3, voffA);
            PG8_WAIT_V(8); PG8_WAIT_L(0); PG8_BAR; PG8_MMA(1, 0, At, B0); PG8_MMA(1, 1, At, B1); PG8_BAR; PG8_SCHED;
        }
        if (wr == 0) PG8_BAR;
        E(acc, cur, wr, wc, fr, fq);
        if (!has_next) break;
#pragma unroll
        for (int a = 0; a < 2; ++a)
#pragma unroll
            for (int b = 0; b < 2; ++b)
#pragma unroll
                for (int m = 0; m < 4; ++m)
#pragma unroll
                    for (int n = 0; n < 2; ++n) acc[a][b][m][n] = (f32x4){0.f, 0.f, 0.f, 0.f};
        cur = nxt; cA = nA; cB = nB; ++ui;
        if (wr == 1) PG8_BAR;
    }
    PG8_WAIT_V(0);
    PG8_BAR;
#undef PG8_SA
#undef PG8_SB
#undef PG8_STAGE
#undef PG8_LDA
#undef PG8_LDB
#undef PG8_MMA
#undef PG8_WAIT_V
#undef PG8_WAIT_L
#undef PG8_BAR
#undef PG8_SCHED
}
}
typedef f32x4 AccT[2][2][4][2];
#define EPI_LOOP_ROWS for (int ai = 0; ai < 2; ++ai) _Pragma("unroll") for (int m = 0; m < 4; ++m)

struct EpiIn {
    static constexpr bool PERM = true;
    bf16_t* U; float* DT; const float* rstd; const float* dtb;
    __device__ __forceinline__ void operator()(const AccT& acc, const pg8::Unit& u, int wr, int wc, int fr, int fq) const {
#pragma unroll
        EPI_LOOP_ROWS {
            const int row = u.pm * 256 + ai * 128 + wr * 64 + m * 16 + fr; const float rs = rstd[row]; bf16_t* rowp = U + (size_t)row * INW;
#pragma unroll
            for (int bj = 0; bj < 2; ++bj) { const int col0 = u.pn * 256 + bj * 128 + wc * 32 + 8 * fq;
                if (col0 < INW) { const f32x4 v0 = acc[ai][bj][m][0] * rs, v1 = acc[ai][bj][m][1] * rs;
                    u32x4 w; w.x = cvt_pk_bf16(v0[0], v0[1]); w.y = cvt_pk_bf16(v0[2], v0[3]); w.z = cvt_pk_bf16(v1[0], v1[1]); w.w = cvt_pk_bf16(v1[2], v1[3]);
                    *(u32x4*)(rowp + col0) = w;
                    if (col0 >= ODT && col0 < ODT + 16) { const int d0 = col0 - ODT; float* dp = DT + (size_t)row * 16 + d0;
#pragma unroll
                        for (int i = 0; i < 4; ++i) { float x = v0[i] + dtb[d0 + i]; dp[i] = x > 20.f ? x : log1pf(__expf(x)); x = v1[i] + dtb[d0 + 4 + i]; dp[4 + i] = x > 20.f ? x : log1pf(__expf(x)); } } } }
        }
    }
};
template <int SECOND> struct EpiGate {
    static constexpr bool PERM = true;
    const bf16_t* U; bf16_t* MG;
    __device__ __forceinline__ void operator()(const AccT& acc, const pg8::Unit& u, int wr, int wc, int fr, int fq) const {
#pragma unroll
        EPI_LOOP_ROWS {
            const int row = u.pm * 256 + ai * 128 + wr * 64 + m * 16 + fr; const bf16_t* gp = U + (size_t)row * INW + (SECOND ? OGB : OGA); bf16_t* op = MG + (size_t)row * DM;
#pragma unroll
            for (int bj = 0; bj < 2; ++bj) { const int col0 = u.pn * 256 + bj * 128 + wc * 32 + 8 * fq;
                const u32x4 gv = *(const u32x4*)(gp + col0); const f32x4 a0 = acc[ai][bj][m][0], a1 = acc[ai][bj][m][1];
                float r[8];
                r[0] = sigmoidf_(bflo(gv.x)) * a0[0]; r[1] = sigmoidf_(bfhi(gv.x)) * a0[1]; r[2] = sigmoidf_(bflo(gv.y)) * a0[2]; r[3] = sigmoidf_(bfhi(gv.y)) * a0[3];
                r[4] = sigmoidf_(bflo(gv.z)) * a1[0]; r[5] = sigmoidf_(bfhi(gv.z)) * a1[1]; r[6] = sigmoidf_(bflo(gv.w)) * a1[2]; r[7] = sigmoidf_(bfhi(gv.w)) * a1[3];
                if (SECOND) { const u32x4 pv = *(const u32x4*)(op + col0);
                    r[0] += bflo(pv.x); r[1] += bfhi(pv.x); r[2] += bflo(pv.y); r[3] += bfhi(pv.y); r[4] += bflo(pv.z); r[5] += bfhi(pv.z); r[6] += bflo(pv.w); r[7] += bfhi(pv.w); }
                u32x4 w; w.x = cvt_pk_bf16(r[0], r[1]); w.y = cvt_pk_bf16(r[2], r[3]); w.z = cvt_pk_bf16(r[4], r[5]); w.w = cvt_pk_bf16(r[6], r[7]);
                *(u32x4*)(op + col0) = w; }
        }
    }
};
template <int WITH_BF> struct EpiRes {
    static constexpr bool PERM = true;
    const float* base_p; const float* base_s; float* X; bf16_t* XB; float* ssq;
    __device__ __forceinline__ void operator()(const AccT& acc, const pg8::Unit& u, int wr, int wc, int fr, int fq) const {
#pragma unroll
        EPI_LOOP_ROWS {
            const int row = u.pm * 256 + ai * 128 + wr * 64 + m * 16 + fr;
            const float* bp = row < MP ? base_p + (size_t)row * DM : base_s + (size_t)(row - MP) * DM; float* xp = X + (size_t)row * DM;
            float ss = 0.f;
#pragma unroll
            for (int bj = 0; bj < 2; ++bj) { const int col0 = u.pn * 256 + bj * 128 + wc * 32 + 8 * fq;
                const f32x4 b0 = *(const f32x4*)(bp + col0), b1 = *(const f32x4*)(bp + col0 + 4);
                const f32x4 v0 = b0 + acc[ai][bj][m][0], v1 = b1 + acc[ai][bj][m][1];
                *(f32x4*)(xp + col0) = v0; *(f32x4*)(xp + col0 + 4) = v1;
                ss += (v0[0] * v0[0] + v0[1] * v0[1]) + (v0[2] * v0[2] + v0[3] * v0[3]) + (v1[0] * v1[0] + v1[1] * v1[1]) + (v1[2] * v1[2] + v1[3] * v1[3]);
                if (WITH_BF) { u32x4 w; w.x = cvt_pk_bf16(v0[0], v0[1]); w.y = cvt_pk_bf16(v0[2], v0[3]); w.z = cvt_pk_bf16(v1[0], v1[1]); w.w = cvt_pk_bf16(v1[2], v1[3]);
                    *(u32x4*)(XB + (size_t)row * DM + col0) = w; } }
            ss += __shfl_xor(ss, 16); ss += __shfl_xor(ss, 32);
            if (fq == 0) atomicAdd(ssq + row, ss);
        }
    }
};
struct EpiUp {
    static constexpr bool PERM = true;
    const float* ssq2; bf16_t* ACT;
    __device__ __forceinline__ void operator()(const AccT& acc, const pg8::Unit& u, int wr, int wc, int fr, int fq) const {
#pragma unroll
        EPI_LOOP_ROWS {
            const int row = u.pm * 256 + ai * 128 + wr * 64 + m * 16 + fr; const float rs = rsqrtf(ssq2[row] * (1.f / DM) + EPS); bf16_t* op = ACT + (size_t)row * DFF;
#pragma unroll
            for (int bj = 0; bj < 2; ++bj) { const int col0 = u.pn * 256 + bj * 128 + wc * 32 + 8 * fq;
                f32x4 v0 = acc[ai][bj][m][0] * rs, v1 = acc[ai][bj][m][1] * rs;
#pragma unroll
                for (int i = 0; i < 4; ++i) { const float a = fmaxf(v0[i], 0.f), b = fmaxf(v1[i], 0.f); v0[i] = a * a; v1[i] = b * b; }
                u32x4 w; w.x = cvt_pk_bf16(v0[0], v0[1]); w.y = cvt_pk_bf16(v0[2], v0[3]); w.z = cvt_pk_bf16(v1[0], v1[1]); w.w = cvt_pk_bf16(v1[2], v1[3]);
                *(u32x4*)(op + col0) = w; }
        }
    }
};

__device__ __forceinline__ void transpose_item(const float* W, int K, int N, const float* scale, bf16_t* WT, LAS float* scr, int item, int nblk, int lane) {
    const int kb = item / nblk, nb = item % nblk, k0 = 64 * kb, n0 = 32 * nb;
    const int n = n0 + (lane & 31);
#pragma unroll 8
    for (int i = 0; i < 32; ++i) { const int kk = 2 * i + (lane >> 5); float v = 0.f; if (n < N) { v = W[(size_t)(k0 + kk) * N + n]; if (scale) v *= scale[k0 + kk]; } scr[kk * 33 + (lane & 31)] = v; }
    LDS_WAIT();
    const int c = lane & 7;
#pragma unroll
    for (int j = 0; j < 4; ++j) { const int nn = (lane >> 3) + 8 * j; const LAS float* s = scr + (8 * c) * 33 + nn;
        u32x4 o; o.x = pk2(s[0 * 33], s[1 * 33]); o.y = pk2(s[2 * 33], s[3 * 33]); o.z = pk2(s[4 * 33], s[5 * 33]); o.w = pk2(s[6 * 33], s[7 * 33]);
        *(u32x4*)(WT + (size_t)(n0 + nn) * K + k0 + 8 * c) = o; }
    LDS_WAIT();
}

constexpr int KS_LD = 72;
__device__ __forceinline__ void attn_tile(const LAS bf16_t* Ks, const LAS bf16_t* Vt, bf16_t* qptr, int kt0, int rq, int kmin, float sink, int lane) {
    const int c16 = lane & 15, quad = lane >> 4;
    bf16x8 qf[2];
    qf[0] = *(const bf16x8*)(qptr + quad * 8); qf[1] = *(const bf16x8*)(qptr + 32 + quad * 8);
    f32x4 s[10];
#pragma unroll
    for (int j = 0; j < 10; ++j) { s[j] = (f32x4){0.f, 0.f, 0.f, 0.f};
#pragma unroll
        for (int ks = 0; ks < 2; ++ks) { const bf16x8 kf = *(const LAS bf16x8*)(Ks + ((kt0 + j) * 16 + c16) * KS_LD + ks * 32 + quad * 8); s[j] = MFMA16(kf, qf[ks], s[j]); } }
    float mx = sink;
#pragma unroll
    for (int j = 0; j < 10; ++j)
#pragma unroll
        for (int jj = 0; jj < 4; ++jj) { const int kidx = (kt0 + j) * 16 + quad * 4 + jj; const bool ok = (kidx >= rq) && (kidx <= rq + 128) && (kidx >= kmin);
            const float v = ok ? s[j][jj] * 0.125f : -INFINITY; s[j][jj] = v; mx = fmaxf(mx, v); }
    mx = fmaxf(mx, __shfl_xor(mx, 16)); mx = fmaxf(mx, __shfl_xor(mx, 32));
    float sum = 0.f;
#pragma unroll
    for (int j = 0; j < 10; ++j)
#pragma unroll
        for (int jj = 0; jj < 4; ++jj) { const float p = __expf(s[j][jj] - mx); s[j][jj] = p; sum += p; }
    sum += __shfl_xor(sum, 16); sum += __shfl_xor(sum, 32); sum += __expf(sink - mx);
    const float inv = 1.f / sum;
    f32x4 o[4];
#pragma unroll
    for (int dt = 0; dt < 4; ++dt) o[dt] = (f32x4){0.f, 0.f, 0.f, 0.f};
    const unsigned vaddr = LDSADDR(Vt) + (unsigned)(((kt0 * 16 + quad * 4 + (c16 >> 2)) * KS_LD + 4 * (c16 & 3)) * 2);
#pragma unroll
    for (int st = 0; st < 5; ++st) {
        u32x4 pw; pw.x = pk2(s[2 * st][0] * inv, s[2 * st][1] * inv); pw.y = pk2(s[2 * st][2] * inv, s[2 * st][3] * inv);
        pw.z = pk2(s[2 * st + 1][0] * inv, s[2 * st + 1][1] * inv); pw.w = pk2(s[2 * st + 1][2] * inv, s[2 * st + 1][3] * inv);
        const bf16x8 pf = __builtin_bit_cast(bf16x8, pw);
        bf16x8 vf[4]; tr_frag4<0, 32, 64, 96, 16 * KS_LD * 2>(vaddr + st * (32 * KS_LD * 2), vf);
#pragma unroll
        for (int dt = 0; dt < 4; ++dt) o[dt] = MFMA16(vf[dt], pf, o[dt]);
    }
#pragma unroll
    for (int dt = 0; dt < 4; ++dt) { u32x2 w; w.x = pk2(o[dt][0], o[dt][1]); w.y = pk2(o[dt][2], o[dt][3]); *(u32x2*)(qptr + dt * 16 + quad * 4) = w; }
}

__device__ __forceinline__ const float* kin(int k) {
    const __attribute__((address_space(4))) unsigned char* ka = (const __attribute__((address_space(4))) unsigned char*)__builtin_amdgcn_kernarg_segment_ptr();
    asm volatile("" : "+s"(ka));
    return *(const float* const __attribute__((address_space(4)))*)(ka + 8 * k);
}
struct Args { const float* in[22]; float* out; unsigned char* ws; int ph_lo, ph_hi; };

__global__ void __launch_bounds__(512, 2) mega(Args a) {
    extern __shared__ __attribute__((aligned(16))) unsigned char lds_raw[];
    LAS unsigned char* lds = (LAS unsigned char*)lds_raw;
    cg::grid_group grid = cg::this_grid();
    const int tid0 = threadIdx.x, w = __builtin_amdgcn_readfirstlane(tid0 >> 6), G = gridDim.x, bx = blockIdx.x;
    const int gw = bx * 8 + w, NGW = G * 8, NGT = G * 512;
#define LOCAL_IDS const int tid = opaque(tid0), lane = tid & 63, c16 = lane & 15, quad = lane >> 4; (void)c16; (void)quad; (void)lane;
    unsigned char* ws = a.ws; float* out = a.out;
    float* RSTD1 = (float*)(ws + WS_RSTD1); float* SSQ2 = (float*)(ws + WS_SSQ2); float* SSQF = (float*)(ws + WS_SSQF); float* CD = (float*)(ws + WS_CD);
    bf16_t* WIN = (bf16_t*)(ws + WS_WIN); bf16_t* WOA = (bf16_t*)(ws + WS_WOA); bf16_t* WOB = (bf16_t*)(ws + WS_WOB); bf16_t* WO = (bf16_t*)(ws + WS_WO);
    bf16_t* WUP = (bf16_t*)(ws + WS_WUP); bf16_t* WDN = (bf16_t*)(ws + WS_WDN);
    float* DT = (float*)(ws + WS_DT); bf16_t* U = (bf16_t*)(ws + WS_U); bf16_t* XC = (bf16_t*)(ws + WS_XC);
    bf16_t* MERGED = (bf16_t*)(ws + WS_MERGED); bf16_t* X1B = (bf16_t*)(ws + WS_X1B); bf16_t* ACT = (bf16_t*)(ws + WS_ACT);
    bf16_t* XB = (bf16_t*)(out + O_SS);
    bf16_t* STB = (bf16_t*)(out + O_YP);
    float* X1 = out + O_YP;
    const int lo = a.ph_lo, hi = a.ph_hi;
#ifndef PHMASK
#define PHMASK 0x7ff
#endif
#define IN(k) (((PHMASK >> (k)) & 1) && lo <= (k) && (k) < hi)
    unsigned* BARW = (unsigned*)(ws + WS_BAR);
    if (lo < 0) grid.sync();
    unsigned bar_target = 0;
#define SEAM(k) do { if (IN(k) && IN((k) + 1)) { bar_target += (unsigned)G; \
        asm volatile("s_waitcnt vmcnt(0) lgkmcnt(0)" ::: "memory"); __syncthreads(); \
        if (tid0 == 0) { __builtin_amdgcn_fence(__ATOMIC_RELEASE, "agent"); asm volatile("s_waitcnt vmcnt(0)" ::: "memory"); \
            __hip_atomic_fetch_add(BARW, 1u, __ATOMIC_RELAXED, __HIP_MEMORY_SCOPE_AGENT); unsigned sp_ = 0; \
            while (__hip_atomic_load(BARW, __ATOMIC_RELAXED, __HIP_MEMORY_SCOPE_AGENT) < bar_target) { __builtin_amdgcn_s_sleep(2); if (++sp_ > (1u << 24)) break; } \
            __builtin_amdgcn_fence(__ATOMIC_ACQUIRE, "agent"); asm volatile("s_waitcnt vmcnt(0)" ::: "memory"); } \
        __syncthreads(); } } while (0)

    if (IN(0)) {
        const float* x_p = kin(0); const float* x_s = kin(1); const float* norm1 = kin(6); const float* w_in = kin(7); const float* ssm_norm = kin(14); const float* w_oa = kin(15); const float* w_ob = kin(16); const float* w_o = kin(17);
        LOCAL_IDS const int gtid = bx * 512 + tid;
        LAS float* scr = (LAS float*)(lds + w * 8448);
        constexpr int I_IN = 16 * 176, I_OA = 8 * 32, I_OB = 16 * 32, I_O = 16 * 32;
        for (int it = gw; it < I_IN + I_OA + I_OB + I_O; it += NGW) {
            int r = it;
            if (r < I_IN) { transpose_item(w_in, DM, INW, norm1, WIN, scr, r, 176, lane); continue; } r -= I_IN;
            if (r < I_OA) { transpose_item(w_oa, 512, DM, nullptr, WOA, scr, r, 32, lane); continue; } r -= I_OA;
            if (r < I_OB) { transpose_item(w_ob, DM, DM, ssm_norm, WOB, scr, r, 32, lane); continue; } r -= I_OB;
            transpose_item(w_o, DM, DM, nullptr, WO, scr, r, 32, lane);
        }
        for (int m = gw; m < M; m += NGW) {
            const float* xr = m < MP ? x_p + (size_t)m * DM : x_s + (size_t)(m - MP) * DM;
            f32x4 v[4]; float ss = 0.f;
#pragma unroll
            for (int j = 0; j < 4; ++j) { v[j] = *(const f32x4*)(xr + lane * 4 + 256 * j); ss += (v[j][0] * v[j][0] + v[j][1] * v[j][1]) + (v[j][2] * v[j][2] + v[j][3] * v[j][3]); }
            ss = wave_sum(ss);
            if (lane == 0) RSTD1[m] = rsqrtf(ss * (1.f / DM) + EPS);
#pragma unroll
            for (int j = 0; j < 4; ++j) { u32x2 o; o.x = pk2(v[j][0], v[j][1]); o.y = pk2(v[j][2], v[j][3]); *(u32x2*)(XB + (size_t)m * DM + lane * 4 + 256 * j) = o; }
        }
        for (int i = gtid; i < M; i += NGT) { SSQ2[i] = 0.f; SSQF[i] = 0.f; }
    }
    SEAM(0);
    if (IN(1)) {
        const float* dt_bias = kin(11);
        pg8::Gemm g{XB, WIN, M, NPAD, DM, DM, DM}; pg8::StaticOrder S; S.init(M, NPAD, G, bx);
        EpiIn E{U, DT, RSTD1, dt_bias};
        pg8::gemm_phase<EpiIn>(lds, g, S, E);
    }
    SEAM(1);
    if (IN(2)) {
        const float* cache_k = kin(2); const float* cache_v = kin(3); const float* state_conv = kin(4); const float* sinks = kin(8); const float* conv_w = kin(9); const float* conv_b = kin(10);
        for (int item = bx; item < 576; item += G) {
            LOCAL_IDS
            if (tid < 384) {
                const int cgi = tid % 192, half = tid / 192, ch0 = cgi * 8;
                float wv[4][8], bias[8];
#pragma unroll
                for (int i = 0; i < 4; ++i) { const f32x4 t0 = *(const f32x4*)(conv_w + i * CONVD + ch0), t1 = *(const f32x4*)(conv_w + i * CONVD + ch0 + 4);
#pragma unroll
                    for (int k = 0; k < 4; ++k) { wv[i][k] = t0[k]; wv[i][4 + k] = t1[k]; } }
                { const f32x4 t0 = *(const f32x4*)(conv_b + ch0), t1 = *(const f32x4*)(conv_b + ch0 + 4);
#pragma unroll
                  for (int k = 0; k < 4; ++k) { bias[k] = t0[k]; bias[4 + k] = t1[k]; } }
                float x0[8], x1[8], x2[8], x3[8];
                int nrows, rowbase; bool prompt = item < 512; int b, t0;
                if (prompt) { b = item >> 6; t0 = (item & 63) * 32 + half * 16; nrows = 16; rowbase = b * SEQ + t0;
#pragma unroll
                    for (int k = 0; k < 8; ++k) { x0[k] = 0.f; x1[k] = 0.f; x2[k] = 0.f; }
                    if (t0 > 0) { const u32x4 r0 = *(const u32x4*)(U + (size_t)(rowbase - 3) * INW + OX + ch0), r1 = *(const u32x4*)(U + (size_t)(rowbase - 2) * INW + OX + ch0), r2 = *(const u32x4*)(U + (size_t)(rowbase - 1) * INW + OX + ch0);
                        x0[0] = bflo(r0.x); x0[1] = bfhi(r0.x); x0[2] = bflo(r0.y); x0[3] = bfhi(r0.y); x0[4] = bflo(r0.z); x0[5] = bfhi(r0.z); x0[6] = bflo(r0.w); x0[7] = bfhi(r0.w);
                        x1[0] = bflo(r1.x); x1[1] = bfhi(r1.x); x1[2] = bflo(r1.y); x1[3] = bfhi(r1.y); x1[4] = bflo(r1.z); x1[5] = bfhi(r1.z); x1[6] = bflo(r1.w); x1[7] = bfhi(r1.w);
                        x2[0] = bflo(r2.x); x2[1] = bfhi(r2.x); x2[2] = bflo(r2.y); x2[3] = bfhi(r2.y); x2[4] = bflo(r2.z); x2[5] = bfhi(r2.z); x2[6] = bflo(r2.w); x2[7] = bfhi(r2.w); }
                } else { b = (item - 512) * 2 + half; t0 = 0; nrows = 4; rowbase = MP + b * 4;
                    const float* sp = state_conv + (size_t)b * 3 * CONVD + ch0;
#pragma unroll
                    for (int k = 0; k < 8; ++k) { x0[k] = sp[k]; x1[k] = sp[CONVD + k]; x2[k] = sp[2 * CONVD + k]; }
                }
                for (int tt = 0; tt < nrows; ++tt) {
                    const u32x4 r3 = *(const u32x4*)(U + (size_t)(rowbase + tt) * INW + OX + ch0);
                    x3[0] = bflo(r3.x); x3[1] = bfhi(r3.x); x3[2] = bflo(r3.y); x3[3] = bfhi(r3.y); x3[4] = bflo(r3.z); x3[5] = bfhi(r3.z); x3[6] = bflo(r3.w); x3[7] = bfhi(r3.w);
                    float y[8];
#pragma unroll
                    for (int k = 0; k < 8; ++k) { const float s = bias[k] + x0[k] * wv[0][k] + x1[k] * wv[1][k] + x2[k] * wv[2][k] + x3[k] * wv[3][k]; y[k] = siluf_(s); }
                    u32x4 o; o.x = pk2(y[0], y[1]); o.y = pk2(y[2], y[3]); o.z = pk2(y[4], y[5]); o.w = pk2(y[6], y[7]);
                    *(u32x4*)(XC + (size_t)(rowbase + tt) * CONVD + ch0) = o;
                    int oj = -1; float* obase = nullptr;
                    if (prompt) { if (t0 + tt >= SEQ - 3) { oj = t0 + tt - (SEQ - 3); obase = out + O_CP + (size_t)b * 3 * CONVD; } }
                    else { if (tt >= 1) { oj = tt - 1; obase = out + O_CS + (size_t)b * 3 * CONVD; } }
                    if (oj >= 0) { float* op = obase + (size_t)oj * CONVD + ch0; *(f32x4*)op = (f32x4){x3[0], x3[1], x3[2], x3[3]}; *(f32x4*)(op + 4) = (f32x4){x3[4], x3[5], x3[6], x3[7]}; }
#pragma unroll
                    for (int k = 0; k < 8; ++k) { x0[k] = x1[k]; x1[k] = x2[k]; x2[k] = x3[k]; }
                }
            }
        }
        LAS bf16_t* Ks = (LAS bf16_t*)lds; LAS bf16_t* Vt = (LAS bf16_t*)(lds + 272 * KS_LD * 2);
        for (int unit = bx; unit < 256; unit += G) {
            LOCAL_IDS const int b = unit >> 5, qblk = (unit >> 1) & 15, kvh = unit & 1;
            __syncthreads();
            for (int pc = tid; pc < 272 * 8; pc += 512) { const int kidx = pc >> 3, part = pc & 7; const int tok = (qblk - 1) * 128 + kidx;
                u32x4 kv = (u32x4){0u, 0u, 0u, 0u}, vv = (u32x4){0u, 0u, 0u, 0u};
                if (kidx < 256 && tok >= 0) { const bf16_t* rp = U + (size_t)(b * SEQ + tok) * INW + kvh * 64 + part * 8; kv = *(const u32x4*)(rp + OKK); vv = *(const u32x4*)(rp + OV);
                    if (qblk == 15 && kidx >= 128) { const size_t oo = ((size_t)(b * 128 + kidx - 128) * 2 + kvh) * 64 + part * 8;
                        *(f32x4*)(out + O_KP + oo) = (f32x4){bflo(kv.x), bfhi(kv.x), bflo(kv.y), bfhi(kv.y)}; *(f32x4*)(out + O_KP + oo + 4) = (f32x4){bflo(kv.z), bfhi(kv.z), bflo(kv.w), bfhi(kv.w)};
                        *(f32x4*)(out + O_VP + oo) = (f32x4){bflo(vv.x), bfhi(vv.x), bflo(vv.y), bfhi(vv.y)}; *(f32x4*)(out + O_VP + oo + 4) = (f32x4){bflo(vv.z), bfhi(vv.z), bflo(vv.w), bfhi(vv.w)}; } }
                *(LAS u32x4*)(Ks + kidx * KS_LD + part * 8) = kv; *(LAS u32x4*)(Vt + kidx * KS_LD + part * 8) = vv; }
            __syncthreads();
            const int hq = kvh * 4 + (w >> 1), qh = w & 1; const float sink = sinks[hq];
            for (int i = 0; i < 4; ++i) { const int r0 = qh * 64 + i * 16;
                bf16_t* qp = U + (size_t)(b * SEQ + qblk * 128 + r0 + c16) * INW + hq * 64;
                attn_tile(Ks, Vt, qp, r0 >> 4, r0 + c16, qblk == 0 ? 128 : 0, sink, lane); }
        }
        for (int unit = bx; unit < 256; unit += G) {
            LOCAL_IDS const int b = unit >> 1, kvh = unit & 1;
            __syncthreads();
            for (int pc = tid; pc < 160 * 8; pc += 512) { const int kidx = pc >> 3, part = pc & 7;
                float kf[8], vf[8];
#pragma unroll
                for (int i = 0; i < 8; ++i) { kf[i] = 0.f; vf[i] = 0.f; }
                if (kidx < 128) { const size_t io = ((size_t)(b * 128 + kidx) * 2 + kvh) * 64 + part * 8;
                    const f32x4 k0 = *(const f32x4*)(cache_k + io), k1 = *(const f32x4*)(cache_k + io + 4), v0 = *(const f32x4*)(cache_v + io), v1 = *(const f32x4*)(cache_v + io + 4);
#pragma unroll
                    for (int i = 0; i < 4; ++i) { kf[i] = k0[i]; kf[4 + i] = k1[i]; vf[i] = v0[i]; vf[4 + i] = v1[i]; }
                } else if (kidx < 132) { const bf16_t* rp = U + (size_t)(MP + b * 4 + kidx - 128) * INW + kvh * 64 + part * 8; const u32x4 kv = *(const u32x4*)(rp + OKK), vv = *(const u32x4*)(rp + OV);
                    kf[0] = bflo(kv.x); kf[1] = bfhi(kv.x); kf[2] = bflo(kv.y); kf[3] = bfhi(kv.y); kf[4] = bflo(kv.z); kf[5] = bfhi(kv.z); kf[6] = bflo(kv.w); kf[7] = bfhi(kv.w);
                    vf[0] = bflo(vv.x); vf[1] = bfhi(vv.x); vf[2] = bflo(vv.y); vf[3] = bfhi(vv.y); vf[4] = bflo(vv.z); vf[5] = bfhi(vv.z); vf[6] = bflo(vv.w); vf[7] = bfhi(vv.w); }
                if (kidx >= 4 && kidx < 132) { const size_t oo = ((size_t)(b * 128 + kidx - 4) * 2 + kvh) * 64 + part * 8;
                    *(f32x4*)(out + O_KS + oo) = (f32x4){kf[0], kf[1], kf[2], kf[3]}; *(f32x4*)(out + O_KS + oo + 4) = (f32x4){kf[4], kf[5], kf[6], kf[7]};
                    *(f32x4*)(out + O_VS + oo) = (f32x4){vf[0], vf[1], vf[2], vf[3]}; *(f32x4*)(out + O_VS + oo + 4) = (f32x4){vf[4], vf[5], vf[6], vf[7]}; }
                u32x4 kw; kw.x = pk2(kf[0], kf[1]); kw.y = pk2(kf[2], kf[3]); kw.z = pk2(kf[4], kf[5]); kw.w = pk2(kf[6], kf[7]);
                u32x4 vw; vw.x = pk2(vf[0], vf[1]); vw.y = pk2(vf[2], vf[3]); vw.z = pk2(vf[4], vf[5]); vw.w = pk2(vf[6], vf[7]);
                *(LAS u32x4*)(Ks + kidx * KS_LD + part * 8) = kw; *(LAS u32x4*)(Vt + kidx * KS_LD + part * 8) = vw; }
            __syncthreads();
            if (w == 0) { const int gq = c16 >> 2, t = c16 & 3, hq = kvh * 4 + gq;
                bf16_t* qp = U + (size_t)(MP + b * 4 + t) * INW + hq * 64;
                attn_tile(Ks, Vt, qp, 0, t, 0, sinks[hq], lane); }
        }
    }
    SEAM(2);
    if (IN(3)) {
        const float* state_ssm = kin(5); const float* a_log = kin(12); const float* d_skip = kin(13);
        {
            LAS bf16_t* Bt = (LAS bf16_t*)lds;
            LAS bf16_t* Xs = (LAS bf16_t*)(lds + 18432);
            LAS float* scl = (LAS float*)(lds + 18432 + 73728);
            for (int unit = bx; unit < 256; unit += G) {
                LOCAL_IDS const int b = unit >> 5, c = (unit >> 1) & 15, g = unit & 1, row0 = b * SEQ + c * 128, h = 8 * g + w;
                __syncthreads();
                { const float A = -__expf(a_log[h]);
                  const float d0 = DT[(size_t)(row0 + lane) * 16 + h], d1 = DT[(size_t)(row0 + 64 + lane) * 16 + h];
                  float v0 = d0 * A, v1 = d1 * A;
#pragma unroll
                  for (int o = 1; o < 64; o <<= 1) { const float t0 = __builtin_bit_cast(float, __builtin_amdgcn_ds_bpermute((lane - o) << 2, __builtin_bit_cast(int, v0))), t1 = __builtin_bit_cast(float, __builtin_amdgcn_ds_bpermute((lane - o) << 2, __builtin_bit_cast(int, v1))); if (lane >= o) { v0 += t0; v1 += t1; } }
                  v1 += __builtin_bit_cast(float, __builtin_amdgcn_readlane(__builtin_bit_cast(int, v0), 63)); const float last = __builtin_bit_cast(float, __builtin_amdgcn_readlane(__builtin_bit_cast(int, v1), 63));
                  scl[w * 128 + lane] = d0 * __expf(last - v0); scl[w * 128 + 64 + lane] = d1 * __expf(last - v1);
                  if (lane == 0) CD[(b * 16 + c) * 16 + h] = __expf(last); }
                f32x4 acc[8][4];
#pragma unroll
                for (int nt = 0; nt < 8; ++nt)
#pragma unroll
                    for (int pt = 0; pt < 4; ++pt) acc[nt][pt] = (f32x4){0.f, 0.f, 0.f, 0.f};
                for (int half = 0; half < 2; ++half) {
                    __syncthreads();
#pragma unroll 1
                    for (int pc = tid; pc < 1024; pc += 512) { const int lr = pc >> 4, part = pc & 15;
                        *(LAS u32x4*)(Bt + lr * 136 + part * 8) = *(const u32x4*)(XC + (size_t)(row0 + half * 64 + lr) * CONVD + 1024 + g * 128 + part * 8); }
#pragma unroll 1
                    for (int pc = tid; pc < 4096; pc += 512) { const int lr = pc >> 6, part = pc & 63, hh = part >> 3;
                        const u32x4 v = *(const u32x4*)(XC + (size_t)(row0 + half * 64 + lr) * CONVD + g * 512 + part * 8);
                        const float sc = scl[hh * 128 + half * 64 + lr];
                        u32x4 o; o.x = pk2(bflo(v.x) * sc, bfhi(v.x) * sc); o.y = pk2(bflo(v.y) * sc, bfhi(v.y) * sc); o.z = pk2(bflo(v.z) * sc, bfhi(v.z) * sc); o.w = pk2(bflo(v.w) * sc, bfhi(v.w) * sc);
                        *(LAS u32x4*)(Xs + (hh * 64 + lr) * 72 + (part & 7) * 8) = o; }
                    __syncthreads();
                    const unsigned baddr = LDSADDR(Bt) + (unsigned)(((quad * 8 + (c16 >> 2)) * 136 + 4 * (c16 & 3)) * 2);
                    const unsigned xaddr = LDSADDR(Xs) + (unsigned)(((w * 64 + quad * 8 + (c16 >> 2)) * 72 + 4 * (c16 & 3)) * 2);
#pragma unroll
                    for (int ks = 0; ks < 2; ++ks) { bf16x8 xf[4]; tr_frag4<0, 32, 64, 96, 4 * 144>(xaddr + ks * (32 * 144), xf);
#pragma unroll
                        for (int nh = 0; nh < 2; ++nh) { bf16x8 bfr[4]; tr_frag4<0, 32, 64, 96, 4 * 272>(baddr + ks * (32 * 272) + nh * 128, bfr);
#pragma unroll
                            for (int n4 = 0; n4 < 4; ++n4)
#pragma unroll
                                for (int pt = 0; pt < 4; ++pt) acc[nh * 4 + n4][pt] = MFMA16(bfr[n4], xf[pt], acc[nh * 4 + n4][pt]); } }
                }
                bf16_t* sp = STB + ((size_t)((b * 16 + c) * 16 + h) * 64) * 128;
#pragma unroll
                for (int nt = 0; nt < 8; ++nt)
#pragma unroll
                    for (int pt = 0; pt < 4; ++pt) { u32x2 o; o.x = pk2(acc[nt][pt][0], acc[nt][pt][1]); o.y = pk2(acc[nt][pt][2], acc[nt][pt][3]); *(u32x2*)(sp + (size_t)(pt * 16 + c16) * 128 + nt * 16 + quad * 4) = o; }
            }
        }
        {
            LAS float* xr = (LAS float*)lds;
            LAS float* xdt = (LAS float*)(lds + 8192);
            LAS float* vals = (LAS float*)(lds + 16384);
            LAS float* rs = (LAS float*)(lds + 24576);
            for (int unit = bx; unit < 256; unit += G) {
                LOCAL_IDS const int b = unit >> 1, g = unit & 1, h = 8 * g + w, R0 = MP + b * 4;
                __syncthreads();
                const float A = -__expf(a_log[h]); float dtv[4], dA[4];
#pragma unroll
                for (int t = 0; t < 4; ++t) { dtv[t] = DT[(size_t)(R0 + t) * 16 + h]; dA[t] = __expf(dtv[t] * A); }
                { const int t = quad, p0 = c16 * 4; const u32x2 v = *(const u32x2*)(XC + (size_t)(R0 + t) * CONVD + h * 64 + p0);
                  const float dtt = t == 0 ? dtv[0] : (t == 1 ? dtv[1] : (t == 2 ? dtv[2] : dtv[3]));
                  const float f0 = bflo(v.x), f1 = bfhi(v.x), f2 = bflo(v.y), f3 = bfhi(v.y);
                  LAS float* p = xr + (w * 4 + t) * 64 + p0; p[0] = f0; p[1] = f1; p[2] = f2; p[3] = f3;
                  LAS float* q = xdt + (w * 4 + t) * 64 + p0; q[0] = f0 * dtt; q[1] = f1 * dtt; q[2] = f2 * dtt; q[3] = f3 * dtt; }
                float Bv[4][8], Cv[4][8];
#pragma unroll
                for (int t = 0; t < 4; ++t) { const bf16_t* rp = XC + (size_t)(R0 + t) * CONVD + 1024 + g * 128 + c16 * 4;
                    const u32x2 b0 = *(const u32x2*)rp, b1 = *(const u32x2*)(rp + 64), c0 = *(const u32x2*)(rp + 256), c1 = *(const u32x2*)(rp + 320);
                    Bv[t][0] = bflo(b0.x); Bv[t][1] = bfhi(b0.x); Bv[t][2] = bflo(b0.y); Bv[t][3] = bfhi(b0.y); Bv[t][4] = bflo(b1.x); Bv[t][5] = bfhi(b1.x); Bv[t][6] = bflo(b1.y); Bv[t][7] = bfhi(b1.y);
                    Cv[t][0] = bflo(c0.x); Cv[t][1] = bfhi(c0.x); Cv[t][2] = bflo(c0.y); Cv[t][3] = bfhi(c0.y); Cv[t][4] = bflo(c1.x); Cv[t][5] = bfhi(c1.x); Cv[t][6] = bflo(c1.y); Cv[t][7] = bfhi(c1.y); }
                const float Dh = d_skip[h];
                LDS_WAIT();
                const float* sin_ = state_ssm + (size_t)(b * 16 + h) * 8192; float* sout = out + O_SS + (size_t)(b * 16 + h) * 8192;
#pragma unroll 2
                for (int i = 0; i < 16; ++i) { const int p = 4 * i + quad;
                    f32x4 h0 = *(const f32x4*)(sin_ + p * 128 + c16 * 4), h1 = *(const f32x4*)(sin_ + p * 128 + 64 + c16 * 4);
                    float yk = 0.f;
#pragma unroll
                    for (int t = 0; t < 4; ++t) { const float xd = xdt[(w * 4 + t) * 64 + p]; float y = 0.f;
#pragma unroll
                        for (int k = 0; k < 4; ++k) { h0[k] = h0[k] * dA[t] + xd * Bv[t][k]; y += h0[k] * Cv[t][k]; h1[k] = h1[k] * dA[t] + xd * Bv[t][4 + k]; y += h1[k] * Cv[t][4 + k]; }
                        y += __shfl_xor(y, 1); y += __shfl_xor(y, 2); y += __shfl_xor(y, 4); y += __shfl_xor(y, 8);
                        if (c16 == t) yk = y + Dh * xr[(w * 4 + t) * 64 + p]; }
                    *(f32x4*)(sout + p * 128 + c16 * 4) = h0; *(f32x4*)(sout + p * 128 + 64 + c16 * 4) = h1;
                    if (c16 < 4) { const float z = bf1(U[(size_t)(R0 + c16) * INW + OZ + h * 64 + p]); vals[(w * 4 + c16) * 64 + p] = yk * siluf_(z); } }
                __syncthreads();
                if (w < 4) { float s = 0.f;
#pragma unroll
                    for (int hh = 0; hh < 8; ++hh) { const float v = vals[(hh * 4 + w) * 64 + lane]; s += v * v; }
                    s = wave_sum(s); if (lane == 0) rs[w] = rsqrtf(s * (1.f / 512.f) + EPS); }
                __syncthreads();
                { const int t = tid >> 7, ch4 = (tid & 127) * 4, hh = ch4 >> 6, p = ch4 & 63; const float r = rs[t]; const LAS float* vp = vals + (hh * 4 + t) * 64 + p;
                  u32x2 o; o.x = pk2(vp[0] * r, vp[1] * r); o.y = pk2(vp[2] * r, vp[3] * r);
                  *(u32x2*)(U + (size_t)(R0 + t) * INW + OZ + g * 512 + ch4) = o; }
            }
        }
    }
    SEAM(3);
    if (IN(4)) {
        LOCAL_IDS const int gtid = bx * 512 + tid;
        for (int idx = gtid; idx < 131072; idx += NGT) { const int n8 = idx & 15, p = (idx >> 4) & 63, h = (idx >> 10) & 15, b = idx >> 14;
            float hc[8];
#pragma unroll
            for (int k = 0; k < 8; ++k) hc[k] = 0.f;
#pragma unroll
            for (int c = 0; c < 16; ++c) { bf16_t* ptr = STB + ((size_t)((b * 16 + c) * 16 + h) * 64 + p) * 128 + n8 * 8; const u32x4 sv = *(const u32x4*)ptr;
                u32x4 o; o.x = pk2(hc[0], hc[1]); o.y = pk2(hc[2], hc[3]); o.z = pk2(hc[4], hc[5]); o.w = pk2(hc[6], hc[7]); *(u32x4*)ptr = o;
                const float d = CD[(b * 16 + c) * 16 + h];
                hc[0] = hc[0] * d + bflo(sv.x); hc[1] = hc[1] * d + bfhi(sv.x); hc[2] = hc[2] * d + bflo(sv.y); hc[3] = hc[3] * d + bfhi(sv.y);
                hc[4] = hc[4] * d + bflo(sv.z); hc[5] = hc[5] * d + bfhi(sv.z); hc[6] = hc[6] * d + bflo(sv.w); hc[7] = hc[7] * d + bfhi(sv.w); }
            float* op = out + O_SP + ((size_t)(b * 16 + h) * 64 + p) * 128 + n8 * 8;
            *(f32x4*)op = (f32x4){hc[0], hc[1], hc[2], hc[3]}; *(f32x4*)(op + 4) = (f32x4){hc[4], hc[5], hc[6], hc[7]}; }
    }
    SEAM(4);
    if (IN(5)) {
        const float* a_log = kin(12); const float* d_skip = kin(13);
        LAS bf16_t* Cs = (LAS bf16_t*)lds; LAS bf16_t* Bs = (LAS bf16_t*)(lds + 34816); LAS bf16_t* CBs = (LAS bf16_t*)(lds + 69632);
        LAS bf16_t* Xt = (LAS bf16_t*)(lds + 104448 + w * 5120);
        LAS float* acs = (LAS float*)(lds + 145408); LAS float* dts = (LAS float*)(lds + 149504); LAS float* ssq = (LAS float*)(lds + 153600);
        for (int unit = bx; unit < 256; unit += G) {
            LOCAL_IDS const int b = unit >> 5, c = (unit >> 1) & 15, g = unit & 1, row0 = b * SEQ + c * 128, h = 8 * g + w;
            __syncthreads();
            { const float A = -__expf(a_log[h]);
              const float d0 = DT[(size_t)(row0 + lane) * 16 + h], d1 = DT[(size_t)(row0 + 64 + lane) * 16 + h];
              float v0 = d0 * A, v1 = d1 * A;
#pragma unroll
              for (int o = 1; o < 64; o <<= 1) { const float t0 = __builtin_bit_cast(float, __builtin_amdgcn_ds_bpermute((lane - o) << 2, __builtin_bit_cast(int, v0))), t1 = __builtin_bit_cast(float, __builtin_amdgcn_ds_bpermute((lane - o) << 2, __builtin_bit_cast(int, v1))); if (lane >= o) { v0 += t0; v1 += t1; } }
              v1 += __builtin_bit_cast(float, __builtin_amdgcn_readlane(__builtin_bit_cast(int, v0), 63));
              acs[w * 128 + lane] = v0; acs[w * 128 + 64 + lane] = v1; dts[w * 128 + lane] = d0; dts[w * 128 + 64 + lane] = d1; }
#pragma unroll 1
            for (int pc = tid; pc < 2048; pc += 512) { const int lr = pc >> 4, part = pc & 15; const bf16_t* rp = XC + (size_t)(row0 + lr) * CONVD + 1024 + g * 128 + part * 8;
                *(LAS u32x4*)(Bs + lr * 136 + part * 8) = *(const u32x4*)rp; *(LAS u32x4*)(Cs + lr * 136 + part * 8) = *(const u32x4*)(rp + 256); }
            __syncthreads();
            {
                bf16x8 bfr[4];
#pragma unroll
                for (int ks = 0; ks < 4; ++ks) bfr[ks] = *(const LAS bf16x8*)(Bs + (16 * w + c16) * 136 + ks * 32 + quad * 8);
#pragma unroll
                for (int lt = 0; lt < 8; ++lt) { f32x4 d = (f32x4){0.f, 0.f, 0.f, 0.f};
#pragma unroll
                    for (int ks = 0; ks < 4; ++ks) { const bf16x8 cfr = *(const LAS bf16x8*)(Cs + (lt * 16 + c16) * 136 + ks * 32 + quad * 8); d = MFMA16(bfr[ks], cfr, d); }
                    u32x2 o; o.x = pk2(d[0], d[1]); o.y = pk2(d[2], d[3]); *(LAS u32x2*)(CBs + (lt * 16 + c16) * 136 + 16 * w + quad * 4) = o; }
            }
            __syncthreads();
            f32x4 acc[4][8];
#pragma unroll
            for (int pt = 0; pt < 4; ++pt)
#pragma unroll
                for (int lt = 0; lt < 8; ++lt) acc[pt][lt] = (f32x4){0.f, 0.f, 0.f, 0.f};
            const bf16_t* Hp = STB + (size_t)((b * 16 + c) * 16 + h) * 8192;
#pragma unroll
            for (int ks = 0; ks < 4; ++ks) { bf16x8 hf[4];
#pragma unroll
                for (int pt = 0; pt < 4; ++pt) hf[pt] = *(const bf16x8*)(Hp + (pt * 16 + c16) * 128 + ks * 32 + quad * 8);
#pragma unroll
                for (int lt = 0; lt < 8; ++lt) { const bf16x8 cfr = *(const LAS bf16x8*)(Cs + (lt * 16 + c16) * 136 + ks * 32 + quad * 8);
#pragma unroll
                    for (int pt = 0; pt < 4; ++pt) acc[pt][lt] = MFMA16(hf[pt], cfr, acc[pt][lt]); }
                asm volatile("" ::: "memory"); }
#pragma unroll
            for (int lt = 0; lt < 8; ++lt) { const float e = __expf(acs[w * 128 + lt * 16 + c16]);
#pragma unroll
                for (int pt = 0; pt < 4; ++pt) acc[pt][lt] = acc[pt][lt] * e; }
#pragma unroll
            for (int sq = 0; sq < 4; ++sq) {
                asm volatile("s_waitcnt lgkmcnt(0)" ::: "memory");
#pragma unroll
                for (int k = 0; k < 4; ++k) { const int pc = lane + 64 * k, sr = pc >> 3, part = pc & 7;
                    *(LAS u32x4*)(Xt + sr * 72 + part * 8) = *(const u32x4*)(XC + (size_t)(row0 + sq * 32 + sr) * CONVD + h * 64 + part * 8); }
                asm volatile("s_waitcnt vmcnt(0) lgkmcnt(0)" ::: "memory");
                bf16x8 xf[4]; tr_frag4<0, 32, 64, 96, 4 * 144>(LDSADDR(Xt) + (unsigned)(((quad * 8 + (c16 >> 2)) * 72 + 4 * (c16 & 3)) * 2), xf);
                const f32x4 as0 = *(const LAS f32x4*)(acs + w * 128 + sq * 32 + quad * 8), as1 = *(const LAS f32x4*)(acs + w * 128 + sq * 32 + quad * 8 + 4);
                const f32x4 ds0 = *(const LAS f32x4*)(dts + w * 128 + sq * 32 + quad * 8), ds1 = *(const LAS f32x4*)(dts + w * 128 + sq * 32 + quad * 8 + 4);
#pragma unroll
                for (int lt = 0; lt < 8; ++lt) { if (lt >= 2 * sq) {
                    const int l = lt * 16 + c16; const float al = acs[w * 128 + l];
                    const u32x4 cb = *(const LAS u32x4*)(CBs + l * 136 + sq * 32 + quad * 8);
                    const int s0 = sq * 32 + quad * 8;
                    float wv[8];
                    wv[0] = bflo(cb.x); wv[1] = bfhi(cb.x); wv[2] = bflo(cb.y); wv[3] = bfhi(cb.y); wv[4] = bflo(cb.z); wv[5] = bfhi(cb.z); wv[6] = bflo(cb.w); wv[7] = bfhi(cb.w);
#pragma unroll
                    for (int i = 0; i < 4; ++i) { wv[i] = (s0 + i <= l) ? wv[i] * __expf(fminf(al - as0[i], 0.f)) * ds0[i] : 0.f; wv[4 + i] = (s0 + 4 + i <= l) ? wv[4 + i] * __expf(fminf(al - as1[i], 0.f)) * ds1[i] : 0.f; }
                    u32x4 ww; ww.x = pk2(wv[0], wv[1]); ww.y = pk2(wv[2], wv[3]); ww.z = pk2(wv[4], wv[5]); ww.w = pk2(wv[6], wv[7]);
                    const bf16x8 wf = __builtin_bit_cast(bf16x8, ww);
#pragma unroll
                    for (int pt = 0; pt < 4; ++pt) acc[pt][lt] = MFMA16(xf[pt], wf, acc[pt][lt]);
                    asm volatile("" ::: "memory"); } }
            }
            const float Dh = d_skip[h];
#pragma unroll
            for (int lt = 0; lt < 8; ++lt) { const int l = lt * 16 + c16; const size_t tok = (size_t)(row0 + l); float ss = 0.f;
#pragma unroll
                for (int pt = 0; pt < 4; ++pt) { const int pb = pt * 16 + quad * 4;
                    const u32x2 xv = *(const u32x2*)(XC + tok * CONVD + h * 64 + pb), zv = *(const u32x2*)(U + tok * INW + OZ + h * 64 + pb);
                    const float xf0 = bflo(xv.x), xf1 = bfhi(xv.x), xf2 = bflo(xv.y), xf3 = bfhi(xv.y);
                    const float z0 = bflo(zv.x), z1 = bfhi(zv.x), z2 = bflo(zv.y), z3 = bfhi(zv.y);
                    f32x4 v = acc[pt][lt];
                    v[0] = (v[0] + Dh * xf0) * siluf_(z0); v[1] = (v[1] + Dh * xf1) * siluf_(z1); v[2] = (v[2] + Dh * xf2) * siluf_(z2); v[3] = (v[3] + Dh * xf3) * siluf_(z3);
                    acc[pt][lt] = v; ss += (v[0] * v[0] + v[1] * v[1]) + (v[2] * v[2] + v[3] * v[3]); }
                ss += __shfl_xor(ss, 16); ss += __shfl_xor(ss, 32);
                if (quad == 0) ssq[w * 128 + l] = ss;
                asm volatile("" ::: "memory"); }
            __syncthreads();
#pragma unroll
            for (int lt = 0; lt < 8; ++lt) { const int l = lt * 16 + c16; const size_t tok = (size_t)(row0 + l); float s = 0.f;
#pragma unroll
                for (int ww = 0; ww < 8; ++ww) s += ssq[ww * 128 + l];
                const float r = rsqrtf(s * (1.f / 512.f) + EPS);
#pragma unroll
                for (int pt = 0; pt < 4; ++pt) { const f32x4 v = acc[pt][lt] * r; u32x2 o; o.x = pk2(v[0], v[1]); o.y = pk2(v[2], v[3]);
                    *(u32x2*)(U + tok * INW + OZ + h * 64 + pt * 16 + quad * 4) = o; }
                asm volatile("" ::: "memory"); }
        }
    }
    SEAM(5);
    if (IN(6)) {
        const float* norm2 = kin(18); const float* w_up = kin(19); const float* w_down = kin(20);
        { LOCAL_IDS LAS float* scr = (LAS float*)(lds + w * 8448);
          for (int it = gw; it < 4096; it += NGW) { if (it < 2048) transpose_item(w_up, DM, DFF, norm2, WUP, scr, it, 128, lane); else transpose_item(w_down, DFF, DM, nullptr, WDN, scr, it - 2048, 32, lane); }
          __syncthreads(); }
        { pg8::Gemm g{U + OQ, WOA, M, DM, 512, INW, 512}; pg8::StaticOrder S; S.init(M, DM, G, bx); EpiGate<0> E{U, MERGED}; pg8::gemm_phase<EpiGate<0>>(lds, g, S, E); }
        { pg8::Gemm g{U + OZ, WOB, M, DM, DM, INW, DM}; pg8::StaticOrder S; S.init(M, DM, G, bx); EpiGate<1> E{U, MERGED}; pg8::gemm_phase<EpiGate<1>>(lds, g, S, E); }
    }
    SEAM(6);
    if (IN(7)) {
        const float* x_p = kin(0); const float* x_s = kin(1);
        pg8::Gemm g{MERGED, WO, M, DM, DM, DM, DM}; pg8::StaticOrder S; S.init(M, DM, G, bx);
        EpiRes<1> E{x_p, x_s, X1, X1B, SSQ2}; pg8::gemm_phase<EpiRes<1>>(lds, g, S, E);
    }
    SEAM(7);
    if (IN(8)) {
        pg8::Gemm g{X1B, WUP, M, DFF, DM, DM, DM}; pg8::StaticOrder S; S.init(M, DFF, G, bx);
        EpiUp E{SSQ2, ACT}; pg8::gemm_phase<EpiUp>(lds, g, S, E);
    }
    SEAM(8);
    if (IN(9)) {
        pg8::Gemm g{ACT, WDN, M, DM, DFF, DFF, DFF}; pg8::StaticOrder S; S.init(M, DM, G, bx);
        EpiRes<0> E{X1, X1 + (size_t)MP * DM, X1, nullptr, SSQF}; pg8::gemm_phase<EpiRes<0>>(lds, g, S, E);
    }
    SEAM(9);
    if (IN(10)) {
        const float* final_norm = kin(21);
        LOCAL_IDS
        for (int m = gw; m < M; m += NGW) { float* xr = X1 + (size_t)m * DM; const float r = rsqrtf(SSQF[m] * (1.f / DM) + EPS);
#pragma unroll
            for (int j = 0; j < 4; ++j) { const int cidx = lane * 4 + 256 * j; f32x4 v = *(const f32x4*)(xr + cidx); const f32x4 fw = *(const f32x4*)(final_norm + cidx); v = v * r * fw; *(f32x4*)(xr + cidx) = v; } }
    }
#undef IN
#undef SEAM
}

#ifndef N_LAUNCH_MODE
#define N_LAUNCH_MODE 1
#endif
extern "C" void kernel_launch(void* const* d_in, const int* in_sizes, int n_in, void* d_out, int out_size, void* d_ws, size_t ws_size, hipStream_t stream) {
    static int grid = 0;
    if (grid == 0) {
        int dev = 0, cus = 0, per_cu = 0;
        hipGetDevice(&dev); hipDeviceGetAttribute(&cus, hipDeviceAttributeMultiprocessorCount, dev);
        if (hipFuncSetAttribute((const void*)mega, hipFuncAttributeMaxDynamicSharedMemorySize, LDS_BYTES) != hipSuccess) { fprintf(stderr, "hipFuncSetAttribute failed\n"); }
        if (hipOccupancyMaxActiveBlocksPerMultiprocessor(&per_cu, (const void*)mega, 512, LDS_BYTES) != hipSuccess || per_cu < 1) { fprintf(stderr, "occupancy query: %d\n", per_cu); per_cu = 1; }
        (void)hipGetLastError();
        grid = cus * 1;
        if (grid <= 0) grid = 256;
    }
    (void)hipMemsetAsync((unsigned char*)d_ws + WS_BAR, 0, 256, stream);
    Args a{};
    for (int i = 0; i < 22; ++i) a.in[i] = (const float*)d_in[i];
    a.out = (float*)d_out; a.ws = (unsigned char*)d_ws;
#if N_LAUNCH_MODE == 1
    a.ph_lo = 0; a.ph_hi = 11;
    void* args[] = {&a};
    hipError_t e = hipLaunchCooperativeKernel((const void*)mega, dim3(grid), dim3(512), args, LDS_BYTES, stream);
    if (e != hipSuccess) fprintf(stderr, "cooperative launch failed: %s (grid %d)\n", hipGetErrorString(e), grid);
#else
    for (int p = 0; p < 11; ++p) { a.ph_lo = p; a.ph_hi = p + 1; hipLaunchKernelGGL(mega, dim3(grid), dim3(512), LDS_BYTES, stream, a); }
#endif
}
```

```cpp
#include <hip/hip_runtime.h>
#include <hip/hip_cooperative_groups.h>
#include <cstdio>
#include <cstdint>
namespace cg = cooperative_groups;

#define LAS __attribute__((address_space(3)))
typedef unsigned short bf16_t;
typedef short bf16x8 __attribute__((ext_vector_type(8)));
typedef float f32x4 __attribute__((ext_vector_type(4)));
typedef float f32x2 __attribute__((ext_vector_type(2)));
typedef unsigned u32x4 __attribute__((ext_vector_type(4)));
typedef unsigned u32x2 __attribute__((ext_vector_type(2)));

constexpr int DM = 1024, MP = 16384, MS = 512, M = MP + MS, SEQ = 2048, NBATCH = 8, DBATCH = 128;
constexpr int INW = 5392, NPAD = 5632, DFF = 4096, CONVD = 1536;
constexpr int OQ = 0, OZ = 512, OKK = 1536, OV = 1664, OX = 1792, ODT = 3328, OGA = 3344, OGB = 4368;
constexpr float EPS = 1e-6f;
constexpr size_t O_YP = 0, O_YS = 16777216, O_KP = 17301504, O_VP = 17432576, O_CP = 17563648, O_SP = 17600512,
                 O_KS = 18649088, O_VS = 20746240, O_CS = 22843392, O_SS = 23433216;
constexpr size_t MiB = 1u << 20;
constexpr size_t WS_RSTD1 = 0, WS_SSQ2 = 128 * 1024, WS_SSQF = 256 * 1024, WS_CD = 384 * 1024, WS_BAR = 512 * 1024, WS_XB = 512 * 1024 + 1024;
constexpr size_t WS_WIN = 1 * MiB, WS_WOA = 12 * MiB, WS_WOB = 13 * MiB, WS_WO = 15 * MiB, WS_DT = 17 * MiB;
constexpr size_t WS_U = 20 * MiB;
constexpr size_t WS_X1B = 20 * MiB, WS_ACT = 54 * MiB;
constexpr size_t WS_XC = 194 * MiB;
constexpr size_t WS_MERGED = 194 * MiB, WS_WUP = 227 * MiB, WS_WDN = 235 * MiB;
constexpr int LDS_BYTES = 163840;

__device__ __forceinline__ int opaque(int x) { asm volatile("" : "+v"(x)); return x; }
__device__ __forceinline__ unsigned f2bf(float f) { unsigned u = __builtin_bit_cast(unsigned, f); return (u + 0x7fffu + ((u >> 16) & 1u)) >> 16; }
typedef __bf16 bf16x2_t __attribute__((ext_vector_type(2)));
__device__ __forceinline__ unsigned pk2(float lo, float hi) { const f32x2 v = {lo, hi}; const bf16x2_t b = __builtin_convertvector(v, bf16x2_t); return __builtin_bit_cast(unsigned, b); }
__device__ __forceinline__ unsigned cvt_pk_bf16(float lo, float hi) { return pk2(lo, hi); }
__device__ __forceinline__ float bflo(unsigned w) { return __builtin_bit_cast(float, w << 16); }
__device__ __forceinline__ float bfhi(unsigned w) { return __builtin_bit_cast(float, w & 0xffff0000u); }
__device__ __forceinline__ float bf1(bf16_t h) { return __builtin_bit_cast(float, (unsigned)h << 16); }
__device__ __forceinline__ float sigmoidf_(float x) { return __builtin_amdgcn_rcpf(1.f + __expf(-x)); }
__device__ __forceinline__ float siluf_(float x) { return x * __builtin_amdgcn_rcpf(1.f + __expf(-x)); }
__device__ __forceinline__ void st_wt8(void* p, unsigned lo, unsigned hi) { __hip_atomic_store((unsigned long long*)p, ((unsigned long long)hi << 32) | lo, __ATOMIC_RELAXED, __HIP_MEMORY_SCOPE_AGENT); }
__device__ __forceinline__ float row16_sum(float v) {
    v += __builtin_bit_cast(float, __builtin_amdgcn_update_dpp(0, __builtin_bit_cast(int, v), 0xB1, 0xF, 0xF, true));
    v += __builtin_bit_cast(float, __builtin_amdgcn_update_dpp(0, __builtin_bit_cast(int, v), 0x4E, 0xF, 0xF, true));
    v += __builtin_bit_cast(float, __builtin_amdgcn_update_dpp(0, __builtin_bit_cast(int, v), 0x141, 0xF, 0xF, true));
    v += __builtin_bit_cast(float, __builtin_amdgcn_update_dpp(0, __builtin_bit_cast(int, v), 0x140, 0xF, 0xF, true));
    return v;
}
__device__ __forceinline__ float wave_sum(float v) { v = row16_sum(v); v += __shfl_xor(v, 16); v += __shfl_xor(v, 32); return v; }
#define LDS_WAIT() asm volatile("s_waitcnt lgkmcnt(0)" ::: "memory")
#define MFMA16(a, b, c) __builtin_amdgcn_mfma_f32_16x16x32_bf16(a, b, c, 0, 0, 0)

template <int O0, int O1, int O2, int O3, int D> __device__ __forceinline__ void tr_frag4(unsigned addr, bf16x8 (&f)[4]) {
    u32x2 a0, b0, a1, b1, a2, b2, a3, b3;
    asm volatile("ds_read_b64_tr_b16 %0, %8 offset:%9\n\tds_read_b64_tr_b16 %1, %8 offset:%10\n\tds_read_b64_tr_b16 %2, %8 offset:%11\n\tds_read_b64_tr_b16 %3, %8 offset:%12\n\t"
                 "ds_read_b64_tr_b16 %4, %8 offset:%13\n\tds_read_b64_tr_b16 %5, %8 offset:%14\n\tds_read_b64_tr_b16 %6, %8 offset:%15\n\tds_read_b64_tr_b16 %7, %8 offset:%16\n\ts_waitcnt lgkmcnt(0)"
                 : "=&v"(a0), "=&v"(b0), "=&v"(a1), "=&v"(b1), "=&v"(a2), "=&v"(b2), "=&v"(a3), "=&v"(b3)
                 : "v"(addr), "i"(O0), "i"(O0 + D), "i"(O1), "i"(O1 + D), "i"(O2), "i"(O2 + D), "i"(O3), "i"(O3 + D) : "memory");
    f[0] = __builtin_bit_cast(bf16x8, (u32x4){a0.x, a0.y, b0.x, b0.y}); f[1] = __builtin_bit_cast(bf16x8, (u32x4){a1.x, a1.y, b1.x, b1.y});
    f[2] = __builtin_bit_cast(bf16x8, (u32x4){a2.x, a2.y, b2.x, b2.y}); f[3] = __builtin_bit_cast(bf16x8, (u32x4){a3.x, a3.y, b3.x, b3.y});
}
#define LDSADDR(p) ((unsigned)(size_t)(p))

__device__ __forceinline__ const float* kin(int k) {
    const __attribute__((address_space(4))) unsigned char* ka = (const __attribute__((address_space(4))) unsigned char*)__builtin_amdgcn_kernarg_segment_ptr();
    asm volatile("" : "+s"(ka));
    return *(const float* const __attribute__((address_space(4)))*)(ka + 8 * k);
}
__device__ __forceinline__ unsigned char* kws() { return (unsigned char*)kin(23); }

namespace pg8 {
constexpr int BM = 256, BK = 64, HALF = 128, HTB = HALF * BK * 2, STAGE_BYTES = 8 * HTB, NXCD = 8, WGM = 8;
__host__ __device__ __forceinline__ int lds_byte(int r, int c) { const int st = (r >> 4) * 2 + (c >> 5), rr = r & 15, cc = c & 31, ob = rr * 64 + cc * 2; return st * 1024 + (ob ^ (((ob >> 9) & 1) << 5)); }
__host__ __device__ __forceinline__ void stage_rc(int b, int& R, int& C) { const int st = b / 1024, sb = b % 1024, swz = sb ^ (((sb >> 9) & 1) << 5); R = (st >> 1) * 16 + swz / 64; C = (st & 1) * 32 + (swz % 64) / 2; }
__host__ __device__ __forceinline__ int perm32(int rho) { const int n = rho >> 4, i = rho & 15; return 8 * (i >> 2) + 4 * n + (i & 3); }
struct Unit { int pm, pn, ks, split; };
struct Gemm { const bf16_t* A; const bf16_t* Bt; int M, N, K, lda, ldb; };
struct StaticOrder {
    int nM, nN, nwg, G, c, S, Q;
    __device__ __forceinline__ void init(int M_, int N_, int G_, int c_, int S_ = 1, int sample_mtiles = 0) { nM = M_ / BM; nN = N_ / BM; nwg = nM * nN; G = G_; c = c_; S = S_; Q = sample_mtiles * nN * S_; }
    __device__ __forceinline__ bool next(int i, Unit& u) const {
        const long L = (long)i * G + c; const bool isS = L >= nwg; const int q = isS ? (int)(L - nwg) : 0;
        if (isS && q >= Q) return false;
        int wgid = isS ? 0 : (int)L; { const int qq = nwg / NXCD, r = nwg % NXCD, xcd = wgid % NXCD, off = wgid / NXCD; wgid = (xcd < r ? xcd * (qq + 1) : r * (qq + 1) + (xcd - r) * qq) + off; }
        const int nig = WGM * nN, gid = wgid / nig, fm = gid * WGM, gsz = (nM - fm) < WGM ? (nM - fm) : WGM;
        const int pmF = fm + ((wgid % nig) % gsz), pnF = (wgid % nig) / gsz;
        const int tile = q / S;
        u.pm = isS ? nM + tile / nN : pmF; u.pn = isS ? tile % nN : pnF; u.ks = isS ? q - tile * S : 0; u.split = isS ? 1 : 0;
        return true;
    }
};
template <class Epi, int KSL = 128, size_t PART_OFF = 0, int SOFT_IDX = -1, int MID_T = -1>
__device__ __forceinline__ void gemm_phase(LAS unsigned char* lds, const Gemm g, const StaticOrder& S, const Epi& E) {
    const int tid = opaque((int)threadIdx.x), wid = __builtin_amdgcn_readfirstlane(tid >> 6), lane = tid & 63, wr = wid >> 2, wc = wid & 3, fr = lane & 15, fq = lane >> 4;
    const int ntF = g.K / BK; constexpr int ntS = KSL / BK; constexpr size_t ksbytes = (size_t)KSL * 2;
    unsigned voffA[2], voffB[2];
#pragma unroll
    for (int i = 0; i < 2; ++i) { int R, C; stage_rc(tid * 16 + i * 8192, R, C); const int Rb = (R & ~31) + perm32(R & 31);
        voffA[i] = (unsigned)(R * g.lda + C) * 2u; voffB[i] = (unsigned)(Rb * g.ldb + C) * 2u; }
    const size_t kstep = (size_t)(BK * 2);
    const size_t hstepA = (size_t)HALF * g.lda * 2, hstepB = (size_t)HALF * g.ldb * 2;
    const size_t tstepA = 2 * hstepA, tstepB = 2 * hstepB;
    const unsigned ldsw = (unsigned)wid * 1024u;
    const int aoff = lds_byte(wr * 64 + fr, fq * 8), boff = lds_byte(wc * 32 + fr, fq * 8);
#define PG8_SA(b, h) (((b) * 2 + (h)) * HTB)
#define PG8_SB(b, h) ((4 + (b) * 2 + (h)) * HTB)
#define PG8_STAGE(bufoff, gbase, voff) do { _Pragma("unroll") for (int _i = 0; _i < 2; ++_i) \
        __builtin_amdgcn_global_load_lds((const unsigned*)((const char*)(gbase) + (voff)[_i]), (LAS unsigned*)(lds + (bufoff) + ldsw + _i * 8192), 16, 0, 0); } while (0)
#define PG8_LDA(dst, b, h) do { _Pragma("unroll") for (int m = 0; m < 4; ++m) _Pragma("unroll") for (int k = 0; k < 2; ++k) dst[m][k] = *(const LAS bf16x8*)(lds + PG8_SA(b, h) + aoff + m * 2048 + k * 1024); } while (0)
#define PG8_LDB(dst, b, h) do { _Pragma("unroll") for (int n = 0; n < 2; ++n) _Pragma("unroll") for (int k = 0; k < 2; ++k) dst[n][k] = *(const LAS bf16x8*)(lds + PG8_SB(b, h) + boff + n * 2048 + k * 1024); } while (0)
#define PG8_MMA(ai, bj, At, Bt) do { __builtin_amdgcn_s_setprio(1); _Pragma("unroll") for (int m = 0; m < 4; ++m) _Pragma("unroll") for (int n = 0; n < 2; ++n) _Pragma("unroll") for (int k = 0; k < 2; ++k) \
        acc[ai][bj][m][n] = __builtin_amdgcn_mfma_f32_16x16x32_bf16(Bt[n][k], At[m][k], acc[ai][bj][m][n], 0, 0, 0); __builtin_amdgcn_s_setprio(0); } while (0)
#define PG8_WAIT_V(n) asm volatile("s_waitcnt vmcnt(" #n ")" ::: "memory")
#define PG8_WAIT_L(n) asm volatile("s_waitcnt lgkmcnt(" #n ")" ::: "memory")
#define PG8_BAR __builtin_amdgcn_s_barrier()
#define PG8_SCHED __builtin_amdgcn_sched_barrier(0)
    Unit cur, nxt; int ui = 0;
    if (!S.next(0, cur)) return;
    float pre[8];
#pragma unroll
    for (int e = 0; e < 8; ++e) pre[e] = 0.f;
    f32x4 acc[2][2][4][2];
#pragma unroll
    for (int a = 0; a < 2; ++a)
#pragma unroll
        for (int b = 0; b < 2; ++b)
#pragma unroll
            for (int m = 0; m < 4; ++m)
#pragma unroll
                for (int n = 0; n < 2; ++n) acc[a][b][m][n] = (f32x4){0.f, 0.f, 0.f, 0.f};
    bf16x8 At[4][2], B0[2][2], B1[2][2];
    const char* cA = (const char*)g.A + (size_t)cur.pm * tstepA + (cur.split ? cur.ks * ksbytes : 0); const char* cB = (const char*)g.Bt + (size_t)cur.pn * tstepB + (cur.split ? cur.ks * ksbytes : 0);
    PG8_STAGE(PG8_SB(0, 0), cB, voffB); PG8_STAGE(PG8_SB(0, 1), cB + hstepB, voffB); PG8_STAGE(PG8_SA(0, 0), cA, voffA); PG8_STAGE(PG8_SA(0, 1), cA + hstepA, voffA);
    if (wr == 1) PG8_BAR;
    PG8_WAIT_V(2); PG8_BAR;
    PG8_STAGE(PG8_SB(1, 0), cB + kstep, voffB); PG8_STAGE(PG8_SA(1, 0), cA + kstep, voffA); PG8_STAGE(PG8_SB(1, 1), cB + hstepB + kstep, voffB);
    PG8_WAIT_V(6); PG8_BAR;
    for (;;) {
        const bool has_next = S.next(ui + 1, nxt);
        const char* nA = has_next ? (const char*)g.A + (size_t)nxt.pm * tstepA + (nxt.split ? nxt.ks * ksbytes : 0) : cA; const char* nB = has_next ? (const char*)g.Bt + (size_t)nxt.pn * tstepB + (nxt.split ? nxt.ks * ksbytes : 0) : cB;
        const int nt = cur.split ? ntS : ntF;
        if (SOFT_IDX >= 0 && has_next && nxt.split && !cur.split) {
            if (tid == 0) { unsigned* sw = (unsigned*)(kws() + WS_BAR) + 64 + SOFT_IDX; unsigned sp = 0;
                while (__hip_atomic_load(sw, __ATOMIC_RELAXED, __HIP_MEMORY_SCOPE_AGENT) < (unsigned)gridDim.x) { __builtin_amdgcn_s_sleep(2); if (++sp > (1u << 22)) break; }
                __builtin_amdgcn_fence(__ATOMIC_ACQUIRE, "agent"); }
            PG8_BAR; }
        for (int t = 0; t < nt; t += 2) {
            const bool last = (t == nt - 2);
            if (MID_T >= 0 && t == MID_T && !cur.split) { PG8_SCHED; E.mid(acc, cur, wr, wc, fr, fq); PG8_SCHED; }
            if (last && !cur.split) E.prefetch(pre, cur, wr, fr);
            const char* a1 = cA + (size_t)(t + 1) * kstep;
            const char* a2 = last ? nA : cA + (size_t)(t + 2) * kstep; const char* b2 = last ? nB : cB + (size_t)(t + 2) * kstep;
            const char* a3 = a2 + kstep; const char* b3 = b2 + kstep;
            PG8_LDB(B0, 0, 0); PG8_LDB(B1, 0, 1); PG8_SCHED; PG8_LDA(At, 0, 0); PG8_STAGE(PG8_SA(1, 1), a1 + hstepA, voffA);
            PG8_WAIT_V(8); PG8_WAIT_L(0); PG8_BAR; PG8_MMA(0, 0, At, B0); PG8_MMA(0, 1, At, B1); PG8_BAR; PG8_SCHED;
            PG8_LDA(At, 0, 1); PG8_STAGE(PG8_SB(0, 0), b2, voffB); PG8_STAGE(PG8_SB(0, 1), b2 + hstepB, voffB); PG8_STAGE(PG8_SA(0, 0), a2, voffA);
            PG8_WAIT_V(8); PG8_WAIT_L(0); PG8_BAR; PG8_MMA(1, 0, At, B0); PG8_MMA(1, 1, At, B1); PG8_BAR; PG8_SCHED;
            PG8_LDB(B0, 1, 0); PG8_LDB(B1, 1, 1); PG8_SCHED; PG8_LDA(At, 1, 0); PG8_STAGE(PG8_SA(0, 1), a2 + hstepA, voffA);
            PG8_WAIT_V(8); PG8_WAIT_L(0); PG8_BAR; PG8_MMA(0, 0, At, B0); PG8_MMA(0, 1, At, B1); PG8_BAR; PG8_SCHED;
            PG8_LDA(At, 1, 1); PG8_STAGE(PG8_SB(1, 0), b3, voffB); PG8_STAGE(PG8_SB(1, 1), b3 + hstepB, voffB); PG8_STAGE(PG8_SA(1, 0), a3, voffA);
            PG8_WAIT_V(8); PG8_WAIT_L(0); PG8_BAR; PG8_MMA(1, 0, At, B0); PG8_MMA(1, 1, At, B1); PG8_BAR; PG8_SCHED;
        }
        if (wr == 0) PG8_BAR;
        if (cur.split) {
            float* pp = (float*)(kws() + PART_OFF) + ((size_t)cur.ks * 512 + (cur.pm - S.nM) * 256 + wr * 64 + fr) * g.N + cur.pn * 256 + wc * 32 + 8 * fq;
#pragma unroll
            for (int a = 0; a < 2; ++a)
#pragma unroll
                for (int m = 0; m < 4; ++m)
#pragma unroll
                    for (int b = 0; b < 2; ++b) { float* q = pp + (size_t)(a * 128 + m * 16) * g.N + b * 128; *(f32x4*)q = acc[a][b][m][0]; *(f32x4*)(q + 4) = acc[a][b][m][1]; }
        } else E(acc, cur, wr, wc, fr, fq, 0, 8, pre);
        if (!has_next) break;
#pragma unroll
        for (int a = 0; a < 2; ++a)
#pragma unroll
            for (int b = 0; b < 2; ++b)
#pragma unroll
                for (int m = 0; m < 4; ++m)
#pragma unroll
                    for (int n = 0; n < 2; ++n) acc[a][b][m][n] = (f32x4){0.f, 0.f, 0.f, 0.f};
        cur = nxt; cA = nA; cB = nB; ++ui;
        if (wr == 1) PG8_BAR;
    }
    PG8_WAIT_V(0);
    PG8_BAR;
#undef PG8_SA
#undef PG8_SB
#undef PG8_STAGE
#undef PG8_LDA
#undef PG8_LDB
#undef PG8_MMA
#undef PG8_WAIT_V
#undef PG8_WAIT_L
#undef PG8_BAR
#undef PG8_SCHED
}
}
typedef f32x4 AccT[2][2][4][2];
#define EPI_LOOP_ROWS for (int ai = 0; ai < 2; ++ai) _Pragma("unroll") for (int m = 0; m < 4; ++m) if (ai * 4 + m < ghi)
#define EPI_ROW (u.pm * 256 + ((ai * 4 + m + glo) >> 2) * 128 + wr * 64 + ((ai * 4 + m + glo) & 3) * 16 + fr)

struct EpiIn {
    static constexpr bool PERM = true;
    bf16_t* U; float* DT; const float* rstd; const float* dtb;
    __device__ __forceinline__ void mid(AccT&, const pg8::Unit&, int, int, int, int) const {}
    __device__ __forceinline__ void prefetch(float (&pre)[8], const pg8::Unit& u, int wr, int fr) const {
#pragma unroll
        for (int e = 0; e < 8; ++e) pre[e] = rstd[u.pm * 256 + (e >> 2) * 128 + wr * 64 + (e & 3) * 16 + fr]; }
    __device__ __forceinline__ void operator()(const AccT& acc, const pg8::Unit& u, int wr, int wc, int fr, int fq, int glo, int ghi, const float (&pre)[8]) const {
#pragma unroll
        EPI_LOOP_ROWS {
            const int row = EPI_ROW; const float rs = pre[ai * 4 + m]; bf16_t* rowp = U + (size_t)row * INW;
#pragma unroll
            for (int bj = 0; bj < 2; ++bj) { const int col0 = u.pn * 256 + bj * 128 + wc * 32 + 8 * fq;
                if (col0 < INW) { const f32x4 v0 = acc[ai][bj][m][0] * rs, v1 = acc[ai][bj][m][1] * rs;
                    u32x4 w; w.x = cvt_pk_bf16(v0[0], v0[1]); w.y = cvt_pk_bf16(v0[2], v0[3]); w.z = cvt_pk_bf16(v1[0], v1[1]); w.w = cvt_pk_bf16(v1[2], v1[3]);
                    *(u32x4*)(rowp + col0) = w;
                    if (col0 >= ODT && col0 < ODT + 16) { const int d0 = col0 - ODT; float* dp = DT + (size_t)row * 16 + d0;
#pragma unroll
                        for (int i = 0; i < 4; ++i) { float x = v0[i] + dtb[d0 + i]; dp[i] = x > 20.f ? x : log1pf(__expf(x)); x = v1[i] + dtb[d0 + 4 + i]; dp[4 + i] = x > 20.f ? x : log1pf(__expf(x)); } } } }
        }
    }
};
struct EpiGate2 {
    static constexpr bool PERM = true;
    const bf16_t* U; bf16_t* MG;
    __device__ __forceinline__ void prefetch(float (&)[8], const pg8::Unit&, int, int) const {}
    __device__ __forceinline__ void mid(AccT& acc, const pg8::Unit& u, int wr, int wc, int fr_, int fq) const {
        const int fr = opaque(fr_);
#pragma unroll
        for (int ai = 0; ai < 2; ++ai)
#pragma unroll
            for (int m = 0; m < 4; ++m) { const int row = u.pm * 256 + ai * 128 + wr * 64 + m * 16 + fr; const bf16_t* gp = U + (size_t)row * INW;
#pragma unroll
                for (int bj = 0; bj < 2; ++bj) { const int col0 = u.pn * 256 + bj * 128 + wc * 32 + 8 * fq;
                    const u32x4 ga = *(const u32x4*)(gp + OGA + col0), gb = *(const u32x4*)(gp + OGB + col0);
                    float r[8];
                    r[0] = (1.f + __expf(-bflo(gb.x))) * __builtin_amdgcn_rcpf(1.f + __expf(-bflo(ga.x))); r[1] = (1.f + __expf(-bfhi(gb.x))) * __builtin_amdgcn_rcpf(1.f + __expf(-bfhi(ga.x)));
                    r[2] = (1.f + __expf(-bflo(gb.y))) * __builtin_amdgcn_rcpf(1.f + __expf(-bflo(ga.y))); r[3] = (1.f + __expf(-bfhi(gb.y))) * __builtin_amdgcn_rcpf(1.f + __expf(-bfhi(ga.y)));
                    r[4] = (1.f + __expf(-bflo(gb.z))) * __builtin_amdgcn_rcpf(1.f + __expf(-bflo(ga.z))); r[5] = (1.f + __expf(-bfhi(gb.z))) * __builtin_amdgcn_rcpf(1.f + __expf(-bfhi(ga.z)));
                    r[6] = (1.f + __expf(-bflo(gb.w))) * __builtin_amdgcn_rcpf(1.f + __expf(-bflo(ga.w))); r[7] = (1.f + __expf(-bfhi(gb.w))) * __builtin_amdgcn_rcpf(1.f + __expf(-bfhi(ga.w)));
                    f32x4 a0 = acc[ai][bj][m][0], a1 = acc[ai][bj][m][1];
                    a0[0] *= r[0]; a0[1] *= r[1]; a0[2] *= r[2]; a0[3] *= r[3]; a1[0] *= r[4]; a1[1] *= r[5]; a1[2] *= r[6]; a1[3] *= r[7];
                    acc[ai][bj][m][0] = a0; acc[ai][bj][m][1] = a1; }
                __builtin_amdgcn_sched_barrier(0); }
    }
    __device__ __forceinline__ void operator()(const AccT& acc, const pg8::Unit& u, int wr, int wc, int fr, int fq, int glo, int ghi, const float (&pre)[8]) const {
#pragma unroll
        EPI_LOOP_ROWS {
            const int row = EPI_ROW; const bf16_t* gp = U + (size_t)row * INW + OGB; bf16_t* op = MG + (size_t)row * DM;
#pragma unroll
            for (int bj = 0; bj < 2; ++bj) { const int col0 = u.pn * 256 + bj * 128 + wc * 32 + 8 * fq;
                const u32x4 gv = *(const u32x4*)(gp + col0); const f32x4 a0 = acc[ai][bj][m][0], a1 = acc[ai][bj][m][1];
                float r[8];
                r[0] = sigmoidf_(bflo(gv.x)) * a0[0]; r[1] = sigmoidf_(bfhi(gv.x)) * a0[1]; r[2] = sigmoidf_(bflo(gv.y)) * a0[2]; r[3] = sigmoidf_(bfhi(gv.y)) * a0[3];
                r[4] = sigmoidf_(bflo(gv.z)) * a1[0]; r[5] = sigmoidf_(bfhi(gv.z)) * a1[1]; r[6] = sigmoidf_(bflo(gv.w)) * a1[2]; r[7] = sigmoidf_(bfhi(gv.w)) * a1[3];
                u32x4 w; w.x = cvt_pk_bf16(r[0], r[1]); w.y = cvt_pk_bf16(r[2], r[3]); w.z = cvt_pk_bf16(r[4], r[5]); w.w = cvt_pk_bf16(r[6], r[7]);
                *(u32x4*)(op + col0) = w; }
        }
    }
};
template <int FIRST> struct EpiRes {
    static constexpr bool PERM = true;
    __device__ __forceinline__ void mid(AccT&, const pg8::Unit&, int, int, int, int) const {}
    __device__ __forceinline__ void prefetch(float (&)[8], const pg8::Unit&, int, int) const {}
    const float* base_p; bf16_t* XB; float* ssq;
    __device__ __forceinline__ void operator()(const AccT& acc, const pg8::Unit& u, int wr, int wc, int fr, int fq, int glo, int ghi, const float (&pre)[8]) const {
#pragma unroll
        EPI_LOOP_ROWS {
            const int row = EPI_ROW; bf16_t* xb = XB + (size_t)row * DM; float ss = 0.f;
#pragma unroll
            for (int bj = 0; bj < 2; ++bj) { const int col0 = u.pn * 256 + bj * 128 + wc * 32 + 8 * fq;
                f32x4 b0, b1;
                if (FIRST) { const float* bp = base_p + (size_t)row * DM + col0; b0 = __builtin_nontemporal_load((const f32x4*)bp); b1 = __builtin_nontemporal_load((const f32x4*)(bp + 4)); }
                else { const u32x4 pv = *(const u32x4*)(xb + col0); b0 = (f32x4){bflo(pv.x), bfhi(pv.x), bflo(pv.y), bfhi(pv.y)}; b1 = (f32x4){bflo(pv.z), bfhi(pv.z), bflo(pv.w), bfhi(pv.w)}; }
                const f32x4 v0 = b0 + acc[ai][bj][m][0], v1 = b1 + acc[ai][bj][m][1];
                if (FIRST) ss += (v0[0] * v0[0] + v0[1] * v0[1]) + (v0[2] * v0[2] + v0[3] * v0[3]) + (v1[0] * v1[0] + v1[1] * v1[1]) + (v1[2] * v1[2] + v1[3] * v1[3]);
                u32x4 w; w.x = cvt_pk_bf16(v0[0], v0[1]); w.y = cvt_pk_bf16(v0[2], v0[3]); w.z = cvt_pk_bf16(v1[0], v1[1]); w.w = cvt_pk_bf16(v1[2], v1[3]);
                *(u32x4*)(xb + col0) = w; }
            if (FIRST) { ss += __shfl_xor(ss, 16); ss += __shfl_xor(ss, 32); if (fq == 0) atomicAdd(ssq + row, ss); }
        }
    }
};
struct EpiUp {
    static constexpr bool PERM = true;
    const float* ssq2; bf16_t* ACT;
    __device__ __forceinline__ void mid(AccT&, const pg8::Unit&, int, int, int, int) const {}
    __device__ __forceinline__ void prefetch(float (&pre)[8], const pg8::Unit& u, int wr, int fr) const {
#pragma unroll
        for (int e = 0; e < 8; ++e) pre[e] = ssq2[u.pm * 256 + (e >> 2) * 128 + wr * 64 + (e & 3) * 16 + fr]; }
    __device__ __forceinline__ void operator()(const AccT& acc, const pg8::Unit& u, int wr, int wc, int fr, int fq, int glo, int ghi, const float (&pre)[8]) const {
#pragma unroll
        EPI_LOOP_ROWS {
            const int row = EPI_ROW; const float rs = rsqrtf(pre[ai * 4 + m] * (1.f / DM) + EPS); bf16_t* op = ACT + (size_t)row * DFF;
#pragma unroll
            for (int bj = 0; bj < 2; ++bj) { const int col0 = u.pn * 256 + bj * 128 + wc * 32 + 8 * fq;
                f32x4 v0 = acc[ai][bj][m][0] * rs, v1 = acc[ai][bj][m][1] * rs;
#pragma unroll
                for (int i = 0; i < 4; ++i) { const float a = fmaxf(v0[i], 0.f), b = fmaxf(v1[i], 0.f); v0[i] = a * a; v1[i] = b * b; }
                u32x4 w; w.x = cvt_pk_bf16(v0[0], v0[1]); w.y = cvt_pk_bf16(v0[2], v0[3]); w.z = cvt_pk_bf16(v1[0], v1[1]); w.w = cvt_pk_bf16(v1[2], v1[3]);
                *(u32x4*)(op + col0) = w; }
        }
    }
};

__device__ __forceinline__ void transpose_item(const float* W, int K, int N, const float* scale, bf16_t* WT, int ldw, int kdst0, LAS float* scr, int kb, int nsrc0, int ndst0, int lane) {
    const int k0 = 64 * kb;
    const int n = nsrc0 + (lane & 15) * 4, kr = lane >> 4;
    f32x4 v[16];
#pragma unroll
    for (int i = 0; i < 16; ++i) { v[i] = (f32x4){0.f, 0.f, 0.f, 0.f}; if (n < N) v[i] = __builtin_nontemporal_load((const f32x4*)(W + (size_t)(k0 + 4 * i + kr) * N + n)); }
#pragma unroll
    for (int i = 0; i < 16; ++i) { const int kk = 4 * i + kr; const float sc = scale ? scale[k0 + kk] : 1.f; LAS float* p = scr + kk * 65 + (lane & 15) * 4;
        p[0] = v[i][0] * sc; p[1] = v[i][1] * sc; p[2] = v[i][2] * sc; p[3] = v[i][3] * sc; }
    LDS_WAIT();
    const int c = lane & 7;
#pragma unroll
    for (int j = 0; j < 8; ++j) { const int nn = (lane >> 3) + 8 * j; const LAS float* sp = scr + (8 * c) * 65 + nn;
        u32x4 o; o.x = pk2(sp[0 * 65], sp[1 * 65]); o.y = pk2(sp[2 * 65], sp[3 * 65]); o.z = pk2(sp[4 * 65], sp[5 * 65]); o.w = pk2(sp[6 * 65], sp[7 * 65]);
        *(u32x4*)(WT + (size_t)(ndst0 + nn) * ldw + kdst0 + k0 + 8 * c) = o; }
    LDS_WAIT();
}

constexpr int KS_LD = 72;
__device__ __forceinline__ void attn_tile(const LAS bf16_t* Ks, const LAS bf16_t* Vt, bf16_t* qptr, const bf16x8 qf0, const bf16x8 qf1, int kt0, int rq, int kmin, float sink, int lane) {
    const int c16 = lane & 15, quad = lane >> 4;
    bf16x8 qf[2]; qf[0] = qf0; qf[1] = qf1;
    f32x4 s[10];
#pragma unroll
    for (int j = 0; j < 10; ++j) { s[j] = (f32x4){0.f, 0.f, 0.f, 0.f};
#pragma unroll
        for (int ks = 0; ks < 2; ++ks) { const bf16x8 kf = *(const LAS bf16x8*)(Ks + ((kt0 + j) * 16 + c16) * KS_LD + ks * 32 + quad * 8); s[j] = MFMA16(kf, qf[ks], s[j]); } }
    float mx = sink;
#pragma unroll
    for (int j = 0; j < 10; ++j)
#pragma unroll
        for (int jj = 0; jj < 4; ++jj) { const int kidx = (kt0 + j) * 16 + quad * 4 + jj; const bool ok = (kidx >= rq) && (kidx <= rq + 128) && (kidx >= kmin);
            const float v = ok ? s[j][jj] * 0.125f : -INFINITY; s[j][jj] = v; mx = fmaxf(mx, v); }
    mx = fmaxf(mx, __shfl_xor(mx, 16)); mx = fmaxf(mx, __shfl_xor(mx, 32));
    float sum = 0.f;
#pragma unroll
    for (int j = 0; j < 10; ++j)
#pragma unroll
        for (int jj = 0; jj < 4; ++jj) { const float p = __expf(s[j][jj] - mx); s[j][jj] = p; sum += p; }
    sum += __shfl_xor(sum, 16); sum += __shfl_xor(sum, 32); sum += __expf(sink - mx);
    const float inv = 1.f / sum;
    f32x4 o[4];
#pragma unroll
    for (int dt = 0; dt < 4; ++dt) o[dt] = (f32x4){0.f, 0.f, 0.f, 0.f};
    const unsigned vaddr = LDSADDR(Vt) + (unsigned)(((kt0 * 16 + quad * 4 + (c16 >> 2)) * KS_LD + 4 * (c16 & 3)) * 2);
#pragma unroll
    for (int st = 0; st < 5; ++st) {
        u32x4 pw; pw.x = pk2(s[2 * st][0] * inv, s[2 * st][1] * inv); pw.y = pk2(s[2 * st][2] * inv, s[2 * st][3] * inv);
        pw.z = pk2(s[2 * st + 1][0] * inv, s[2 * st + 1][1] * inv); pw.w = pk2(s[2 * st + 1][2] * inv, s[2 * st + 1][3] * inv);
        const bf16x8 pf = __builtin_bit_cast(bf16x8, pw);
        bf16x8 vf[4]; tr_frag4<0, 32, 64, 96, 16 * KS_LD * 2>(vaddr + st * (32 * KS_LD * 2), vf);
#pragma unroll
        for (int dt = 0; dt < 4; ++dt) o[dt] = MFMA16(vf[dt], pf, o[dt]);
    }
#pragma unroll
    for (int dt = 0; dt < 4; ++dt) { u32x2 w; w.x = pk2(o[dt][0], o[dt][1]); w.y = pk2(o[dt][2], o[dt][3]); *(u32x2*)(qptr + dt * 16 + quad * 4) = w; }
}

#define XB_TMO      128
#define XB_XCNT(j)  (256  + 64 * (j))
#define XB_XSUB(j)  (1280 + 64 * (j))
#define XB_XGEN(j)  (2304 + 64 * (j))
#define XB_TOP      3328
#define XB_TOPGEN   3392
#define XCD_BAR_WORDS 3456
#define XB_SPIN_CAP (1u << 18)
__device__ __forceinline__ unsigned xb_ld(unsigned* p)              { return __hip_atomic_load(p, __ATOMIC_RELAXED, __HIP_MEMORY_SCOPE_AGENT); }
__device__ __forceinline__ unsigned xb_add(unsigned* p, unsigned v) { return __hip_atomic_fetch_add(p, v, __ATOMIC_RELAXED, __HIP_MEMORY_SCOPE_AGENT); }
__device__ __forceinline__ unsigned xb_xcc_id() { return (unsigned)__builtin_amdgcn_s_getreg((3 << 11) | 20) & 0xFu; }
#define XB_SPIN(cond, bar) do { unsigned _sp = 0; while (cond) { __builtin_amdgcn_s_sleep(1); \
    if ((++_sp & 255u) == 0u) { if (xb_ld(&(bar)[XB_TMO])) break; if (_sp > XB_SPIN_CAP) { atomicAdd(&(bar)[XB_TMO], 1u); break; } } } } while (0)
__device__ __forceinline__ void xcd_barrier_complete(unsigned* bar, unsigned x, unsigned& nloc, unsigned& nx) {
    const unsigned Gt = gridDim.x;
    unsigned sum, cnt, mine, sp = 0u;
    for (;;) {
        sum = 0u; cnt = 0u; mine = 0u;
#pragma unroll
        for (unsigned j = 0; j < 16; ++j) { const unsigned c = xb_ld(&bar[XB_XCNT(j)]); sum += c; cnt += (c > 0u) ? 1u : 0u; mine = (j == x) ? c : mine; }
        if (sum == Gt) break;
        __builtin_amdgcn_s_sleep(1);
        if ((++sp & 255u) == 0u) { if (xb_ld(&bar[XB_TMO])) break; if (sp > XB_SPIN_CAP) { atomicAdd(&bar[XB_TMO], 1u); break; } }
    }
    nloc = mine > 0u ? mine : 1u; nx = cnt > 0u ? cnt : 1u;
}
__device__ __forceinline__ void xcd_barrier(unsigned* bar, unsigned x, volatile LAS unsigned* st, int tid0) {
    asm volatile("s_waitcnt vmcnt(0) lgkmcnt(0)" ::: "memory");
    __syncthreads();
    if (tid0 == 0) {
        __builtin_amdgcn_s_waitcnt(0);
        unsigned nloc = st[0], nx = st[1];
        if (nloc == 0u) { xcd_barrier_complete(bar, x, nloc, nx); st[0] = nloc; st[1] = nx; }
        const unsigned old = xb_add(&bar[XB_XSUB(x)], 1u);
        const unsigned gen = old / nloc;
        if (old + 1u == (gen + 1u) * nloc) {
            __builtin_amdgcn_fence(__ATOMIC_RELEASE, "agent");
            asm volatile("s_waitcnt vmcnt(0)" ::: "memory");
            const unsigned og = xb_add(&bar[XB_TOP], 1u);
            const unsigned tg = og / nx;
            if (og + 1u == (tg + 1u) * nx) xb_add(&bar[XB_TOPGEN], 1u);
            else XB_SPIN(xb_ld(&bar[XB_TOPGEN]) == tg, bar);
            __builtin_amdgcn_fence(__ATOMIC_ACQUIRE, "agent");
            xb_add(&bar[XB_XGEN(x)], 1u);
            asm volatile("s_waitcnt vmcnt(0)" ::: "memory");
        } else {
            XB_SPIN(xb_ld(&bar[XB_XGEN(x)]) == gen, bar);
            __builtin_amdgcn_fence(__ATOMIC_ACQUIRE, "agent");
            asm volatile("s_waitcnt vmcnt(0)" ::: "memory");
        }
    }
    __syncthreads();
}
struct Args { const float* in[22]; float* out; unsigned char* ws; int ph_lo, ph_hi; };

__global__ void __launch_bounds__(512, 2) mega(Args a) {
    extern __shared__ __attribute__((aligned(16))) unsigned char lds_raw[];
    LAS unsigned char* lds = (LAS unsigned char*)lds_raw;
    cg::grid_group grid = cg::this_grid();
    const int tid0 = threadIdx.x, w = __builtin_amdgcn_readfirstlane(tid0 >> 6), G = gridDim.x, bx = blockIdx.x;
    const int gw = bx * 8 + w, NGW = G * 8, NGT = G * 512;
#define LOCAL_IDS const int tid = opaque(tid0), lane = tid & 63, c16 = lane & 15, quad = lane >> 4; (void)c16; (void)quad; (void)lane;
    unsigned char* ws = a.ws; float* out = a.out;
    float* RSTD1 = (float*)(ws + WS_RSTD1); float* SSQ2 = (float*)(ws + WS_SSQ2); float* SSQF = (float*)(ws + WS_SSQF); float* CD = (float*)(ws + WS_CD);
    bf16_t* WIN = (bf16_t*)(ws + WS_WIN); bf16_t* WOA = (bf16_t*)(ws + WS_WOA); bf16_t* WOB = (bf16_t*)(ws + WS_WOB); bf16_t* WO = (bf16_t*)(ws + WS_WO);
    bf16_t* WUP = (bf16_t*)((unsigned char*)out + 40 * MiB); bf16_t* WDN = (bf16_t*)((unsigned char*)out + 48 * MiB);
    float* DT = (float*)(ws + WS_DT); bf16_t* U = (bf16_t*)(ws + WS_U); bf16_t* XC = (bf16_t*)(ws + WS_XC);
    bf16_t* MERGED = (bf16_t*)(ws + WS_MERGED); bf16_t* X1B = (bf16_t*)(ws + WS_X1B); bf16_t* ACT = (bf16_t*)(ws + WS_ACT);
    bf16_t* XB = (bf16_t*)(out + O_SS);
    bf16_t* STB = (bf16_t*)(out + O_YP);
    float* X1 = out + O_YP;
    const int lo = a.ph_lo, hi = a.ph_hi;
#ifndef PHMASK
#define PHMASK 0x7ff
#endif
#define IN(k) (((PHMASK >> (k)) & 1) && lo <= (k) && (k) < hi)
    unsigned* BARW = (unsigned*)(ws + WS_BAR);
    if (lo < 0) grid.sync();
#ifdef PROBE_A
    unsigned tstamp[12];
#define STAMP(i) tstamp[i] = (unsigned)__builtin_amdgcn_s_memrealtime()
    STAMP(0);
#else
#define STAMP(i)
#endif
    unsigned* XBW = (unsigned*)(ws + WS_XB); volatile LAS unsigned* xst = (volatile LAS unsigned*)(lds + LDS_BYTES - 64);
    const unsigned xcc = xb_xcc_id();
    if (tid0 < 2) xst[tid0] = 0u;
    if (tid0 == 0) (void)xb_add(&XBW[XB_XCNT(xcc)], 1u);
    __syncthreads();
#define SEAM(k) do { if (IN(k) && IN((k) + 1)) xcd_barrier(XBW, xcc, xst, tid0); } while (0)
#define SOFT_ARRIVE(k) do { asm volatile("s_waitcnt vmcnt(0) lgkmcnt(0)" ::: "memory"); __syncthreads(); \
        if (tid0 == 0) { __hip_atomic_fetch_add(BARW + 64 + (k), 1u, __ATOMIC_RELAXED, __HIP_MEMORY_SCOPE_AGENT); } } while (0)
    if (IN(0)) {
        const float* x_p = kin(0); const float* x_s = kin(1); const float* norm1 = kin(6); const float* w_in = kin(7); const float* ssm_norm = kin(14); const float* w_oa = kin(15); const float* w_ob = kin(16); const float* w_o = kin(17);
        LOCAL_IDS const int gtid = bx * 512 + tid;
        LAS float* scr = (LAS float*)(lds + w * 16640);
        constexpr int I_IN = 16 * 88, I_OA = 8 * 16, I_OB = 16 * 16, I_O = 16 * 16;
        for (int it = gw; it < I_IN + I_OA + I_OB + I_O; it += NGW) {
            int r = it;
            if (r < I_IN) { const int kb = r / 88, nd = 64 * (r % 88); const int ns = nd < 512 ? nd : (nd < 1536 ? nd + 256 : (nd < 1792 ? nd - 1024 : nd));
                transpose_item(w_in, DM, INW, norm1, WIN, DM, 0, scr, kb, ns, nd, lane); continue; } r -= I_IN;
            if (r < I_OA) { transpose_item(w_oa, 512, DM, nullptr, WOA, 1536, 0, scr, r / 16, 64 * (r % 16), 64 * (r % 16), lane); continue; } r -= I_OA;
            if (r < I_OB) { transpose_item(w_ob, DM, DM, ssm_norm, WOA, 1536, 512, scr, r / 16, 64 * (r % 16), 64 * (r % 16), lane); continue; } r -= I_OB;
            transpose_item(w_o, DM, DM, nullptr, WO, DM, 0, scr, r / 16, 64 * (r % 16), 64 * (r % 16), lane);
        }
#pragma unroll 2
        for (int m = gw; m < M; m += NGW) {
            const float* xr = m < MP ? x_p + (size_t)m * DM : x_s + (size_t)(m - MP) * DM;
            f32x4 v[4]; float ss = 0.f;
#pragma unroll
            for (int j = 0; j < 4; ++j) { v[j] = __builtin_nontemporal_load((const f32x4*)(xr + lane * 4 + 256 * j)); ss += (v[j][0] * v[j][0] + v[j][1] * v[j][1]) + (v[j][2] * v[j][2] + v[j][3] * v[j][3]); }
            ss = wave_sum(ss);
            if (lane == 0) RSTD1[m] = rsqrtf(ss * (1.f / DM) + EPS);
#pragma unroll
            for (int j = 0; j < 4; ++j) { u32x2 o; o.x = pk2(v[j][0], v[j][1]); o.y = pk2(v[j][2], v[j][3]); *(u32x2*)(XB + (size_t)m * DM + lane * 4 + 256 * j) = o; }
        }
        for (int i = gtid; i < M; i += NGT) { SSQ2[i] = 0.f; SSQF[i] = 0.f; }
    }
    SEAM(0); STAMP(1);
    if (IN(1)) {
        const float* dt_bias = kin(11);
        pg8::Gemm g{XB, WIN, M, NPAD, DM, DM, DM}; pg8::StaticOrder S; S.init(M, NPAD, G, bx);
        EpiIn E{U, DT, RSTD1, dt_bias};
        pg8::gemm_phase<EpiIn>(lds, g, S, E);
        {
            constexpr int NT1 = (M / 256) * (NPAD / 256); const int full = NT1 / G, rem = NT1 - full * G;
            if (bx >= rem && rem > 0) { LOCAL_IDS const float* norm2 = kin(18); const float* w_up = kin(19); const float* w_down = kin(20);
                LAS float* scr = (LAS float*)(lds + w * 16640); const int nidle = (G - rem) * 8;
                for (int it = (bx - rem) * 8 + w; it < 2048; it += nidle) { if (it < 1024) transpose_item(w_up, DM, DFF, norm2, WUP, DM, 0, scr, it / 64, 64 * (it % 64), 64 * (it % 64), lane); else transpose_item(w_down, DFF, DM, nullptr, WDN, DFF, 0, scr, (it - 1024) / 16, 64 * ((it - 1024) % 16), 64 * ((it - 1024) % 16), lane); } } }
    }
    SEAM(1); STAMP(2);
    if (IN(2)) {
        const float* cache_k = kin(2); const float* cache_v = kin(3); const float* state_conv = kin(4); const float* sinks = kin(8); const float* conv_w = kin(9); const float* conv_b = kin(10);
        {   LOCAL_IDS
            if (tid < 384) {
                const int cgi = tid % 192, sub = tid / 192, ch0 = cgi * 8;
                float wv[4][8], bias[8];
#pragma unroll
                for (int i = 0; i < 4; ++i) { const f32x4 t0 = *(const f32x4*)(conv_w + i * CONVD + ch0), t1 = *(const f32x4*)(conv_w + i * CONVD + ch0 + 4);
#pragma unroll
                    for (int k = 0; k < 4; ++k) { wv[i][k] = t0[k]; wv[i][4 + k] = t1[k]; } }
                { const f32x4 t0 = *(const f32x4*)(conv_b + ch0), t1 = *(const f32x4*)(conv_b + ch0 + 4);
#pragma unroll
                  for (int k = 0; k < 4; ++k) { bias[k] = t0[k]; bias[4 + k] = t1[k]; } }
#pragma unroll 1
                for (int rg = bx * 2 + sub; rg < 4096 + 128; rg += 2 * G) {
                    const bool prompt = rg < 4096; const int bs = rg - 4096;
                    const int rowbase = prompt ? rg * 4 : MP + bs * 4; const int t = rowbase & (SEQ - 1);
                    float x[7][8];
                    u32x4 r[7];
#pragma unroll
                    for (int j = 0; j < 7; ++j) r[j] = (u32x4){0u, 0u, 0u, 0u};
#pragma unroll
                    for (int j = 3; j < 7; ++j) r[j] = __builtin_nontemporal_load((const u32x4*)(U + (size_t)(rowbase + j - 3) * INW + OX + ch0));
                    if (prompt && t > 0) {
#pragma unroll
                        for (int j = 0; j < 3; ++j) r[j] = *(const u32x4*)(U + (size_t)(rowbase + j - 3) * INW + OX + ch0); }
#pragma unroll
                    for (int j = 0; j < 7; ++j) { x[j][0] = bflo(r[j].x); x[j][1] = bfhi(r[j].x); x[j][2] = bflo(r[j].y); x[j][3] = bfhi(r[j].y); x[j][4] = bflo(r[j].z); x[j][5] = bfhi(r[j].z); x[j][6] = bflo(r[j].w); x[j][7] = bfhi(r[j].w); }
                    if (!prompt) { const float* sp = state_conv + (size_t)bs * 3 * CONVD + ch0;
#pragma unroll
                        for (int j = 0; j < 3; ++j) { const f32x4 a0 = *(const f32x4*)(sp + j * CONVD), a1 = *(const f32x4*)(sp + j * CONVD + 4);
#pragma unroll
                            for (int k = 0; k < 4; ++k) { x[j][k] = a0[k]; x[j][4 + k] = a1[k]; } } }
#pragma unroll
                    for (int tt = 0; tt < 4; ++tt) { float y[8];
#pragma unroll
                        for (int k = 0; k < 8; ++k) { const float sacc = bias[k] + x[tt][k] * wv[0][k] + x[tt + 1][k] * wv[1][k] + x[tt + 2][k] * wv[2][k] + x[tt + 3][k] * wv[3][k]; y[k] = siluf_(sacc); }
                        u32x4 o; o.x = pk2(y[0], y[1]); o.y = pk2(y[2], y[3]); o.z = pk2(y[4], y[5]); o.w = pk2(y[6], y[7]);
                        *(u32x4*)(XC + (size_t)(rowbase + tt) * CONVD + ch0) = o; }
                    float* obase = nullptr;
                    if (prompt) { if (t == SEQ - 4) obase = out + O_CP + (size_t)(rowbase >> 11) * 3 * CONVD; } else obase = out + O_CS + (size_t)bs * 3 * CONVD;
                    if (obase) {
#pragma unroll
                        for (int j = 0; j < 3; ++j) { float* op = obase + (size_t)j * CONVD + ch0; *(f32x4*)op = (f32x4){x[4 + j][0], x[4 + j][1], x[4 + j][2], x[4 + j][3]}; *(f32x4*)(op + 4) = (f32x4){x[4 + j][4], x[4 + j][5], x[4 + j][6], x[4 + j][7]}; } }
                }
            }
        }
        LAS bf16_t* Ks = (LAS bf16_t*)lds; LAS bf16_t* Vt = (LAS bf16_t*)(lds + 272 * KS_LD * 2);
        LAS bf16_t* Ks2 = (LAS bf16_t*)(lds + 2 * 272 * KS_LD * 2); LAS bf16_t* Vt2 = (LAS bf16_t*)(lds + 2 * 272 * KS_LD * 2 + 160 * KS_LD * 2);
        for (int unit = bx; unit < 256; unit += G) {
            LOCAL_IDS const int b = unit >> 5, qblk = (unit >> 1) & 15, kvh = unit & 1, bs = unit >> 1, kvh2 = unit & 1;
            const int hq = kvh * 4 + (w >> 1), qh = w & 1; const float sink = sinks[hq];
            bf16x8 qf[4][2];
#pragma unroll
            for (int i = 0; i < 4; ++i) { const bf16_t* qp = U + (size_t)(b * SEQ + qblk * 128 + qh * 64 + i * 16 + c16) * INW + hq * 64; qf[i][0] = *(const bf16x8*)(qp + quad * 8); qf[i][1] = *(const bf16x8*)(qp + 32 + quad * 8); }
            const int sw = unit & 7;
            const int gq = c16 >> 2, ts = c16 & 3, hq2 = kvh2 * 4 + gq;
            bf16_t* qp2 = U + (size_t)(MP + bs * 4 + ts) * INW + hq2 * 64; bf16x8 q2a = qf[0][0], q2b = qf[0][1];
            if (w == sw) { q2a = *(const bf16x8*)(qp2 + quad * 8); q2b = *(const bf16x8*)(qp2 + 32 + quad * 8); }
            __syncthreads();
#pragma unroll
            for (int pc = tid; pc < 272 * 8; pc += 512) { const int kidx = pc >> 3, part = pc & 7; const int tok = (qblk - 1) * 128 + kidx;
                u32x4 kv = (u32x4){0u, 0u, 0u, 0u}, vv = (u32x4){0u, 0u, 0u, 0u};
                if (kidx < 256 && tok >= 0) { const bf16_t* rp = U + (size_t)(b * SEQ + tok) * INW + kvh * 64 + part * 8; kv = *(const u32x4*)(rp + OKK); vv = *(const u32x4*)(rp + OV);
                    if (qblk == 15 && kidx >= 128) { const size_t oo = ((size_t)(b * 128 + kidx - 128) * 2 + kvh) * 64 + part * 8;
                        *(f32x4*)(out + O_KP + oo) = (f32x4){bflo(kv.x), bfhi(kv.x), bflo(kv.y), bfhi(kv.y)}; *(f32x4*)(out + O_KP + oo + 4) = (f32x4){bflo(kv.z), bfhi(kv.z), bflo(kv.w), bfhi(kv.w)};
                        *(f32x4*)(out + O_VP + oo) = (f32x4){bflo(vv.x), bfhi(vv.x), bflo(vv.y), bfhi(vv.y)}; *(f32x4*)(out + O_VP + oo + 4) = (f32x4){bflo(vv.z), bfhi(vv.z), bflo(vv.w), bfhi(vv.w)}; } }
                *(LAS u32x4*)(Ks + kidx * KS_LD + part * 8) = kv; *(LAS u32x4*)(Vt + kidx * KS_LD + part * 8) = vv; }
#pragma unroll
            for (int pc = tid; pc < 160 * 8; pc += 512) { const int kidx = pc >> 3, part = pc & 7;
                float kf[8], vf[8];
#pragma unroll
                for (int i = 0; i < 8; ++i) { kf[i] = 0.f; vf[i] = 0.f; }
                if (kidx < 128) { const size_t io = ((size_t)(bs * 128 + kidx) * 2 + kvh2) * 64 + part * 8;
                    const f32x4 k0 = __builtin_nontemporal_load((const f32x4*)(cache_k + io)), k1 = __builtin_nontemporal_load((const f32x4*)(cache_k + io + 4)), v0 = __builtin_nontemporal_load((const f32x4*)(cache_v + io)), v1 = __builtin_nontemporal_load((const f32x4*)(cache_v + io + 4));
#pragma unroll
                    for (int i = 0; i < 4; ++i) { kf[i] = k0[i]; kf[4 + i] = k1[i]; vf[i] = v0[i]; vf[4 + i] = v1[i]; }
                } else if (kidx < 132) { const bf16_t* rp = U + (size_t)(MP + bs * 4 + kidx - 128) * INW + kvh2 * 64 + part * 8; const u32x4 kv = *(const u32x4*)(rp + OKK), vv = *(const u32x4*)(rp + OV);
                    kf[0] = bflo(kv.x); kf[1] = bfhi(kv.x); kf[2] = bflo(kv.y); kf[3] = bfhi(kv.y); kf[4] = bflo(kv.z); kf[5] = bfhi(kv.z); kf[6] = bflo(kv.w); kf[7] = bfhi(kv.w);
                    vf[0] = bflo(vv.x); vf[1] = bfhi(vv.x); vf[2] = bflo(vv.y); vf[3] = bfhi(vv.y); vf[4] = bflo(vv.z); vf[5] = bfhi(vv.z); vf[6] = bflo(vv.w); vf[7] = bfhi(vv.w); }
                if (kidx >= 4 && kidx < 132) { const size_t oo = ((size_t)(bs * 128 + kidx - 4) * 2 + kvh2) * 64 + part * 8;
                    __builtin_nontemporal_store((f32x4){kf[0], kf[1], kf[2], kf[3]}, (f32x4*)(out + O_KS + oo)); __builtin_nontemporal_store((f32x4){kf[4], kf[5], kf[6], kf[7]}, (f32x4*)(out + O_KS + oo + 4));
                    __builtin_nontemporal_store((f32x4){vf[0], vf[1], vf[2], vf[3]}, (f32x4*)(out + O_VS + oo)); __builtin_nontemporal_store((f32x4){vf[4], vf[5], vf[6], vf[7]}, (f32x4*)(out + O_VS + oo + 4)); }
                u32x4 kw; kw.x = pk2(kf[0], kf[1]); kw.y = pk2(kf[2], kf[3]); kw.z = pk2(kf[4], kf[5]); kw.w = pk2(kf[6], kf[7]);
                u32x4 vw; vw.x = pk2(vf[0], vf[1]); vw.y = pk2(vf[2], vf[3]); vw.z = pk2(vf[4], vf[5]); vw.w = pk2(vf[6], vf[7]);
                *(LAS u32x4*)(Ks2 + kidx * KS_LD + part * 8) = kw; *(LAS u32x4*)(Vt2 + kidx * KS_LD + part * 8) = vw; }
            __syncthreads();
#pragma unroll
            for (int i = 0; i < 4; ++i) { const int r0 = qh * 64 + i * 16;
                bf16_t* qp = U + (size_t)(b * SEQ + qblk * 128 + r0 + c16) * INW + hq * 64;
                attn_tile(Ks, Vt, qp, qf[i][0], qf[i][1], r0 >> 4, r0 + c16, qblk == 0 ? 128 : 0, sink, lane); }
            if (w == sw) attn_tile(Ks2, Vt2, qp2, q2a, q2b, 0, ts, 0, sinks[hq2], lane);
        }
    }
    SEAM(2); STAMP(3);
    if (IN(3)) {
        const float* state_ssm = kin(5); const float* a_log = kin(12); const float* d_skip = kin(13);
        for (int ord = 0; ord < 2; ++ord) {
        if (((ord ^ bx) & 1) == 0) {
            LAS bf16_t* Bt = (LAS bf16_t*)lds;
            LAS bf16_t* Xs = (LAS bf16_t*)(lds + 18432);
            LAS float* scl = (LAS float*)(lds + 18432 + 73728);
            for (int unit = bx; unit < 256; unit += G) {
                LOCAL_IDS const int b = unit >> 5, c = (unit >> 1) & 15, g = unit & 1, row0 = b * SEQ + c * 128, h = 8 * g + w;
                __syncthreads();
                { const float A = -__expf(a_log[h]);
                  const float d0 = DT[(size_t)(row0 + lane) * 16 + h], d1 = DT[(size_t)(row0 + 64 + lane) * 16 + h];
                  float v0 = d0 * A, v1 = d1 * A;
#pragma unroll
                  for (int o = 1; o < 64; o <<= 1) { const float t0 = __builtin_bit_cast(float, __builtin_amdgcn_ds_bpermute((lane - o) << 2, __builtin_bit_cast(int, v0))), t1 = __builtin_bit_cast(float, __builtin_amdgcn_ds_bpermute((lane - o) << 2, __builtin_bit_cast(int, v1))); if (lane >= o) { v0 += t0; v1 += t1; } }
                  v1 += __builtin_bit_cast(float, __builtin_amdgcn_readlane(__builtin_bit_cast(int, v0), 63)); const float last = __builtin_bit_cast(float, __builtin_amdgcn_readlane(__builtin_bit_cast(int, v1), 63));
                  scl[w * 128 + lane] = d0 * __expf(last - v0); scl[w * 128 + 64 + lane] = d1 * __expf(last - v1);
                  if (lane == 0) CD[(b * 16 + c) * 16 + h] = __expf(last); }
                f32x4 acc[8][4];
#pragma unroll
                for (int nt = 0; nt < 8; ++nt)
#pragma unroll
                    for (int pt = 0; pt < 4; ++pt) acc[nt][pt] = (f32x4){0.f, 0.f, 0.f, 0.f};
                for (int half = 0; half < 2; ++half) {
                    __syncthreads();
#pragma unroll 2
                    for (int pc = tid; pc < 1024; pc += 512) { const int lr = pc >> 4, part = pc & 15;
                        *(LAS u32x4*)(Bt + lr * 136 + part * 8) = *(const u32x4*)(XC + (size_t)(row0 + half * 64 + lr) * CONVD + 1024 + g * 128 + part * 8); }
#pragma unroll 1
                    for (int pc0 = tid; pc0 < 4096; pc0 += 2048) { u32x4 vv[4];
#pragma unroll
                        for (int k = 0; k < 4; ++k) { const int pc = pc0 + 512 * k, lr = pc >> 6, part = pc & 63; vv[k] = *(const u32x4*)(XC + (size_t)(row0 + half * 64 + lr) * CONVD + g * 512 + part * 8); }
#pragma unroll
                        for (int k = 0; k < 4; ++k) { const int pc = pc0 + 512 * k, lr = pc >> 6, part = pc & 63, hh = part >> 3; const u32x4 v = vv[k];
                            const float sc = scl[hh * 128 + half * 64 + lr];
                            u32x4 o; o.x = pk2(bflo(v.x) * sc, bfhi(v.x) * sc); o.y = pk2(bflo(v.y) * sc, bfhi(v.y) * sc); o.z = pk2(bflo(v.z) * sc, bfhi(v.z) * sc); o.w = pk2(bflo(v.w) * sc, bfhi(v.w) * sc);
                            *(LAS u32x4*)(Xs + (hh * 64 + lr) * 72 + (part & 7) * 8) = o; } }
                    __syncthreads();
                    const unsigned baddr = LDSADDR(Bt) + (unsigned)(((quad * 8 + (c16 >> 2)) * 136 + 4 * (c16 & 3)) * 2);
                    const unsigned xaddr = LDSADDR(Xs) + (unsigned)(((w * 64 + quad * 8 + (c16 >> 2)) * 72 + 4 * (c16 & 3)) * 2);
#pragma unroll
                    for (int ks = 0; ks < 2; ++ks) { bf16x8 xf[4]; tr_frag4<0, 32, 64, 96, 4 * 144>(xaddr + ks * (32 * 144), xf);
#pragma unroll
                        for (int nh = 0; nh < 2; ++nh) { bf16x8 bfr[4]; tr_frag4<0, 32, 64, 96, 4 * 272>(baddr + ks * (32 * 272) + nh * 128, bfr);
#pragma unroll
                            for (int n4 = 0; n4 < 4; ++n4)
#pragma unroll
                                for (int pt = 0; pt < 4; ++pt) acc[nh * 4 + n4][pt] = MFMA16(bfr[n4], xf[pt], acc[nh * 4 + n4][pt]); } }
                }
                bf16_t* sp = STB + ((size_t)((b * 16 + c) * 16 + h) * 64) * 128;
#pragma unroll
                for (int nt = 0; nt < 8; ++nt)
#pragma unroll
                    for (int pt = 0; pt < 4; ++pt) { u32x2 o; o.x = pk2(acc[nt][pt][0], acc[nt][pt][1]); o.y = pk2(acc[nt][pt][2], acc[nt][pt][3]); *(u32x2*)(sp + (size_t)(pt * 16 + c16) * 128 + nt * 16 + quad * 4) = o; }
            }
        }
        else {
            LAS float* xr = (LAS float*)lds;
            LAS float* xdt = (LAS float*)(lds + 8192);
            LAS float* vals = (LAS float*)(lds + 16384);
            LAS float* rs = (LAS float*)(lds + 24576);
            for (int unit = bx; unit < 256; unit += G) {
                LOCAL_IDS const int b = unit >> 1, g = unit & 1, h = 8 * g + w, R0 = MP + b * 4;
                __syncthreads();
                const float A = -__expf(a_log[h]); float dtv[4], dA[4];
#pragma unroll
                for (int t = 0; t < 4; ++t) { dtv[t] = DT[(size_t)(R0 + t) * 16 + h]; dA[t] = __expf(dtv[t] * A); }
                { const int t = quad, p0 = c16 * 4; const u32x2 v = *(const u32x2*)(XC + (size_t)(R0 + t) * CONVD + h * 64 + p0);
                  const float dtt = t == 0 ? dtv[0] : (t == 1 ? dtv[1] : (t == 2 ? dtv[2] : dtv[3]));
                  const float f0 = bflo(v.x), f1 = bfhi(v.x), f2 = bflo(v.y), f3 = bfhi(v.y);
                  LAS float* p = xr + (w * 4 + t) * 64 + p0; p[0] = f0; p[1] = f1; p[2] = f2; p[3] = f3;
                  LAS float* q = xdt + (w * 4 + t) * 64 + p0; q[0] = f0 * dtt; q[1] = f1 * dtt; q[2] = f2 * dtt; q[3] = f3 * dtt; }
                float Bv[4][8], Cv[4][8];
#pragma unroll
                for (int t = 0; t < 4; ++t) { const bf16_t* rp = XC + (size_t)(R0 + t) * CONVD + 1024 + g * 128 + c16 * 4;
                    const u32x2 b0 = *(const u32x2*)rp, b1 = *(const u32x2*)(rp + 64), c0 = *(const u32x2*)(rp + 256), c1 = *(const u32x2*)(rp + 320);
                    Bv[t][0] = bflo(b0.x); Bv[t][1] = bfhi(b0.x); Bv[t][2] = bflo(b0.y); Bv[t][3] = bfhi(b0.y); Bv[t][4] = bflo(b1.x); Bv[t][5] = bfhi(b1.x); Bv[t][6] = bflo(b1.y); Bv[t][7] = bfhi(b1.y);
                    Cv[t][0] = bflo(c0.x); Cv[t][1] = bfhi(c0.x); Cv[t][2] = bflo(c0.y); Cv[t][3] = bfhi(c0.y); Cv[t][4] = bflo(c1.x); Cv[t][5] = bfhi(c1.x); Cv[t][6] = bflo(c1.y); Cv[t][7] = bfhi(c1.y); }
                const float Dh = d_skip[h];
                LDS_WAIT();
                const float* sin_ = state_ssm + (size_t)(b * 16 + h) * 8192; float* sout = out + O_SS + (size_t)(b * 16 + h) * 8192;
#pragma unroll 1
                for (int i0 = 0; i0 < 16; i0 += 4) { f32x4 H0[4], H1[4];
#pragma unroll
                  for (int ii = 0; ii < 4; ++ii) { const int p = 4 * (i0 + ii) + quad; H0[ii] = __builtin_nontemporal_load((const f32x4*)(sin_ + p * 128 + c16 * 4)); H1[ii] = __builtin_nontemporal_load((const f32x4*)(sin_ + p * 128 + 64 + c16 * 4)); }
#pragma unroll
                  for (int ii = 0; ii < 4; ++ii) { const int p = 4 * (i0 + ii) + quad;
                    f32x4 h0 = H0[ii], h1 = H1[ii];
                    float yk = 0.f;
#pragma unroll
                    for (int t = 0; t < 4; ++t) { const float xd = xdt[(w * 4 + t) * 64 + p]; float y = 0.f;
#pragma unroll
                        for (int k = 0; k < 4; ++k) { h0[k] = h0[k] * dA[t] + xd * Bv[t][k]; y += h0[k] * Cv[t][k]; h1[k] = h1[k] * dA[t] + xd * Bv[t][4 + k]; y += h1[k] * Cv[t][4 + k]; }
                        y = row16_sum(y);
                        if (c16 == t) yk = y + Dh * xr[(w * 4 + t) * 64 + p]; }
                    __builtin_nontemporal_store(h0, (f32x4*)(sout + p * 128 + c16 * 4)); __builtin_nontemporal_store(h1, (f32x4*)(sout + p * 128 + 64 + c16 * 4));
                    if (c16 < 4) { const float z = bf1(U[(size_t)(R0 + c16) * INW + OZ + h * 64 + p]); vals[(w * 4 + c16) * 64 + p] = yk * siluf_(z); } } }
                __syncthreads();
                if (w < 4) { float s = 0.f;
#pragma unroll
                    for (int hh = 0; hh < 8; ++hh) { const float v = vals[(hh * 4 + w) * 64 + lane]; s += v * v; }
                    s = wave_sum(s); if (lane == 0) rs[w] = rsqrtf(s * (1.f / 512.f) + EPS); }
                __syncthreads();
                { const int t = tid >> 7, ch4 = (tid & 127) * 4, hh = ch4 >> 6, p = ch4 & 63; const float r = rs[t]; const LAS float* vp = vals + (hh * 4 + t) * 64 + p;
                  u32x2 o; o.x = pk2(vp[0] * r, vp[1] * r); o.y = pk2(vp[2] * r, vp[3] * r);
                  *(u32x2*)(U + (size_t)(R0 + t) * INW + OZ + g * 512 + ch4) = o; }
            }
        }
        }
    }
    SEAM(3); STAMP(4);
    if (IN(4)) {
        LOCAL_IDS const int gtid = bx * 512 + tid;
        for (int idx = gtid; idx < 131072; idx += NGT) { const int n8 = idx & 15, p = (idx >> 4) & 63, h = (idx >> 10) & 15, b = idx >> 14;
            float hc[8];
#pragma unroll
            for (int k = 0; k < 8; ++k) hc[k] = 0.f;
            bf16_t* ptr0 = STB + ((size_t)(b * 16 * 16 + h) * 64 + p) * 128 + n8 * 8; u32x4 svv[16]; float dd[16];
#pragma unroll
            for (int c = 0; c < 16; ++c) { svv[c] = __builtin_nontemporal_load((const u32x4*)(ptr0 + (size_t)c * (16 * 8192))); dd[c] = CD[(b * 16 + c) * 16 + h]; }
#pragma unroll
            for (int c = 0; c < 16; ++c) { const u32x4 sv = svv[c];
                u32x4 o; o.x = pk2(hc[0], hc[1]); o.y = pk2(hc[2], hc[3]); o.z = pk2(hc[4], hc[5]); o.w = pk2(hc[6], hc[7]); *(u32x4*)(ptr0 + (size_t)c * (16 * 8192)) = o;
                const float d = dd[c];
                hc[0] = hc[0] * d + bflo(sv.x); hc[1] = hc[1] * d + bfhi(sv.x); hc[2] = hc[2] * d + bflo(sv.y); hc[3] = hc[3] * d + bfhi(sv.y);
                hc[4] = hc[4] * d + bflo(sv.z); hc[5] = hc[5] * d + bfhi(sv.z); hc[6] = hc[6] * d + bflo(sv.w); hc[7] = hc[7] * d + bfhi(sv.w); }
            float* op = out + O_SP + ((size_t)(b * 16 + h) * 64 + p) * 128 + n8 * 8;
            __builtin_nontemporal_store((f32x4){hc[0], hc[1], hc[2], hc[3]}, (f32x4*)op); __builtin_nontemporal_store((f32x4){hc[4], hc[5], hc[6], hc[7]}, (f32x4*)(op + 4)); }
    }
    SEAM(4); STAMP(5);
    if (IN(5)) {
        const float* a_log = kin(12); const float* d_skip = kin(13);
        LAS bf16_t* Cs = (LAS bf16_t*)lds; LAS bf16_t* Bs = (LAS bf16_t*)(lds + 34816); LAS bf16_t* CBs = (LAS bf16_t*)(lds + 69632);
        LAS bf16_t* Xt = (LAS bf16_t*)(lds + 104448 + w * 5120);
        LAS float* acs = (LAS float*)(lds + 145408); LAS float* dts = (LAS float*)(lds + 149504); LAS float* ssq = (LAS float*)(lds + 153600);
        for (int unit = bx; unit < 256; unit += G) {
            LOCAL_IDS const int b = unit >> 5, c = (unit >> 1) & 15, g = unit & 1, row0 = b * SEQ + c * 128, h = 8 * g + w;
            __syncthreads();
            { const float A = -__expf(a_log[h]);
              const float d0 = DT[(size_t)(row0 + lane) * 16 + h], d1 = DT[(size_t)(row0 + 64 + lane) * 16 + h];
              float v0 = d0 * A, v1 = d1 * A;
#pragma unroll
              for (int o = 1; o < 64; o <<= 1) { const float t0 = __builtin_bit_cast(float, __builtin_amdgcn_ds_bpermute((lane - o) << 2, __builtin_bit_cast(int, v0))), t1 = __builtin_bit_cast(float, __builtin_amdgcn_ds_bpermute((lane - o) << 2, __builtin_bit_cast(int, v1))); if (lane >= o) { v0 += t0; v1 += t1; } }
              v1 += __builtin_bit_cast(float, __builtin_amdgcn_readlane(__builtin_bit_cast(int, v0), 63));
              acs[w * 128 + lane] = v0; acs[w * 128 + 64 + lane] = v1; dts[w * 128 + lane] = d0; dts[w * 128 + 64 + lane] = d1; }
#pragma unroll 4
            for (int pc = tid; pc < 2048; pc += 512) { const int lr = pc >> 4, part = pc & 15; const bf16_t* rp = XC + (size_t)(row0 + lr) * CONVD + 1024 + g * 128 + part * 8;
                *(LAS u32x4*)(Bs + lr * 136 + part * 8) = __builtin_nontemporal_load((const u32x4*)rp); *(LAS u32x4*)(Cs + lr * 136 + part * 8) = __builtin_nontemporal_load((const u32x4*)(rp + 256)); }
            __syncthreads();
            {
                bf16x8 bfr[4];
#pragma unroll
                for (int ks = 0; ks < 4; ++ks) bfr[ks] = *(const LAS bf16x8*)(Bs + (16 * w + c16) * 136 + ks * 32 + quad * 8);
#pragma unroll
                for (int lt = 0; lt < 8; ++lt) { f32x4 d = (f32x4){0.f, 0.f, 0.f, 0.f};
#pragma unroll
                    for (int ks = 0; ks < 4; ++ks) { const bf16x8 cfr = *(const LAS bf16x8*)(Cs + (lt * 16 + c16) * 136 + ks * 32 + quad * 8); d = MFMA16(bfr[ks], cfr, d); }
                    u32x2 o; o.x = pk2(d[0], d[1]); o.y = pk2(d[2], d[3]); *(LAS u32x2*)(CBs + (lt * 16 + c16) * 136 + 16 * w + quad * 4) = o; }
            }
            __syncthreads();
            f32x4 acc[4][8];
#pragma unroll
            for (int pt = 0; pt < 4; ++pt)
#pragma unroll
                for (int lt = 0; lt < 8; ++lt) acc[pt][lt] = (f32x4){0.f, 0.f, 0.f, 0.f};
            const bf16_t* Hp = STB + (size_t)((b * 16 + c) * 16 + h) * 8192;
#pragma unroll
            for (int kh = 0; kh < 2; ++kh) { bf16x8 hf[2][4];
#pragma unroll
              for (int k2 = 0; k2 < 2; ++k2)
#pragma unroll
                for (int pt = 0; pt < 4; ++pt) hf[k2][pt] = __builtin_nontemporal_load((const bf16x8*)(Hp + (pt * 16 + c16) * 128 + (kh * 2 + k2) * 32 + quad * 8));
#pragma unroll
              for (int k2 = 0; k2 < 2; ++k2) {
#pragma unroll
                for (int lt = 0; lt < 8; ++lt) { const bf16x8 cfr = *(const LAS bf16x8*)(Cs + (lt * 16 + c16) * 136 + (kh * 2 + k2) * 32 + quad * 8);
#pragma unroll
                    for (int pt = 0; pt < 4; ++pt) acc[pt][lt] = MFMA16(hf[k2][pt], cfr, acc[pt][lt]); }
                asm volatile("" ::: "memory"); } }
#pragma unroll
            for (int lt = 0; lt < 8; ++lt) { const float e = __expf(acs[w * 128 + lt * 16 + c16]);
#pragma unroll
                for (int pt = 0; pt < 4; ++pt) acc[pt][lt] = acc[pt][lt] * e; }
            __builtin_amdgcn_sched_barrier(0);
            u32x4 xq[4][4];
#pragma unroll
            for (int k = 0; k < 4; ++k) { const int pc = lane + 64 * k, sr = pc >> 3, part = pc & 7; xq[0][k] = __builtin_nontemporal_load((const u32x4*)(XC + (size_t)(row0 + sr) * CONVD + h * 64 + part * 8)); }
#pragma unroll
            for (int sq = 0; sq < 4; ++sq) {
                asm volatile("s_waitcnt lgkmcnt(0)" ::: "memory");
#pragma unroll
                for (int k = 0; k < 4; ++k) { const int pc = lane + 64 * k, sr = pc >> 3, part = pc & 7; *(LAS u32x4*)(Xt + sr * 72 + part * 8) = xq[sq][k]; }
                if (sq < 3) {
#pragma unroll
                    for (int k = 0; k < 4; ++k) { const int pc = lane + 64 * k, sr = pc >> 3, part = pc & 7; xq[sq + 1][k] = __builtin_nontemporal_load((const u32x4*)(XC + (size_t)(row0 + (sq + 1) * 32 + sr) * CONVD + h * 64 + part * 8)); } }
                asm volatile("s_waitcnt lgkmcnt(0)" ::: "memory");
                bf16x8 xf[4]; tr_frag4<0, 32, 64, 96, 4 * 144>(LDSADDR(Xt) + (unsigned)(((quad * 8 + (c16 >> 2)) * 72 + 4 * (c16 & 3)) * 2), xf);
                const f32x4 as0 = *(const LAS f32x4*)(acs + w * 128 + sq * 32 + quad * 8), as1 = *(const LAS f32x4*)(acs + w * 128 + sq * 32 + quad * 8 + 4);
                const f32x4 ds0 = *(const LAS f32x4*)(dts + w * 128 + sq * 32 + quad * 8), ds1 = *(const LAS f32x4*)(dts + w * 128 + sq * 32 + quad * 8 + 4);
#pragma unroll
                for (int lt = 0; lt < 8; ++lt) { if (lt >= 2 * sq) {
                    const int l = lt * 16 + c16; const float al = acs[w * 128 + l];
                    const u32x4 cb = *(const LAS u32x4*)(CBs + l * 136 + sq * 32 + quad * 8);
                    const int s0 = sq * 32 + quad * 8;
                    float wv[8];
                    wv[0] = bflo(cb.x); wv[1] = bfhi(cb.x); wv[2] = bflo(cb.y); wv[3] = bfhi(cb.y); wv[4] = bflo(cb.z); wv[5] = bfhi(cb.z); wv[6] = bflo(cb.w); wv[7] = bfhi(cb.w);
#pragma unroll
                    for (int i = 0; i < 4; ++i) { wv[i] = (s0 + i <= l) ? wv[i] * __expf(fminf(al - as0[i], 0.f)) * ds0[i] : 0.f; wv[4 + i] = (s0 + 4 + i <= l) ? wv[4 + i] * __expf(fminf(al - as1[i], 0.f)) * ds1[i] : 0.f; }
                    u32x4 ww; ww.x = pk2(wv[0], wv[1]); ww.y = pk2(wv[2], wv[3]); ww.z = pk2(wv[4], wv[5]); ww.w = pk2(wv[6], wv[7]);
                    const bf16x8 wf = __builtin_bit_cast(bf16x8, ww);
#pragma unroll
                    for (int pt = 0; pt < 4; ++pt) acc[pt][lt] = MFMA16(xf[pt], wf, acc[pt][lt]);
                    asm volatile("" ::: "memory"); } }
            }
            const float Dh = d_skip[h];
#pragma unroll
            for (int lt = 0; lt < 8; ++lt) { const int l = lt * 16 + c16; const size_t tok = (size_t)(row0 + l); float ss = 0.f;
#pragma unroll
                for (int pt = 0; pt < 4; ++pt) { const int pb = pt * 16 + quad * 4;
                    const u32x2 xv = *(const u32x2*)(XC + tok * CONVD + h * 64 + pb), zv = *(const u32x2*)(U + tok * INW + OZ + h * 64 + pb);
                    const float xf0 = bflo(xv.x), xf1 = bfhi(xv.x), xf2 = bflo(xv.y), xf3 = bfhi(xv.y);
                    const float z0 = bflo(zv.x), z1 = bfhi(zv.x), z2 = bflo(zv.y), z3 = bfhi(zv.y);
                    f32x4 v = acc[pt][lt];
                    v[0] = (v[0] + Dh * xf0) * siluf_(z0); v[1] = (v[1] + Dh * xf1) * siluf_(z1); v[2] = (v[2] + Dh * xf2) * siluf_(z2); v[3] = (v[3] + Dh * xf3) * siluf_(z3);
                    acc[pt][lt] = v; ss += (v[0] * v[0] + v[1] * v[1]) + (v[2] * v[2] + v[3] * v[3]); }
                ss += __shfl_xor(ss, 16); ss += __shfl_xor(ss, 32);
                if (quad == 0) ssq[w * 128 + l] = ss;
                if (lt & 1) asm volatile("" ::: "memory"); }
            __syncthreads();
#pragma unroll
            for (int lt = 0; lt < 8; ++lt) { const int l = lt * 16 + c16; const size_t tok = (size_t)(row0 + l); float s = 0.f;
#pragma unroll
                for (int ww = 0; ww < 8; ++ww) s += ssq[ww * 128 + l];
                const float r = rsqrtf(s * (1.f / 512.f) + EPS);
#pragma unroll
                for (int pt = 0; pt < 4; ++pt) { const f32x4 v = acc[pt][lt] * r; u32x2 o; o.x = pk2(v[0], v[1]); o.y = pk2(v[2], v[3]);
                    *(u32x2*)(U + tok * INW + OZ + h * 64 + pt * 16 + quad * 4) = o; }
                asm volatile("" ::: "memory"); }
        }
    }
    SEAM(5); STAMP(6);
    if (IN(6)) {
        { pg8::Gemm g{U, WOA, M, DM, 1536, INW, 1536}; pg8::StaticOrder S; S.init(MP, DM, G, bx, 6, 2); EpiGate2 E{U, MERGED}; pg8::gemm_phase<EpiGate2, 256, 244 * MiB, -1, 8>(lds, g, S, E); }
    }
    SEAM(6); STAMP(7);
    if (IN(7)) {
        const float* x_p = kin(0);
        {
            LOCAL_IDS const float* pa = (const float*)(ws + 244 * MiB);
            for (int e4 = bx * 512 + tid; e4 < 512 * 256; e4 += NGT) { const int row = e4 >> 8, c4 = (e4 & 255) * 4;
                f32x4 sa = (f32x4){0.f, 0.f, 0.f, 0.f}, sb = (f32x4){0.f, 0.f, 0.f, 0.f};
#pragma unroll
                for (int sl = 0; sl < 6; ++sl) { const f32x4 v = *(const f32x4*)(pa + ((size_t)sl * 512 + row) * DM + c4); if (sl < 2) sa += v; else sb += v; }
                const bf16_t* up = U + (size_t)(MP + row) * INW; const u32x2 ga = *(const u32x2*)(up + OGA + c4), gb = *(const u32x2*)(up + OGB + c4);
                u32x2 o; o.x = pk2(sigmoidf_(bflo(ga.x)) * sa[0] + sigmoidf_(bflo(gb.x)) * sb[0], sigmoidf_(bfhi(ga.x)) * sa[1] + sigmoidf_(bfhi(gb.x)) * sb[1]);
                o.y = pk2(sigmoidf_(bflo(ga.y)) * sa[2] + sigmoidf_(bflo(gb.y)) * sb[2], sigmoidf_(bfhi(ga.y)) * sa[3] + sigmoidf_(bfhi(gb.y)) * sb[3]);
                st_wt8(MERGED + (size_t)(MP + row) * DM + c4, o.x, o.y); }
            SOFT_ARRIVE(0); }
        pg8::Gemm g{MERGED, WO, M, DM, DM, DM, DM}; pg8::StaticOrder S; S.init(MP, DM, G, bx, 4, 2);
        EpiRes<1> E{x_p, X1B, SSQ2}; pg8::gemm_phase<EpiRes<1>, 256, 244 * MiB, 0>(lds, g, S, E);
    }
    SEAM(7); STAMP(8);
    if (IN(8)) {
        {
            LOCAL_IDS const float* x_s = kin(1); const float* p4 = (const float*)(ws + 244 * MiB);
            for (int row = gw; row < 512; row += NGW) { float ss = 0.f;
#pragma unroll
                for (int j = 0; j < 4; ++j) { const int c = lane * 4 + 256 * j; f32x4 v = *(const f32x4*)(x_s + (size_t)row * DM + c);
#pragma unroll
                    for (int sl = 0; sl < 4; ++sl) v += *(const f32x4*)(p4 + ((size_t)sl * 512 + row) * DM + c);
                    st_wt8(X1B + (size_t)(MP + row) * DM + c, pk2(v[0], v[1]), pk2(v[2], v[3]));
                    ss += (v[0] * v[0] + v[1] * v[1]) + (v[2] * v[2] + v[3] * v[3]); }
                ss = wave_sum(ss); if (lane == 0) __hip_atomic_store(SSQ2 + MP + row, ss, __ATOMIC_RELAXED, __HIP_MEMORY_SCOPE_AGENT); }
            SOFT_ARRIVE(1); }
        pg8::Gemm g{X1B, WUP, M, DFF, DM, DM, DM}; pg8::StaticOrder S; S.init(MP, DFF, G, bx, 4, 2);
        EpiUp E{SSQ2, ACT}; pg8::gemm_phase<EpiUp, 256, WS_MERGED, 1>(lds, g, S, E);
    }
    SEAM(8); STAMP(9);
    if (IN(9)) {
        {
            LOCAL_IDS const float* p5 = (const float*)(ws + WS_MERGED);
            for (int e4 = bx * 512 + tid; e4 < 512 * 1024; e4 += NGT) { const int row = e4 >> 10, c4 = (e4 & 1023) * 4;
                f32x4 v = (f32x4){0.f, 0.f, 0.f, 0.f};
#pragma unroll
                for (int sl = 0; sl < 4; ++sl) v += *(const f32x4*)(p5 + ((size_t)sl * 512 + row) * DFF + c4);
                const float rs = rsqrtf(SSQ2[MP + row] * (1.f / DM) + EPS);
#pragma unroll
                for (int i = 0; i < 4; ++i) { const float t = fmaxf(v[i] * rs, 0.f); v[i] = t * t; }
                st_wt8(ACT + (size_t)(MP + row) * DFF + c4, pk2(v[0], v[1]), pk2(v[2], v[3])); }
            SOFT_ARRIVE(2); }
        pg8::Gemm g{ACT, WDN, M, DM, DFF, DFF, DFF}; pg8::StaticOrder S; S.init(MP, DM, G, bx, 16, 2);
        EpiRes<0> E{nullptr, X1B, nullptr}; pg8::gemm_phase<EpiRes<0>, 256, WS_MERGED, 2>(lds, g, S, E);
    }
    SEAM(9); STAMP(10);
    if (IN(10)) {
        const float* final_norm = kin(21);
        LOCAL_IDS
        const float* p6 = (const float*)(ws + WS_MERGED);
        const bool bal = NGW >= 1024;
        const int m_first = bal ? (gw < MS ? MP + gw : gw - MS) : gw, m_step = bal ? (gw < MS ? M : NGW - MS) : NGW, m_end = (bal && gw >= MS) ? MP : M;
#pragma unroll 2
        for (int m = m_first; m < m_end; m += m_step) { float* xr = X1 + (size_t)m * DM; f32x4 v[4]; float ss = 0.f;
#pragma unroll
            for (int j = 0; j < 4; ++j) { const int cidx = lane * 4 + 256 * j; const u32x2 pv = *(const u32x2*)(X1B + (size_t)m * DM + cidx); v[j] = (f32x4){bflo(pv.x), bfhi(pv.x), bflo(pv.y), bfhi(pv.y)};
                if (m >= MP) {
#pragma unroll
                    for (int sl = 0; sl < 16; ++sl) v[j] += *(const f32x4*)(p6 + ((size_t)sl * 512 + (m - MP)) * DM + cidx); }
                ss += (v[j][0] * v[j][0] + v[j][1] * v[j][1]) + (v[j][2] * v[j][2] + v[j][3] * v[j][3]); }
            const float r = rsqrtf(wave_sum(ss) * (1.f / DM) + EPS);
#pragma unroll
            for (int j = 0; j < 4; ++j) { const int cidx = lane * 4 + 256 * j; const f32x4 fw = *(const f32x4*)(final_norm + cidx); __builtin_nontemporal_store(v[j] * r * fw, (f32x4*)(xr + cidx)); } }
    }
#ifdef PROBE_A
    STAMP(11);
    if (bx == 0 && tid0 == 0) { asm volatile("s_waitcnt vmcnt(0)" ::: "memory"); const float us = (float)(tstamp[PROBE_B] - tstamp[PROBE_A]) * 0.01f; out[0] = out[0] + 16.f + us * (1.f / PROBE_SCALE); }
#endif
#undef IN
#undef SEAM
}

#ifndef N_LAUNCH_MODE
#define N_LAUNCH_MODE 1
#endif
extern "C" void kernel_launch(void* const* d_in, const int* in_sizes, int n_in, void* d_out, int out_size, void* d_ws, size_t ws_size, hipStream_t stream) {
    static int grid = 0;
    if (grid == 0) {
        int dev = 0, cus = 0, per_cu = 0;
        hipGetDevice(&dev); hipDeviceGetAttribute(&cus, hipDeviceAttributeMultiprocessorCount, dev);
        if (hipFuncSetAttribute((const void*)mega, hipFuncAttributeMaxDynamicSharedMemorySize, LDS_BYTES) != hipSuccess) { fprintf(stderr, "hipFuncSetAttribute failed\n"); }
        if (hipOccupancyMaxActiveBlocksPerMultiprocessor(&per_cu, (const void*)mega, 512, LDS_BYTES) != hipSuccess || per_cu < 1) { fprintf(stderr, "occupancy query: %d\n", per_cu); per_cu = 1; }
        (void)hipGetLastError();
        grid = cus * 1;
        if (grid <= 0) grid = 256;
    }
    (void)hipMemsetAsync((unsigned char*)d_ws + WS_BAR, 0, 1024 + XCD_BAR_WORDS * 4, stream);
    Args a{};
    for (int i = 0; i < 22; ++i) a.in[i] = (const float*)d_in[i];
    a.out = (float*)d_out; a.ws = (unsigned char*)d_ws;
#if N_LAUNCH_MODE == 1
    a.ph_lo = 0; a.ph_hi = 11;
    void* args[] = {&a};
    hipError_t e = hipLaunchCooperativeKernel((const void*)mega, dim3(grid), dim3(512), args, LDS_BYTES, stream);
    if (e != hipSuccess) fprintf(stderr, "cooperative launch failed: %s (grid %d)\n", hipGetErrorString(e), grid);
#else
    for (int p = 0; p < 11; ++p) { a.ph_lo = p; a.ph_hi = p + 1; hipLaunchKernelGGL(mega, dim3(grid), dim3(512), LDS_BYTES, stream, a); }
#endif
}
```

```cpp
#include <hip/hip_runtime.h>
#include <hip/hip_cooperative_groups.h>
#include <cstdio>
#include <cstdint>
namespace cg = cooperative_groups;

#define LAS __attribute__((address_space(3)))
typedef unsigned short bf16_t;
typedef short bf16x8 __attribute__((ext_vector_type(8)));
typedef float f32x4 __attribute__((ext_vector_type(4)));
typedef float f32x2 __attribute__((ext_vector_type(2)));
typedef unsigned u32x4 __attribute__((ext_vector_type(4)));
typedef unsigned u32x2 __attribute__((ext_vector_type(2)));

constexpr int DM = 1024, MP = 16384, MS = 512, M = MP + MS, SEQ = 2048, NBATCH = 8, DBATCH = 128;
constexpr int INW = 5392, NPAD = 5632, DFF = 4096, CONVD = 1536;
constexpr int OQ = 0, OZ = 512, OKK = 1536, OV = 1664, OX = 1792, ODT = 3328, OGA = 3344, OGB = 4368;
constexpr float EPS = 1e-6f;
constexpr size_t O_YP = 0, O_YS = 16777216, O_KP = 17301504, O_VP = 17432576, O_CP = 17563648, O_SP = 17600512,
                 O_KS = 18649088, O_VS = 20746240, O_CS = 22843392, O_SS = 23433216;
constexpr size_t MiB = 1u << 20;
constexpr size_t WS_RSTD1 = 0, WS_SSQ2 = 128 * 1024, WS_SSQF = 256 * 1024, WS_CD = 384 * 1024, WS_BAR = 512 * 1024, WS_XB = 512 * 1024 + 1024;
constexpr size_t WS_WIN = 1 * MiB, WS_WOA = 12 * MiB, WS_WOB = 13 * MiB, WS_WO = 15 * MiB, WS_DT = 17 * MiB;
constexpr size_t WS_U = 20 * MiB;
constexpr size_t WS_X1B = 20 * MiB, WS_ACT = 54 * MiB;
constexpr size_t WS_XC = 194 * MiB;
constexpr size_t WS_MERGED = 194 * MiB, WS_WUP = 227 * MiB, WS_WDN = 235 * MiB;
constexpr int LDS_BYTES = 163840;

__device__ __forceinline__ int opaque(int x) { asm volatile("" : "+v"(x)); return x; }
__device__ __forceinline__ unsigned f2bf(float f) { unsigned u = __builtin_bit_cast(unsigned, f); return (u + 0x7fffu + ((u >> 16) & 1u)) >> 16; }
typedef __bf16 bf16x2_t __attribute__((ext_vector_type(2)));
__device__ __forceinline__ unsigned pk2(float lo, float hi) { const f32x2 v = {lo, hi}; const bf16x2_t b = __builtin_convertvector(v, bf16x2_t); return __builtin_bit_cast(unsigned, b); }
__device__ __forceinline__ unsigned cvt_pk_bf16(float lo, float hi) { return pk2(lo, hi); }
__device__ __forceinline__ float bflo(unsigned w) { return __builtin_bit_cast(float, w << 16); }
__device__ __forceinline__ float bfhi(unsigned w) { return __builtin_bit_cast(float, w & 0xffff0000u); }
__device__ __forceinline__ float bf1(bf16_t h) { return __builtin_bit_cast(float, (unsigned)h << 16); }
__device__ __forceinline__ float sigmoidf_(float x) { return __builtin_amdgcn_rcpf(1.f + __expf(-x)); }
__device__ __forceinline__ float siluf_(float x) { return x * __builtin_amdgcn_rcpf(1.f + __expf(-x)); }
__device__ __forceinline__ void st_wt8(void* p, unsigned lo, unsigned hi) { __hip_atomic_store((unsigned long long*)p, ((unsigned long long)hi << 32) | lo, __ATOMIC_RELAXED, __HIP_MEMORY_SCOPE_AGENT); }
__device__ __forceinline__ float row16_sum(float v) {
    v += __builtin_bit_cast(float, __builtin_amdgcn_update_dpp(0, __builtin_bit_cast(int, v), 0xB1, 0xF, 0xF, true));
    v += __builtin_bit_cast(float, __builtin_amdgcn_update_dpp(0, __builtin_bit_cast(int, v), 0x4E, 0xF, 0xF, true));
    v += __builtin_bit_cast(float, __builtin_amdgcn_update_dpp(0, __builtin_bit_cast(int, v), 0x141, 0xF, 0xF, true));
    v += __builtin_bit_cast(float, __builtin_amdgcn_update_dpp(0, __builtin_bit_cast(int, v), 0x140, 0xF, 0xF, true));
    return v;
}
__device__ __forceinline__ float wave_sum(float v) { v = row16_sum(v); v += __shfl_xor(v, 16); v += __shfl_xor(v, 32); return v; }
#define LDS_WAIT() asm volatile("s_waitcnt lgkmcnt(0)" ::: "memory")
#define MFMA16(a, b, c) __builtin_amdgcn_mfma_f32_16x16x32_bf16(a, b, c, 0, 0, 0)

template <int O0, int O1, int O2, int O3, int D> __device__ __forceinline__ void tr_frag4(unsigned addr, bf16x8 (&f)[4]) {
    u32x2 a0, b0, a1, b1, a2, b2, a3, b3;
    asm volatile("ds_read_b64_tr_b16 %0, %8 offset:%9\n\tds_read_b64_tr_b16 %1, %8 offset:%10\n\tds_read_b64_tr_b16 %2, %8 offset:%11\n\tds_read_b64_tr_b16 %3, %8 offset:%12\n\t"
                 "ds_read_b64_tr_b16 %4, %8 offset:%13\n\tds_read_b64_tr_b16 %5, %8 offset:%14\n\tds_read_b64_tr_b16 %6, %8 offset:%15\n\tds_read_b64_tr_b16 %7, %8 offset:%16\n\ts_waitcnt lgkmcnt(0)"
                 : "=&v"(a0), "=&v"(b0), "=&v"(a1), "=&v"(b1), "=&v"(a2), "=&v"(b2), "=&v"(a3), "=&v"(b3)
                 : "v"(addr), "i"(O0), "i"(O0 + D), "i"(O1), "i"(O1 + D), "i"(O2), "i"(O2 + D), "i"(O3), "i"(O3 + D) : "memory");
    f[0] = __builtin_bit_cast(bf16x8, (u32x4){a0.x, a0.y, b0.x, b0.y}); f[1] = __builtin_bit_cast(bf16x8, (u32x4){a1.x, a1.y, b1.x, b1.y});
    f[2] = __builtin_bit_cast(bf16x8, (u32x4){a2.x, a2.y, b2.x, b2.y}); f[3] = __builtin_bit_cast(bf16x8, (u32x4){a3.x, a3.y, b3.x, b3.y});
}
#define LDSADDR(p) ((unsigned)(size_t)(p))

__device__ __forceinline__ const float* kin(int k) {
    const __attribute__((address_space(4))) unsigned char* ka = (const __attribute__((address_space(4))) unsigned char*)__builtin_amdgcn_kernarg_segment_ptr();
    asm volatile("" : "+s"(ka));
    return *(const float* const __attribute__((address_space(4)))*)(ka + 8 * k);
}
__device__ __forceinline__ unsigned char* kws() { return (unsigned char*)kin(23); }

namespace pg8 {
constexpr int BM = 256, BK = 64, HALF = 128, HTB = HALF * BK * 2, STAGE_BYTES = 8 * HTB, NXCD = 8, WGM = 8;
__host__ __device__ __forceinline__ int lds_byte(int r, int c) { const int st = (r >> 4) * 2 + (c >> 5), rr = r & 15, cc = c & 31, ob = rr * 64 + cc * 2; return st * 1024 + (ob ^ (((ob >> 9) & 1) << 5)); }
__host__ __device__ __forceinline__ void stage_rc(int b, int& R, int& C) { const int st = b / 1024, sb = b % 1024, swz = sb ^ (((sb >> 9) & 1) << 5); R = (st >> 1) * 16 + swz / 64; C = (st & 1) * 32 + (swz % 64) / 2; }
__host__ __device__ __forceinline__ int perm32(int rho) { const int n = rho >> 4, i = rho & 15; return 8 * (i >> 2) + 4 * n + (i & 3); }
struct Unit { int pm, pn, ks, split; };
struct Gemm { const bf16_t* A; const bf16_t* Bt; int M, N, K, lda, ldb; };
struct StaticOrder {
    int nM, nN, nwg, G, c, S, Q;
    __device__ __forceinline__ void init(int M_, int N_, int G_, int c_, int S_ = 1, int sample_mtiles = 0) { nM = M_ / BM; nN = N_ / BM; nwg = nM * nN; G = G_; c = c_; S = S_; Q = sample_mtiles * nN * S_; }
    __device__ __forceinline__ bool next(int i, Unit& u) const {
        const long L = (long)i * G + c; const bool isS = L >= nwg; const int q = isS ? (int)(L - nwg) : 0;
        if (isS && q >= Q) return false;
        int wgid = isS ? 0 : (int)L; { const int qq = nwg / NXCD, r = nwg % NXCD, xcd = wgid % NXCD, off = wgid / NXCD; wgid = (xcd < r ? xcd * (qq + 1) : r * (qq + 1) + (xcd - r) * qq) + off; }
        const int nig = WGM * nN, gid = wgid / nig, fm = gid * WGM, gsz = (nM - fm) < WGM ? (nM - fm) : WGM;
        const int pmF = fm + ((wgid % nig) % gsz), pnF = (wgid % nig) / gsz;
        const int tile = q / S;
        u.pm = isS ? nM + tile / nN : pmF; u.pn = isS ? tile % nN : pnF; u.ks = isS ? q - tile * S : 0; u.split = isS ? 1 : 0;
        return true;
    }
};
template <class Epi, int KSL = 128, size_t PART_OFF = 0, int SOFT_IDX = -1, int MID_T = -1>
__device__ __forceinline__ void gemm_phase(LAS unsigned char* lds, const Gemm g, const StaticOrder& S, const Epi& E) {
    const int tid = opaque((int)threadIdx.x), wid = __builtin_amdgcn_readfirstlane(tid >> 6), lane = tid & 63, wr = wid >> 2, wc = wid & 3, fr = lane & 15, fq = lane >> 4;
    const int ntF = g.K / BK; constexpr int ntS = KSL / BK; constexpr size_t ksbytes = (size_t)KSL * 2;
    unsigned voffA[2], voffB[2];
#pragma unroll
    for (int i = 0; i < 2; ++i) { int R, C; stage_rc(tid * 16 + i * 8192, R, C); const int Rb = (R & ~31) + perm32(R & 31);
        voffA[i] = (unsigned)(R * g.lda + C) * 2u; voffB[i] = (unsigned)(Rb * g.ldb + C) * 2u; }
    const size_t kstep = (size_t)(BK * 2);
    const size_t hstepA = (size_t)HALF * g.lda * 2, hstepB = (size_t)HALF * g.ldb * 2;
    const size_t tstepA = 2 * hstepA, tstepB = 2 * hstepB;
    const unsigned ldsw = (unsigned)wid * 1024u;
    const int aoff = lds_byte(wr * 64 + fr, fq * 8), boff = lds_byte(wc * 32 + fr, fq * 8);
#define PG8_SA(b, h) (((b) * 2 + (h)) * HTB)
#define PG8_SB(b, h) ((4 + (b) * 2 + (h)) * HTB)
#define PG8_STAGE(bufoff, gbase, voff) do { _Pragma("unroll") for (int _i = 0; _i < 2; ++_i) \
        __builtin_amdgcn_global_load_lds((const unsigned*)((const char*)(gbase) + (voff)[_i]), (LAS unsigned*)(lds + (bufoff) + ldsw + _i * 8192), 16, 0, 0); } while (0)
#define PG8_LDA(dst, b, h) do { _Pragma("unroll") for (int m = 0; m < 4; ++m) _Pragma("unroll") for (int k = 0; k < 2; ++k) dst[m][k] = *(const LAS bf16x8*)(lds + PG8_SA(b, h) + aoff + m * 2048 + k * 1024); } while (0)
#define PG8_LDB(dst, b, h) do { _Pragma("unroll") for (int n = 0; n < 2; ++n) _Pragma("unroll") for (int k = 0; k < 2; ++k) dst[n][k] = *(const LAS bf16x8*)(lds + PG8_SB(b, h) + boff + n * 2048 + k * 1024); } while (0)
#define PG8_MMA(ai, bj, At, Bt) do { __builtin_amdgcn_s_setprio(1); _Pragma("unroll") for (int m = 0; m < 4; ++m) _Pragma("unroll") for (int n = 0; n < 2; ++n) _Pragma("unroll") for (int k = 0; k < 2; ++k) \
        acc[ai][bj][m][n] = __builtin_amdgcn_mfma_f32_16x16x32_bf16(Bt[n][k], At[m][k], acc[ai][bj][m][n], 0, 0, 0); __builtin_amdgcn_s_setprio(0); } while (0)
#define PG8_WAIT_V(n) asm volatile("s_waitcnt vmcnt(" #n ")" ::: "memory")
#define PG8_WAIT_L(n) asm volatile("s_waitcnt lgkmcnt(" #n ")" ::: "memory")
#define PG8_BAR __builtin_amdgcn_s_barrier()
#define PG8_SCHED __builtin_amdgcn_sched_barrier(0)
    Unit cur, nxt; int ui = 0;
    if (!S.next(0, cur)) return;
    float pre[8];
#pragma unroll
    for (int e = 0; e < 8; ++e) pre[e] = 0.f;
    f32x4 acc[2][2][4][2];
#pragma unroll
    for (int a = 0; a < 2; ++a)
#pragma unroll
        for (int b = 0; b < 2; ++b)
#pragma unroll
            for (int m = 0; m < 4; ++m)
#pragma unroll
                for (int n = 0; n < 2; ++n) acc[a][b][m][n] = (f32x4){0.f, 0.f, 0.f, 0.f};
    bf16x8 At[4][2], B0[2][2], B1[2][2];
    const char* cA = (const char*)g.A + (size_t)cur.pm * tstepA + (cur.split ? cur.ks * ksbytes : 0); const char* cB = (const char*)g.Bt + (size_t)cur.pn * tstepB + (cur.split ? cur.ks * ksbytes : 0);
    PG8_STAGE(PG8_SB(0, 0), cB, voffB); PG8_STAGE(PG8_SB(0, 1), cB + hstepB, voffB); PG8_STAGE(PG8_SA(0, 0), cA, voffA); PG8_STAGE(PG8_SA(0, 1), cA + hstepA, voffA);
    if (wr == 1) PG8_BAR;
    PG8_WAIT_V(2); PG8_BAR;
    PG8_STAGE(PG8_SB(1, 0), cB + kstep, voffB); PG8_STAGE(PG8_SA(1, 0), cA + kstep, voffA); PG8_STAGE(PG8_SB(1, 1), cB + hstepB + kstep, voffB);
    PG8_WAIT_V(6); PG8_BAR;
    for (;;) {
        const bool has_next = S.next(ui + 1, nxt);
        const char* nA = has_next ? (const char*)g.A + (size_t)nxt.pm * tstepA + (nxt.split ? nxt.ks * ksbytes : 0) : cA; const char* nB = has_next ? (const char*)g.Bt + (size_t)nxt.pn * tstepB + (nxt.split ? nxt.ks * ksbytes : 0) : cB;
        const int nt = cur.split ? ntS : ntF;
        if (SOFT_IDX >= 0 && has_next && nxt.split && !cur.split) {
            if (tid == 0) { unsigned* sw = (unsigned*)(kws() + WS_BAR) + 64 + SOFT_IDX; unsigned sp = 0;
                while (__hip_atomic_load(sw, __ATOMIC_RELAXED, __HIP_MEMORY_SCOPE_AGENT) < (unsigned)gridDim.x) { __builtin_amdgcn_s_sleep(2); if (++sp > (1u << 22)) break; }
                __builtin_amdgcn_fence(__ATOMIC_ACQUIRE, "agent"); }
            PG8_BAR; }
        for (int t = 0; t < nt; t += 2) {
            const bool last = (t == nt - 2);
            if (MID_T >= 0 && t == MID_T && !cur.split) { PG8_SCHED; E.mid(acc, cur, wr, wc, fr, fq); PG8_SCHED; }
            if (last && !cur.split) E.prefetch(pre, cur, wr, fr);
            const char* a1 = cA + (size_t)(t + 1) * kstep;
            const char* a2 = last ? nA : cA + (size_t)(t + 2) * kstep; const char* b2 = last ? nB : cB + (size_t)(t + 2) * kstep;
            const char* a3 = a2 + kstep; const char* b3 = b2 + kstep;
            PG8_LDB(B0, 0, 0); PG8_LDB(B1, 0, 1); PG8_SCHED; PG8_LDA(At, 0, 0); PG8_STAGE(PG8_SA(1, 1), a1 + hstepA, voffA);
            PG8_WAIT_V(8); PG8_WAIT_L(0); PG8_BAR; PG8_MMA(0, 0, At, B0); PG8_MMA(0, 1, At, B1); PG8_BAR; PG8_SCHED;
            PG8_LDA(At, 0, 1); PG8_STAGE(PG8_SB(0, 0), b2, voffB); PG8_STAGE(PG8_SB(0, 1), b2 + hstepB, voffB); PG8_STAGE(PG8_SA(0, 0), a2, voffA);
            PG8_WAIT_V(8); PG8_WAIT_L(0); PG8_BAR; PG8_MMA(1, 0, At, B0); PG8_MMA(1, 1, At, B1); PG8_BAR; PG8_SCHED;
            PG8_LDB(B0, 1, 0); PG8_LDB(B1, 1, 1); PG8_SCHED; PG8_LDA(At, 1, 0); PG8_STAGE(PG8_SA(0, 1), a2 + hstepA, voffA);
            PG8_WAIT_V(8); PG8_WAIT_L(0); PG8_BAR; PG8_MMA(0, 0, At, B0); PG8_MMA(0, 1, At, B1); PG8_BAR; PG8_SCHED;
            PG8_LDA(At, 1, 1); PG8_STAGE(PG8_SB(1, 0), b3, voffB); PG8_STAGE(PG8_SB(1, 1), b3 + hstepB, voffB); PG8_STAGE(PG8_SA(1, 0), a3, voffA);
            PG8_WAIT_V(8); PG8_WAIT_L(0); PG8_BAR; PG8_MMA(1, 0, At, B0); PG8_MMA(1, 1, At, B1); PG8_BAR; PG8_SCHED;
        }
        if (wr == 0) PG8_BAR;
        if (cur.split) {
            float* pp = (float*)(kws() + PART_OFF) + ((size_t)cur.ks * 512 + (cur.pm - S.nM) * 256 + wr * 64 + fr) * g.N + cur.pn * 256 + wc * 32 + 8 * fq;
#pragma unroll
            for (int a = 0; a < 2; ++a)
#pragma unroll
                for (int m = 0; m < 4; ++m)
#pragma unroll
                    for (int b = 0; b < 2; ++b) { float* q = pp + (size_t)(a * 128 + m * 16) * g.N + b * 128; *(f32x4*)q = acc[a][b][m][0]; *(f32x4*)(q + 4) = acc[a][b][m][1]; }
        } else E(acc, cur, wr, wc, fr, fq, 0, 8, pre);
        if (!has_next) break;
#pragma unroll
        for (int a = 0; a < 2; ++a)
#pragma unroll
            for (int b = 0; b < 2; ++b)
#pragma unroll
                for (int m = 0; m < 4; ++m)
#pragma unroll
                    for (int n = 0; n < 2; ++n) acc[a][b][m][n] = (f32x4){0.f, 0.f, 0.f, 0.f};
        cur = nxt; cA = nA; cB = nB; ++ui;
        if (wr == 1) PG8_BAR;
    }
    PG8_WAIT_V(0);
    PG8_BAR;
#undef PG8_SA
#undef PG8_SB
#undef PG8_STAGE
#undef PG8_LDA
#undef PG8_LDB
#undef PG8_MMA
#undef PG8_WAIT_V
#undef PG8_WAIT_L
#undef PG8_BAR
#undef PG8_SCHED
}
}
typedef f32x4 AccT[2][2][4][2];
#define EPI_LOOP_ROWS for (int ai = 0; ai < 2; ++ai) _Pragma("unroll") for (int m = 0; m < 4; ++m) if (ai * 4 + m < ghi)
#define EPI_ROW (u.pm * 256 + ((ai * 4 + m + glo) >> 2) * 128 + wr * 64 + ((ai * 4 + m + glo) & 3) * 16 + fr)

struct EpiIn {
    static constexpr bool PERM = true;
    bf16_t* U; float* DT; const float* rstd; const float* dtb;
    __device__ __forceinline__ void mid(AccT&, const pg8::Unit&, int, int, int, int) const {}
    __device__ __forceinline__ void prefetch(float (&pre)[8], const pg8::Unit& u, int wr, int fr) const {
#pragma unroll
        for (int e = 0; e < 8; ++e) pre[e] = rstd[u.pm * 256 + (e >> 2) * 128 + wr * 64 + (e & 3) * 16 + fr]; }
    __device__ __forceinline__ void operator()(const AccT& acc, const pg8::Unit& u, int wr, int wc, int fr, int fq, int glo, int ghi, const float (&pre)[8]) const {
#pragma unroll
        EPI_LOOP_ROWS {
            const int row = EPI_ROW; const float rs = pre[ai * 4 + m]; bf16_t* rowp = U + (size_t)row * INW;
#pragma unroll
            for (int bj = 0; bj < 2; ++bj) { const int col0 = u.pn * 256 + bj * 128 + wc * 32 + 8 * fq;
                if (col0 < INW) { const f32x4 v0 = acc[ai][bj][m][0] * rs, v1 = acc[ai][bj][m][1] * rs;
                    u32x4 w; w.x = cvt_pk_bf16(v0[0], v0[1]); w.y = cvt_pk_bf16(v0[2], v0[3]); w.z = cvt_pk_bf16(v1[0], v1[1]); w.w = cvt_pk_bf16(v1[2], v1[3]);
                    *(u32x4*)(rowp + col0) = w;
                    if (col0 >= ODT && col0 < ODT + 16) { const int d0 = col0 - ODT; float* dp = DT + (size_t)row * 16 + d0;
#pragma unroll
                        for (int i = 0; i < 4; ++i) { float x = v0[i] + dtb[d0 + i]; dp[i] = x > 20.f ? x : log1pf(__expf(x)); x = v1[i] + dtb[d0 + 4 + i]; dp[4 + i] = x > 20.f ? x : log1pf(__expf(x)); } } } }
        }
    }
};
struct EpiGate2 {
    static constexpr bool PERM = true;
    const bf16_t* U; bf16_t* MG;
    __device__ __forceinline__ void prefetch(float (&)[8], const pg8::Unit&, int, int) const {}
    __device__ __forceinline__ void mid(AccT& acc, const pg8::Unit& u, int wr, int wc, int fr_, int fq) const {
        const int fr = opaque(fr_);
#pragma unroll
        for (int ai = 0; ai < 2; ++ai)
#pragma unroll
            for (int m = 0; m < 4; ++m) { const int row = u.pm * 256 + ai * 128 + wr * 64 + m * 16 + fr; const bf16_t* gp = U + (size_t)row * INW;
#pragma unroll
                for (int bj = 0; bj < 2; ++bj) { const int col0 = u.pn * 256 + bj * 128 + wc * 32 + 8 * fq;
                    const u32x4 ga = *(const u32x4*)(gp + OGA + col0), gb = *(const u32x4*)(gp + OGB + col0);
                    float r[8];
                    r[0] = (1.f + __expf(-bflo(gb.x))) * __builtin_amdgcn_rcpf(1.f + __expf(-bflo(ga.x))); r[1] = (1.f + __expf(-bfhi(gb.x))) * __builtin_amdgcn_rcpf(1.f + __expf(-bfhi(ga.x)));
                    r[2] = (1.f + __expf(-bflo(gb.y))) * __builtin_amdgcn_rcpf(1.f + __expf(-bflo(ga.y))); r[3] = (1.f + __expf(-bfhi(gb.y))) * __builtin_amdgcn_rcpf(1.f + __expf(-bfhi(ga.y)));
                    r[4] = (1.f + __expf(-bflo(gb.z))) * __builtin_amdgcn_rcpf(1.f + __expf(-bflo(ga.z))); r[5] = (1.f + __expf(-bfhi(gb.z))) * __builtin_amdgcn_rcpf(1.f + __expf(-bfhi(ga.z)));
                    r[6] = (1.f + __expf(-bflo(gb.w))) * __builtin_amdgcn_rcpf(1.f + __expf(-bflo(ga.w))); r[7] = (1.f + __expf(-bfhi(gb.w))) * __builtin_amdgcn_rcpf(1.f + __expf(-bfhi(ga.w)));
                    f32x4 a0 = acc[ai][bj][m][0], a1 = acc[ai][bj][m][1];
                    a0[0] *= r[0]; a0[1] *= r[1]; a0[2] *= r[2]; a0[3] *= r[3]; a1[0] *= r[4]; a1[1] *= r[5]; a1[2] *= r[6]; a1[3] *= r[7];
                    acc[ai][bj][m][0] = a0; acc[ai][bj][m][1] = a1; }
                __builtin_amdgcn_sched_barrier(0); }
    }
    __device__ __forceinline__ void operator()(const AccT& acc, const pg8::Unit& u, int wr, int wc, int fr, int fq, int glo, int ghi, const float (&pre)[8]) const {
#pragma unroll
        EPI_LOOP_ROWS {
            const int row = EPI_ROW; const bf16_t* gp = U + (size_t)row * INW + OGB; bf16_t* op = MG + (size_t)row * DM;
#pragma unroll
            for (int bj = 0; bj < 2; ++bj) { const int col0 = u.pn * 256 + bj * 128 + wc * 32 + 8 * fq;
                const u32x4 gv = *(const u32x4*)(gp + col0); const f32x4 a0 = acc[ai][bj][m][0], a1 = acc[ai][bj][m][1];
                float r[8];
                r[0] = sigmoidf_(bflo(gv.x)) * a0[0]; r[1] = sigmoidf_(bfhi(gv.x)) * a0[1]; r[2] = sigmoidf_(bflo(gv.y)) * a0[2]; r[3] = sigmoidf_(bfhi(gv.y)) * a0[3];
                r[4] = sigmoidf_(bflo(gv.z)) * a1[0]; r[5] = sigmoidf_(bfhi(gv.z)) * a1[1]; r[6] = sigmoidf_(bflo(gv.w)) * a1[2]; r[7] = sigmoidf_(bfhi(gv.w)) * a1[3];
                u32x4 w; w.x = cvt_pk_bf16(r[0], r[1]); w.y = cvt_pk_bf16(r[2], r[3]); w.z = cvt_pk_bf16(r[4], r[5]); w.w = cvt_pk_bf16(r[6], r[7]);
                *(u32x4*)(op + col0) = w; }
        }
    }
};
template <int FIRST> struct EpiRes {
    static constexpr bool PERM = true;
    __device__ __forceinline__ void mid(AccT&, const pg8::Unit&, int, int, int, int) const {}
    __device__ __forceinline__ void prefetch(float (&)[8], const pg8::Unit&, int, int) const {}
    const float* base_p; bf16_t* XB; float* ssq;
    __device__ __forceinline__ void operator()(const AccT& acc, const pg8::Unit& u, int wr, int wc, int fr, int fq, int glo, int ghi, const float (&pre)[8]) const {
#pragma unroll
        EPI_LOOP_ROWS {
            const int row = EPI_ROW; bf16_t* xb = XB + (size_t)row * DM; float ss = 0.f;
#pragma unroll
            for (int bj = 0; bj < 2; ++bj) { const int col0 = u.pn * 256 + bj * 128 + wc * 32 + 8 * fq;
                f32x4 b0, b1;
                if (FIRST) { const float* bp = base_p + (size_t)row * DM + col0; b0 = __builtin_nontemporal_load((const f32x4*)bp); b1 = __builtin_nontemporal_load((const f32x4*)(bp + 4)); }
                else { const u32x4 pv = *(const u32x4*)(xb + col0); b0 = (f32x4){bflo(pv.x), bfhi(pv.x), bflo(pv.y), bfhi(pv.y)}; b1 = (f32x4){bflo(pv.z), bfhi(pv.z), bflo(pv.w), bfhi(pv.w)}; }
                const f32x4 v0 = b0 + acc[ai][bj][m][0], v1 = b1 + acc[ai][bj][m][1];
                if (FIRST) ss += (v0[0] * v0[0] + v0[1] * v0[1]) + (v0[2] * v0[2] + v0[3] * v0[3]) + (v1[0] * v1[0] + v1[1] * v1[1]) + (v1[2] * v1[2] + v1[3] * v1[3]);
                u32x4 w; w.x = cvt_pk_bf16(v0[0], v0[1]); w.y = cvt_pk_bf16(v0[2], v0[3]); w.z = cvt_pk_bf16(v1[0], v1[1]); w.w = cvt_pk_bf16(v1[2], v1[3]);
                *(u32x4*)(xb + col0) = w; }
            if (FIRST) { ss += __shfl_xor(ss, 16); ss += __shfl_xor(ss, 32); if (fq == 0) atomicAdd(ssq + row, ss); }
        }
    }
};
struct EpiUp {
    static constexpr bool PERM = true;
    const float* ssq2; bf16_t* ACT;
    __device__ __forceinline__ void mid(AccT&, const pg8::Unit&, int, int, int, int) const {}
    __device__ __forceinline__ void prefetch(float (&pre)[8], const pg8::Unit& u, int wr, int fr) const {
#pragma unroll
        for (int e = 0; e < 8; ++e) pre[e] = ssq2[u.pm * 256 + (e >> 2) * 128 + wr * 64 + (e & 3) * 16 + fr]; }
    __device__ __forceinline__ void operator()(const AccT& acc, const pg8::Unit& u, int wr, int wc, int fr, int fq, int glo, int ghi, const float (&pre)[8]) const {
#pragma unroll
        EPI_LOOP_ROWS {
            const int row = EPI_ROW; const float rs = rsqrtf(pre[ai * 4 + m] * (1.f / DM) + EPS); bf16_t* op = ACT + (size_t)row * DFF;
#pragma unroll
            for (int bj = 0; bj < 2; ++bj) { const int col0 = u.pn * 256 + bj * 128 + wc * 32 + 8 * fq;
                f32x4 v0 = acc[ai][bj][m][0] * rs, v1 = acc[ai][bj][m][1] * rs;
#pragma unroll
                for (int i = 0; i < 4; ++i) { const float a = fmaxf(v0[i], 0.f), b = fmaxf(v1[i], 0.f); v0[i] = a * a; v1[i] = b * b; }
                u32x4 w; w.x = cvt_pk_bf16(v0[0], v0[1]); w.y = cvt_pk_bf16(v0[2], v0[3]); w.z = cvt_pk_bf16(v1[0], v1[1]); w.w = cvt_pk_bf16(v1[2], v1[3]);
                *(u32x4*)(op + col0) = w; }
        }
    }
};

__device__ __forceinline__ void transpose_item(const float* W, int K, int N, const float* scale, bf16_t* WT, int ldw, int kdst0, LAS float* scr, int kb, int nsrc0, int ndst0, int lane) {
    const int k0 = 64 * kb;
    const int n = nsrc0 + (lane & 15) * 4, kr = lane >> 4;
    f32x4 v[16];
#pragma unroll
    for (int i = 0; i < 16; ++i) { v[i] = (f32x4){0.f, 0.f, 0.f, 0.f}; if (n < N) v[i] = __builtin_nontemporal_load((const f32x4*)(W + (size_t)(k0 + 4 * i + kr) * N + n)); }
#pragma unroll
    for (int i = 0; i < 16; ++i) { const int kk = 4 * i + kr; const float sc = scale ? scale[k0 + kk] : 1.f; LAS float* p = scr + kk * 65 + (lane & 15) * 4;
        p[0] = v[i][0] * sc; p[1] = v[i][1] * sc; p[2] = v[i][2] * sc; p[3] = v[i][3] * sc; }
    LDS_WAIT();
    const int c = lane & 7;
#pragma unroll
    for (int j = 0; j < 8; ++j) { const int nn = (lane >> 3) + 8 * j; const LAS float* sp = scr + (8 * c) * 65 + nn;
        u32x4 o; o.x = pk2(sp[0 * 65], sp[1 * 65]); o.y = pk2(sp[2 * 65], sp[3 * 65]); o.z = pk2(sp[4 * 65], sp[5 * 65]); o.w = pk2(sp[6 * 65], sp[7 * 65]);
        *(u32x4*)(WT + (size_t)(ndst0 + nn) * ldw + kdst0 + k0 + 8 * c) = o; }
    LDS_WAIT();
}

constexpr int KS_LD = 72;
__device__ __forceinline__ void attn_tile(const LAS bf16_t* Ks, const LAS bf16_t* Vt, bf16_t* qptr, const bf16x8 qf0, const bf16x8 qf1, int kt0, int rq, int kmin, float sink, int lane) {
    const int c16 = lane & 15, quad = lane >> 4;
    bf16x8 qf[2]; qf[0] = qf0; qf[1] = qf1;
    f32x4 s[10]; s[9] = (f32x4){0.f, 0.f, 0.f, 0.f};
#pragma unroll
    for (int j = 0; j < 9; ++j) { s[j] = (f32x4){0.f, 0.f, 0.f, 0.f};
#pragma unroll
        for (int ks = 0; ks < 2; ++ks) { const bf16x8 kf = *(const LAS bf16x8*)(Ks + ((kt0 + j) * 16 + c16) * KS_LD + ks * 32 + quad * 8); s[j] = MFMA16(kf, qf[ks], s[j]); } }
    float mx = sink;
#pragma unroll
    for (int j = 0; j < 9; ++j)
#pragma unroll
        for (int jj = 0; jj < 4; ++jj) { const int kidx = (kt0 + j) * 16 + quad * 4 + jj; const bool ok = (kidx >= rq) && (kidx <= rq + 128) && (kidx >= kmin);
            const float v = ok ? s[j][jj] * 0.125f : -INFINITY; s[j][jj] = v; mx = fmaxf(mx, v); }
    mx = fmaxf(mx, __shfl_xor(mx, 16)); mx = fmaxf(mx, __shfl_xor(mx, 32));
    float sum = 0.f;
#pragma unroll
    for (int j = 0; j < 9; ++j)
#pragma unroll
        for (int jj = 0; jj < 4; ++jj) { const float p = __expf(s[j][jj] - mx); s[j][jj] = p; sum += p; }
    sum += __shfl_xor(sum, 16); sum += __shfl_xor(sum, 32); sum += __expf(sink - mx);
    const float inv = 1.f / sum;
    f32x4 o[4];
#pragma unroll
    for (int dt = 0; dt < 4; ++dt) o[dt] = (f32x4){0.f, 0.f, 0.f, 0.f};
    const unsigned vaddr = LDSADDR(Vt) + (unsigned)(((kt0 * 16 + quad * 4 + (c16 >> 2)) * KS_LD + 4 * (c16 & 3)) * 2);
#pragma unroll
    for (int st = 0; st < 5; ++st) {
        u32x4 pw; pw.x = pk2(s[2 * st][0] * inv, s[2 * st][1] * inv); pw.y = pk2(s[2 * st][2] * inv, s[2 * st][3] * inv);
        pw.z = pk2(s[2 * st + 1][0] * inv, s[2 * st + 1][1] * inv); pw.w = pk2(s[2 * st + 1][2] * inv, s[2 * st + 1][3] * inv);
        const bf16x8 pf = __builtin_bit_cast(bf16x8, pw);
        bf16x8 vf[4]; tr_frag4<0, 32, 64, 96, 16 * KS_LD * 2>(vaddr + st * (32 * KS_LD * 2), vf);
#pragma unroll
        for (int dt = 0; dt < 4; ++dt) o[dt] = MFMA16(vf[dt], pf, o[dt]);
    }
#pragma unroll
    for (int dt = 0; dt < 4; ++dt) { u32x2 w; w.x = pk2(o[dt][0], o[dt][1]); w.y = pk2(o[dt][2], o[dt][3]); *(u32x2*)(qptr + dt * 16 + quad * 4) = w; }
}

#define XB_TMO      128
#define XB_XCNT(j)  (256  + 64 * (j))
#define XB_XSUB(j)  (1280 + 64 * (j))
#define XB_XGEN(j)  (2304 + 64 * (j))
#define XB_TOP      3328
#define XB_TOPGEN   3392
#define XCD_BAR_WORDS 3456
#define XB_SPIN_CAP (1u << 18)
__device__ __forceinline__ unsigned xb_ld(unsigned* p)              { return __hip_atomic_load(p, __ATOMIC_RELAXED, __HIP_MEMORY_SCOPE_AGENT); }
__device__ __forceinline__ unsigned xb_add(unsigned* p, unsigned v) { return __hip_atomic_fetch_add(p, v, __ATOMIC_RELAXED, __HIP_MEMORY_SCOPE_AGENT); }
__device__ __forceinline__ unsigned xb_xcc_id() { return (unsigned)__builtin_amdgcn_s_getreg((3 << 11) | 20) & 0xFu; }
#define XB_SPIN(cond, bar) do { unsigned _sp = 0; while (cond) { __builtin_amdgcn_s_sleep(1); \
    if ((++_sp & 255u) == 0u) { if (xb_ld(&(bar)[XB_TMO])) break; if (_sp > XB_SPIN_CAP) { atomicAdd(&(bar)[XB_TMO], 1u); break; } } } } while (0)
__device__ __forceinline__ void xcd_barrier_complete(unsigned* bar, unsigned x, unsigned& nloc, unsigned& nx) {
    const unsigned Gt = gridDim.x;
    unsigned sum, cnt, mine, sp = 0u;
    for (;;) {
        sum = 0u; cnt = 0u; mine = 0u;
#pragma unroll
        for (unsigned j = 0; j < 16; ++j) { const unsigned c = xb_ld(&bar[XB_XCNT(j)]); sum += c; cnt += (c > 0u) ? 1u : 0u; mine = (j == x) ? c : mine; }
        if (sum == Gt) break;
        __builtin_amdgcn_s_sleep(1);
        if ((++sp & 255u) == 0u) { if (xb_ld(&bar[XB_TMO])) break; if (sp > XB_SPIN_CAP) { atomicAdd(&bar[XB_TMO], 1u); break; } }
    }
    nloc = mine > 0u ? mine : 1u; nx = cnt > 0u ? cnt : 1u;
}
__device__ __forceinline__ void xcd_barrier(unsigned* bar, unsigned x, volatile LAS unsigned* st, int tid0) {
    asm volatile("s_waitcnt vmcnt(0) lgkmcnt(0)" ::: "memory");
    __syncthreads();
    if (tid0 == 0) {
        __builtin_amdgcn_s_waitcnt(0);
        unsigned nloc = st[0], nx = st[1];
        if (nloc == 0u) { xcd_barrier_complete(bar, x, nloc, nx); st[0] = nloc; st[1] = nx; }
        const unsigned old = xb_add(&bar[XB_XSUB(x)], 1u);
        const unsigned gen = old / nloc;
        if (old + 1u == (gen + 1u) * nloc) {
            __builtin_amdgcn_fence(__ATOMIC_RELEASE, "agent");
            asm volatile("s_waitcnt vmcnt(0)" ::: "memory");
            const unsigned og = xb_add(&bar[XB_TOP], 1u);
            const unsigned tg = og / nx;
            if (og + 1u == (tg + 1u) * nx) xb_add(&bar[XB_TOPGEN], 1u);
            else XB_SPIN(xb_ld(&bar[XB_TOPGEN]) == tg, bar);
            __builtin_amdgcn_fence(__ATOMIC_ACQUIRE, "agent");
            xb_add(&bar[XB_XGEN(x)], 1u);
            asm volatile("s_waitcnt vmcnt(0)" ::: "memory");
        } else {
            XB_SPIN(xb_ld(&bar[XB_XGEN(x)]) == gen, bar);
            __builtin_amdgcn_fence(__ATOMIC_ACQUIRE, "agent");
            asm volatile("s_waitcnt vmcnt(0)" ::: "memory");
        }
    }
    __syncthreads();
}
struct Args { const float* in[22]; float* out; unsigned char* ws; int ph_lo, ph_hi; };

__global__ void __launch_bounds__(512, 2) mega(Args a) {
    extern __shared__ __attribute__((aligned(16))) unsigned char lds_raw[];
    LAS unsigned char* lds = (LAS unsigned char*)lds_raw;
    cg::grid_group grid = cg::this_grid();
    const int tid0 = threadIdx.x, w = __builtin_amdgcn_readfirstlane(tid0 >> 6), G = gridDim.x, bx = blockIdx.x;
    const int gw = bx * 8 + w, NGW = G * 8, NGT = G * 512;
#define LOCAL_IDS const int tid = opaque(tid0), lane = tid & 63, c16 = lane & 15, quad = lane >> 4; (void)c16; (void)quad; (void)lane;
    unsigned char* ws = a.ws; float* out = a.out;
    float* RSTD1 = (float*)(ws + WS_RSTD1); float* SSQ2 = (float*)(ws + WS_SSQ2); float* SSQF = (float*)(ws + WS_SSQF); float* CD = (float*)(ws + WS_CD);
    bf16_t* WIN = (bf16_t*)(ws + WS_WIN); bf16_t* WOA = (bf16_t*)(ws + WS_WOA); bf16_t* WOB = (bf16_t*)(ws + WS_WOB); bf16_t* WO = (bf16_t*)(ws + WS_WO);
    bf16_t* WUP = (bf16_t*)((unsigned char*)out + 40 * MiB); bf16_t* WDN = (bf16_t*)((unsigned char*)out + 48 * MiB);
    float* DT = (float*)(ws + WS_DT); bf16_t* U = (bf16_t*)(ws + WS_U); bf16_t* XC = (bf16_t*)(ws + WS_XC);
    bf16_t* MERGED = (bf16_t*)(ws + WS_MERGED); bf16_t* X1B = (bf16_t*)(ws + WS_X1B); bf16_t* ACT = (bf16_t*)(ws + WS_ACT);
    bf16_t* XB = (bf16_t*)(out + O_SS);
    bf16_t* STB = (bf16_t*)(out + O_YP);
    float* X1 = out + O_YP;
    const int lo = a.ph_lo, hi = a.ph_hi;
#ifndef PHMASK
#define PHMASK 0x7ff
#endif
#define IN(k) (((PHMASK >> (k)) & 1) && lo <= (k) && (k) < hi)
    unsigned* BARW = (unsigned*)(ws + WS_BAR);
    if (lo < 0) grid.sync();
#ifdef PROBE_A
    unsigned tstamp[12];
#define STAMP(i) tstamp[i] = (unsigned)__builtin_amdgcn_s_memrealtime()
    STAMP(0);
#else
#define STAMP(i)
#endif
    unsigned* XBW = (unsigned*)(ws + WS_XB); volatile LAS unsigned* xst = (volatile LAS unsigned*)(lds + LDS_BYTES - 64);
    const unsigned xcc = xb_xcc_id();
    if (tid0 < 2) xst[tid0] = 0u;
    if (tid0 == 0) (void)xb_add(&XBW[XB_XCNT(xcc)], 1u);
    __syncthreads();
#define SEAM(k) do { if (IN(k) && IN((k) + 1)) xcd_barrier(XBW, xcc, xst, tid0); } while (0)
#define SOFT_ARRIVE(k) do { asm volatile("s_waitcnt vmcnt(0) lgkmcnt(0)" ::: "memory"); __syncthreads(); \
        if (tid0 == 0) { __hip_atomic_fetch_add(BARW + 64 + (k), 1u, __ATOMIC_RELAXED, __HIP_MEMORY_SCOPE_AGENT); } } while (0)
    if (IN(0)) {
        const float* x_p = kin(0); const float* x_s = kin(1); const float* norm1 = kin(6); const float* w_in = kin(7); const float* ssm_norm = kin(14); const float* w_oa = kin(15); const float* w_ob = kin(16); const float* w_o = kin(17);
        LOCAL_IDS const int gtid = bx * 512 + tid;
        LAS float* scr = (LAS float*)(lds + w * 16640);
        constexpr int I_IN = 16 * 88, I_OA = 8 * 16, I_OB = 16 * 16, I_O = 16 * 16;
        for (int it = gw; it < I_IN + I_OA + I_OB + I_O; it += NGW) {
            int r = it;
            if (r < I_IN) { const int kb = r / 88, nd = 64 * (r % 88); const int ns = nd < 512 ? nd : (nd < 1536 ? nd + 256 : (nd < 1792 ? nd - 1024 : nd));
                transpose_item(w_in, DM, INW, norm1, WIN, DM, 0, scr, kb, ns, nd, lane); continue; } r -= I_IN;
            if (r < I_OA) { transpose_item(w_oa, 512, DM, nullptr, WOA, 1536, 0, scr, r / 16, 64 * (r % 16), 64 * (r % 16), lane); continue; } r -= I_OA;
            if (r < I_OB) { transpose_item(w_ob, DM, DM, ssm_norm, WOA, 1536, 512, scr, r / 16, 64 * (r % 16), 64 * (r % 16), lane); continue; } r -= I_OB;
            transpose_item(w_o, DM, DM, nullptr, WO, DM, 0, scr, r / 16, 64 * (r % 16), 64 * (r % 16), lane);
        }
#pragma unroll 2
        for (int m = gw; m < M; m += NGW) {
            const float* xr = m < MP ? x_p + (size_t)m * DM : x_s + (size_t)(m - MP) * DM;
            f32x4 v[4]; float ss = 0.f;
#pragma unroll
            for (int j = 0; j < 4; ++j) { v[j] = __builtin_nontemporal_load((const f32x4*)(xr + lane * 4 + 256 * j)); ss += (v[j][0] * v[j][0] + v[j][1] * v[j][1]) + (v[j][2] * v[j][2] + v[j][3] * v[j][3]); }
            ss = wave_sum(ss);
            if (lane == 0) RSTD1[m] = rsqrtf(ss * (1.f / DM) + EPS);
#pragma unroll
            for (int j = 0; j < 4; ++j) { u32x2 o; o.x = pk2(v[j][0], v[j][1]); o.y = pk2(v[j][2], v[j][3]); *(u32x2*)(XB + (size_t)m * DM + lane * 4 + 256 * j) = o; }
        }
        for (int i = gtid; i < M; i += NGT) { SSQ2[i] = 0.f; SSQF[i] = 0.f; }
    }
    SEAM(0); STAMP(1);
    if (IN(1)) {
        const float* dt_bias = kin(11);
        pg8::Gemm g{XB, WIN, M, NPAD, DM, DM, DM}; pg8::StaticOrder S; S.init(M, NPAD, G, bx);
        EpiIn E{U, DT, RSTD1, dt_bias};
        pg8::gemm_phase<EpiIn>(lds, g, S, E);
        {
            constexpr int NT1 = (M / 256) * (NPAD / 256); const int full = NT1 / G, rem = NT1 - full * G;
            if (bx >= rem && rem > 0) { LOCAL_IDS const float* norm2 = kin(18); const float* w_up = kin(19); const float* w_down = kin(20);
                LAS float* scr = (LAS float*)(lds + w * 16640); const int nidle = (G - rem) * 8;
                for (int it = (bx - rem) * 8 + w; it < 2048; it += nidle) { if (it < 1024) transpose_item(w_up, DM, DFF, norm2, WUP, DM, 0, scr, it / 64, 64 * (it % 64), 64 * (it % 64), lane); else transpose_item(w_down, DFF, DM, nullptr, WDN, DFF, 0, scr, (it - 1024) / 16, 64 * ((it - 1024) % 16), 64 * ((it - 1024) % 16), lane); } } }
    }
    SEAM(1); STAMP(2);
    if (IN(2)) {
        const float* cache_k = kin(2); const float* cache_v = kin(3); const float* state_conv = kin(4); const float* sinks = kin(8); const float* conv_w = kin(9); const float* conv_b = kin(10);
        {   LOCAL_IDS
            if (tid < 384) {
                const int cgi = tid % 192, sub = tid / 192, ch0 = cgi * 8;
                float wv[4][8], bias[8];
#pragma unroll
                for (int i = 0; i < 4; ++i) { const f32x4 t0 = *(const f32x4*)(conv_w + i * CONVD + ch0), t1 = *(const f32x4*)(conv_w + i * CONVD + ch0 + 4);
#pragma unroll
                    for (int k = 0; k < 4; ++k) { wv[i][k] = t0[k]; wv[i][4 + k] = t1[k]; } }
                { const f32x4 t0 = *(const f32x4*)(conv_b + ch0), t1 = *(const f32x4*)(conv_b + ch0 + 4);
#pragma unroll
                  for (int k = 0; k < 4; ++k) { bias[k] = t0[k]; bias[4 + k] = t1[k]; } }
#pragma unroll 1
                for (int rg = bx * 2 + sub; rg < 4096 + 128; rg += 2 * G) {
                    const bool prompt = rg < 4096; const int bs = rg - 4096;
                    const int rowbase = prompt ? rg * 4 : MP + bs * 4; const int t = rowbase & (SEQ - 1);
                    float x[7][8];
                    u32x4 r[7];
#pragma unroll
                    for (int j = 0; j < 7; ++j) r[j] = (u32x4){0u, 0u, 0u, 0u};
#pragma unroll
                    for (int j = 3; j < 7; ++j) r[j] = __builtin_nontemporal_load((const u32x4*)(U + (size_t)(rowbase + j - 3) * INW + OX + ch0));
                    if (prompt && t > 0) {
#pragma unroll
                        for (int j = 0; j < 3; ++j) r[j] = *(const u32x4*)(U + (size_t)(rowbase + j - 3) * INW + OX + ch0); }
#pragma unroll
                    for (int j = 0; j < 7; ++j) { x[j][0] = bflo(r[j].x); x[j][1] = bfhi(r[j].x); x[j][2] = bflo(r[j].y); x[j][3] = bfhi(r[j].y); x[j][4] = bflo(r[j].z); x[j][5] = bfhi(r[j].z); x[j][6] = bflo(r[j].w); x[j][7] = bfhi(r[j].w); }
                    if (!prompt) { const float* sp = state_conv + (size_t)bs * 3 * CONVD + ch0;
#pragma unroll
                        for (int j = 0; j < 3; ++j) { const f32x4 a0 = *(const f32x4*)(sp + j * CONVD), a1 = *(const f32x4*)(sp + j * CONVD + 4);
#pragma unroll
                            for (int k = 0; k < 4; ++k) { x[j][k] = a0[k]; x[j][4 + k] = a1[k]; } } }
#pragma unroll
                    for (int tt = 0; tt < 4; ++tt) { float y[8];
#pragma unroll
                        for (int k = 0; k < 8; ++k) { const float sacc = bias[k] + x[tt][k] * wv[0][k] + x[tt + 1][k] * wv[1][k] + x[tt + 2][k] * wv[2][k] + x[tt + 3][k] * wv[3][k]; y[k] = siluf_(sacc); }
                        u32x4 o; o.x = pk2(y[0], y[1]); o.y = pk2(y[2], y[3]); o.z = pk2(y[4], y[5]); o.w = pk2(y[6], y[7]);
                        *(u32x4*)(XC + (size_t)(rowbase + tt) * CONVD + ch0) = o; }
                    float* obase = nullptr;
                    if (prompt) { if (t == SEQ - 4) obase = out + O_CP + (size_t)(rowbase >> 11) * 3 * CONVD; } else obase = out + O_CS + (size_t)bs * 3 * CONVD;
                    if (obase) {
#pragma unroll
                        for (int j = 0; j < 3; ++j) { float* op = obase + (size_t)j * CONVD + ch0; *(f32x4*)op = (f32x4){x[4 + j][0], x[4 + j][1], x[4 + j][2], x[4 + j][3]}; *(f32x4*)(op + 4) = (f32x4){x[4 + j][4], x[4 + j][5], x[4 + j][6], x[4 + j][7]}; } }
                }
            }
        }
        LAS bf16_t* Ks = (LAS bf16_t*)lds; LAS bf16_t* Vt = (LAS bf16_t*)(lds + 272 * KS_LD * 2);
        LAS bf16_t* Ks2 = (LAS bf16_t*)(lds + 2 * 272 * KS_LD * 2); LAS bf16_t* Vt2 = (LAS bf16_t*)(lds + 2 * 272 * KS_LD * 2 + 160 * KS_LD * 2);
        for (int unit = bx; unit < 256; unit += G) {
            LOCAL_IDS const int b = unit >> 5, qblk = (unit >> 1) & 15, kvh = unit & 1, bs = unit >> 1, kvh2 = unit & 1;
            const int hq = kvh * 4 + (w >> 1), qh = w & 1; const float sink = sinks[hq];
            bf16x8 qf[4][2];
#pragma unroll
            for (int i = 0; i < 4; ++i) { const bf16_t* qp = U + (size_t)(b * SEQ + qblk * 128 + qh * 64 + i * 16 + c16) * INW + hq * 64; qf[i][0] = *(const bf16x8*)(qp + quad * 8); qf[i][1] = *(const bf16x8*)(qp + 32 + quad * 8); }
            const int sw = unit & 7;
            const int gq = c16 >> 2, ts = c16 & 3, hq2 = kvh2 * 4 + gq;
            bf16_t* qp2 = U + (size_t)(MP + bs * 4 + ts) * INW + hq2 * 64; bf16x8 q2a = qf[0][0], q2b = qf[0][1];
            if (w == sw) { q2a = *(const bf16x8*)(qp2 + quad * 8); q2b = *(const bf16x8*)(qp2 + 32 + quad * 8); }
            __syncthreads();
#pragma unroll
            for (int pc = tid; pc < 272 * 8; pc += 512) { const int kidx = pc >> 3, part = pc & 7; const int tok = (qblk - 1) * 128 + kidx;
                u32x4 kv = (u32x4){0u, 0u, 0u, 0u}, vv = (u32x4){0u, 0u, 0u, 0u};
                if (kidx < 256 && tok >= 0) { const bf16_t* rp = U + (size_t)(b * SEQ + tok) * INW + kvh * 64 + part * 8; kv = *(const u32x4*)(rp + OKK); vv = *(const u32x4*)(rp + OV);
                    if (qblk == 15 && kidx >= 128) { const size_t oo = ((size_t)(b * 128 + kidx - 128) * 2 + kvh) * 64 + part * 8;
                        *(f32x4*)(out + O_KP + oo) = (f32x4){bflo(kv.x), bfhi(kv.x), bflo(kv.y), bfhi(kv.y)}; *(f32x4*)(out + O_KP + oo + 4) = (f32x4){bflo(kv.z), bfhi(kv.z), bflo(kv.w), bfhi(kv.w)};
                        *(f32x4*)(out + O_VP + oo) = (f32x4){bflo(vv.x), bfhi(vv.x), bflo(vv.y), bfhi(vv.y)}; *(f32x4*)(out + O_VP + oo + 4) = (f32x4){bflo(vv.z), bfhi(vv.z), bflo(vv.w), bfhi(vv.w)}; } }
                *(LAS u32x4*)(Ks + kidx * KS_LD + part * 8) = kv; *(LAS u32x4*)(Vt + kidx * KS_LD + part * 8) = vv; }
#pragma unroll
            for (int pc = tid; pc < 160 * 8; pc += 512) { const int kidx = pc >> 3, part = pc & 7;
                float kf[8], vf[8];
#pragma unroll
                for (int i = 0; i < 8; ++i) { kf[i] = 0.f; vf[i] = 0.f; }
                if (kidx < 128) { const size_t io = ((size_t)(bs * 128 + kidx) * 2 + kvh2) * 64 + part * 8;
                    const f32x4 k0 = __builtin_nontemporal_load((const f32x4*)(cache_k + io)), k1 = __builtin_nontemporal_load((const f32x4*)(cache_k + io + 4)), v0 = __builtin_nontemporal_load((const f32x4*)(cache_v + io)), v1 = __builtin_nontemporal_load((const f32x4*)(cache_v + io + 4));
#pragma unroll
                    for (int i = 0; i < 4; ++i) { kf[i] = k0[i]; kf[4 + i] = k1[i]; vf[i] = v0[i]; vf[4 + i] = v1[i]; }
                } else if (kidx < 132) { const bf16_t* rp = U + (size_t)(MP + bs * 4 + kidx - 128) * INW + kvh2 * 64 + part * 8; const u32x4 kv = *(const u32x4*)(rp + OKK), vv = *(const u32x4*)(rp + OV);
                    kf[0] = bflo(kv.x); kf[1] = bfhi(kv.x); kf[2] = bflo(kv.y); kf[3] = bfhi(kv.y); kf[4] = bflo(kv.z); kf[5] = bfhi(kv.z); kf[6] = bflo(kv.w); kf[7] = bfhi(kv.w);
                    vf[0] = bflo(vv.x); vf[1] = bfhi(vv.x); vf[2] = bflo(vv.y); vf[3] = bfhi(vv.y); vf[4] = bflo(vv.z); vf[5] = bfhi(vv.z); vf[6] = bflo(vv.w); vf[7] = bfhi(vv.w); }
                if (kidx >= 4 && kidx < 132) { const size_t oo = ((size_t)(bs * 128 + kidx - 4) * 2 + kvh2) * 64 + part * 8;
                    __builtin_nontemporal_store((f32x4){kf[0], kf[1], kf[2], kf[3]}, (f32x4*)(out + O_KS + oo)); __builtin_nontemporal_store((f32x4){kf[4], kf[5], kf[6], kf[7]}, (f32x4*)(out + O_KS + oo + 4));
                    __builtin_nontemporal_store((f32x4){vf[0], vf[1], vf[2], vf[3]}, (f32x4*)(out + O_VS + oo)); __builtin_nontemporal_store((f32x4){vf[4], vf[5], vf[6], vf[7]}, (f32x4*)(out + O_VS + oo + 4)); }
                u32x4 kw; kw.x = pk2(kf[0], kf[1]); kw.y = pk2(kf[2], kf[3]); kw.z = pk2(kf[4], kf[5]); kw.w = pk2(kf[6], kf[7]);
                u32x4 vw; vw.x = pk2(vf[0], vf[1]); vw.y = pk2(vf[2], vf[3]); vw.z = pk2(vf[4], vf[5]); vw.w = pk2(vf[6], vf[7]);
                *(LAS u32x4*)(Ks2 + kidx * KS_LD + part * 8) = kw; *(LAS u32x4*)(Vt2 + kidx * KS_LD + part * 8) = vw; }
            __syncthreads();
#pragma unroll
            for (int i = 0; i < 4; ++i) { const int r0 = qh * 64 + i * 16;
                bf16_t* qp = U + (size_t)(b * SEQ + qblk * 128 + r0 + c16) * INW + hq * 64;
                attn_tile(Ks, Vt, qp, qf[i][0], qf[i][1], r0 >> 4, r0 + c16, qblk == 0 ? 128 : 0, sink, lane); }
            if (w == sw) attn_tile(Ks2, Vt2, qp2, q2a, q2b, 0, ts, 0, sinks[hq2], lane);
        }
    }
    SEAM(2); STAMP(3);
    if (IN(3)) {
        const float* state_ssm = kin(5); const float* a_log = kin(12); const float* d_skip = kin(13);
        for (int ord = 0; ord < 2; ++ord) {
        if (((ord ^ bx) & 1) == 0) {
            LAS bf16_t* Bt = (LAS bf16_t*)lds;
            LAS bf16_t* Xs = (LAS bf16_t*)(lds + 18432);
            LAS float* scl = (LAS float*)(lds + 18432 + 73728);
            for (int unit = bx; unit < 256; unit += G) {
                LOCAL_IDS const int b = unit >> 5, c = (unit >> 1) & 15, g = unit & 1, row0 = b * SEQ + c * 128, h = 8 * g + w;
                __syncthreads();
                { const float A = -__expf(a_log[h]);
                  const float d0 = DT[(size_t)(row0 + lane) * 16 + h], d1 = DT[(size_t)(row0 + 64 + lane) * 16 + h];
                  float v0 = d0 * A, v1 = d1 * A;
#pragma unroll
                  for (int o = 1; o < 64; o <<= 1) { const float t0 = __builtin_bit_cast(float, __builtin_amdgcn_ds_bpermute((lane - o) << 2, __builtin_bit_cast(int, v0))), t1 = __builtin_bit_cast(float, __builtin_amdgcn_ds_bpermute((lane - o) << 2, __builtin_bit_cast(int, v1))); if (lane >= o) { v0 += t0; v1 += t1; } }
                  v1 += __builtin_bit_cast(float, __builtin_amdgcn_readlane(__builtin_bit_cast(int, v0), 63)); const float last = __builtin_bit_cast(float, __builtin_amdgcn_readlane(__builtin_bit_cast(int, v1), 63));
                  scl[w * 128 + lane] = d0 * __expf(last - v0); scl[w * 128 + 64 + lane] = d1 * __expf(last - v1);
                  if (lane == 0) CD[(b * 16 + c) * 16 + h] = __expf(last); }
                f32x4 acc[8][4];
#pragma unroll
                for (int nt = 0; nt < 8; ++nt)
#pragma unroll
                    for (int pt = 0; pt < 4; ++pt) acc[nt][pt] = (f32x4){0.f, 0.f, 0.f, 0.f};
                for (int half = 0; half < 2; ++half) {
                    __syncthreads();
#pragma unroll 2
                    for (int pc = tid; pc < 1024; pc += 512) { const int lr = pc >> 4, part = pc & 15;
                        *(LAS u32x4*)(Bt + lr * 136 + part * 8) = *(const u32x4*)(XC + (size_t)(row0 + half * 64 + lr) * CONVD + 1024 + g * 128 + part * 8); }
#pragma unroll 1
                    for (int pc0 = tid; pc0 < 4096; pc0 += 2048) { u32x4 vv[4];
#pragma unroll
                        for (int k = 0; k < 4; ++k) { const int pc = pc0 + 512 * k, lr = pc >> 6, part = pc & 63; vv[k] = *(const u32x4*)(XC + (size_t)(row0 + half * 64 + lr) * CONVD + g * 512 + part * 8); }
#pragma unroll
                        for (int k = 0; k < 4; ++k) { const int pc = pc0 + 512 * k, lr = pc >> 6, part = pc & 63, hh = part >> 3; const u32x4 v = vv[k];
                            const float sc = scl[hh * 128 + half * 64 + lr];
                            u32x4 o; o.x = pk2(bflo(v.x) * sc, bfhi(v.x) * sc); o.y = pk2(bflo(v.y) * sc, bfhi(v.y) * sc); o.z = pk2(bflo(v.z) * sc, bfhi(v.z) * sc); o.w = pk2(bflo(v.w) * sc, bfhi(v.w) * sc);
                            *(LAS u32x4*)(Xs + (hh * 64 + lr) * 72 + (part & 7) * 8) = o; } }
                    __syncthreads();
                    const unsigned baddr = LDSADDR(Bt) + (unsigned)(((quad * 8 + (c16 >> 2)) * 136 + 4 * (c16 & 3)) * 2);
                    const unsigned xaddr = LDSADDR(Xs) + (unsigned)(((w * 64 + quad * 8 + (c16 >> 2)) * 72 + 4 * (c16 & 3)) * 2);
#pragma unroll
                    for (int ks = 0; ks < 2; ++ks) { bf16x8 xf[4]; tr_frag4<0, 32, 64, 96, 4 * 144>(xaddr + ks * (32 * 144), xf);
#pragma unroll
                        for (int nh = 0; nh < 2; ++nh) { bf16x8 bfr[4]; tr_frag4<0, 32, 64, 96, 4 * 272>(baddr + ks * (32 * 272) + nh * 128, bfr);
#pragma unroll
                            for (int n4 = 0; n4 < 4; ++n4)
#pragma unroll
                                for (int pt = 0; pt < 4; ++pt) acc[nh * 4 + n4][pt] = MFMA16(bfr[n4], xf[pt], acc[nh * 4 + n4][pt]); } }
                }
                bf16_t* sp = STB + ((size_t)((b * 16 + c) * 16 + h) * 64) * 128;
#pragma unroll
                for (int nt = 0; nt < 8; ++nt)
#pragma unroll
                    for (int pt = 0; pt < 4; ++pt) { u32x2 o; o.x = pk2(acc[nt][pt][0], acc[nt][pt][1]); o.y = pk2(acc[nt][pt][2], acc[nt][pt][3]); *(u32x2*)(sp + (size_t)(pt * 16 + c16) * 128 + nt * 16 + quad * 4) = o; }
            }
        }
        else {
            LAS float* xr = (LAS float*)lds;
            LAS float* xdt = (LAS float*)(lds + 8192);
            LAS float* vals = (LAS float*)(lds + 16384);
            LAS float* rs = (LAS float*)(lds + 24576);
            for (int unit = bx; unit < 256; unit += G) {
                LOCAL_IDS const int b = unit >> 1, g = unit & 1, h = 8 * g + w, R0 = MP + b * 4;
                __syncthreads();
                const float A = -__expf(a_log[h]); float dtv[4], dA[4];
#pragma unroll
                for (int t = 0; t < 4; ++t) { dtv[t] = DT[(size_t)(R0 + t) * 16 + h]; dA[t] = __expf(dtv[t] * A); }
                { const int t = quad, p0 = c16 * 4; const u32x2 v = *(const u32x2*)(XC + (size_t)(R0 + t) * CONVD + h * 64 + p0);
                  const float dtt = t == 0 ? dtv[0] : (t == 1 ? dtv[1] : (t == 2 ? dtv[2] : dtv[3]));
                  const float f0 = bflo(v.x), f1 = bfhi(v.x), f2 = bflo(v.y), f3 = bfhi(v.y);
                  LAS float* p = xr + (w * 4 + t) * 64 + p0; p[0] = f0; p[1] = f1; p[2] = f2; p[3] = f3;
                  LAS float* q = xdt + (w * 4 + t) * 64 + p0; q[0] = f0 * dtt; q[1] = f1 * dtt; q[2] = f2 * dtt; q[3] = f3 * dtt; }
                float Bv[4][8], Cv[4][8];
#pragma unroll
                for (int t = 0; t < 4; ++t) { const bf16_t* rp = XC + (size_t)(R0 + t) * CONVD + 1024 + g * 128 + c16 * 4;
                    const u32x2 b0 = *(const u32x2*)rp, b1 = *(const u32x2*)(rp + 64), c0 = *(const u32x2*)(rp + 256), c1 = *(const u32x2*)(rp + 320);
                    Bv[t][0] = bflo(b0.x); Bv[t][1] = bfhi(b0.x); Bv[t][2] = bflo(b0.y); Bv[t][3] = bfhi(b0.y); Bv[t][4] = bflo(b1.x); Bv[t][5] = bfhi(b1.x); Bv[t][6] = bflo(b1.y); Bv[t][7] = bfhi(b1.y);
                    Cv[t][0] = bflo(c0.x); Cv[t][1] = bfhi(c0.x); Cv[t][2] = bflo(c0.y); Cv[t][3] = bfhi(c0.y); Cv[t][4] = bflo(c1.x); Cv[t][5] = bfhi(c1.x); Cv[t][6] = bflo(c1.y); Cv[t][7] = bfhi(c1.y); }
                const float Dh = d_skip[h];
                LDS_WAIT();
                const float* sin_ = state_ssm + (size_t)(b * 16 + h) * 8192; float* sout = out + O_SS + (size_t)(b * 16 + h) * 8192;
#pragma unroll 1
                for (int i0 = 0; i0 < 16; i0 += 4) { f32x4 H0[4], H1[4];
#pragma unroll
                  for (int ii = 0; ii < 4; ++ii) { const int p = 4 * (i0 + ii) + quad; H0[ii] = __builtin_nontemporal_load((const f32x4*)(sin_ + p * 128 + c16 * 4)); H1[ii] = __builtin_nontemporal_load((const f32x4*)(sin_ + p * 128 + 64 + c16 * 4)); }
#pragma unroll
                  for (int ii = 0; ii < 4; ++ii) { const int p = 4 * (i0 + ii) + quad;
                    f32x4 h0 = H0[ii], h1 = H1[ii];
                    float yk = 0.f;
#pragma unroll
                    for (int t = 0; t < 4; ++t) { const float xd = xdt[(w * 4 + t) * 64 + p]; float y = 0.f;
#pragma unroll
                        for (int k = 0; k < 4; ++k) { h0[k] = h0[k] * dA[t] + xd * Bv[t][k]; y += h0[k] * Cv[t][k]; h1[k] = h1[k] * dA[t] + xd * Bv[t][4 + k]; y += h1[k] * Cv[t][4 + k]; }
                        y = row16_sum(y);
                        if (c16 == t) yk = y + Dh * xr[(w * 4 + t) * 64 + p]; }
                    __builtin_nontemporal_store(h0, (f32x4*)(sout + p * 128 + c16 * 4)); __builtin_nontemporal_store(h1, (f32x4*)(sout + p * 128 + 64 + c16 * 4));
                    if (c16 < 4) { const float z = bf1(U[(size_t)(R0 + c16) * INW + OZ + h * 64 + p]); vals[(w * 4 + c16) * 64 + p] = yk * siluf_(z); } } }
                __syncthreads();
                if (w < 4) { float s = 0.f;
#pragma unroll
                    for (int hh = 0; hh < 8; ++hh) { const float v = vals[(hh * 4 + w) * 64 + lane]; s += v * v; }
                    s = wave_sum(s); if (lane == 0) rs[w] = rsqrtf(s * (1.f / 512.f) + EPS); }
                __syncthreads();
                { const int t = tid >> 7, ch4 = (tid & 127) * 4, hh = ch4 >> 6, p = ch4 & 63; const float r = rs[t]; const LAS float* vp = vals + (hh * 4 + t) * 64 + p;
                  u32x2 o; o.x = pk2(vp[0] * r, vp[1] * r); o.y = pk2(vp[2] * r, vp[3] * r);
                  *(u32x2*)(U + (size_t)(R0 + t) * INW + OZ + g * 512 + ch4) = o; }
            }
        }
        }
    }
    SEAM(3); STAMP(4);
    if (IN(4)) {
        LOCAL_IDS const int gtid = bx * 512 + tid;
        for (int idx = gtid; idx < 131072; idx += NGT) { const int n8 = idx & 15, p = (idx >> 4) & 63, h = (idx >> 10) & 15, b = idx >> 14;
            float hc[8];
#pragma unroll
            for (int k = 0; k < 8; ++k) hc[k] = 0.f;
            bf16_t* ptr0 = STB + ((size_t)(b * 16 * 16 + h) * 64 + p) * 128 + n8 * 8; u32x4 svv[16]; float dd[16];
#pragma unroll
            for (int c = 0; c < 16; ++c) { svv[c] = __builtin_nontemporal_load((const u32x4*)(ptr0 + (size_t)c * (16 * 8192))); dd[c] = CD[(b * 16 + c) * 16 + h]; }
#pragma unroll
            for (int c = 0; c < 16; ++c) { const u32x4 sv = svv[c];
                u32x4 o; o.x = pk2(hc[0], hc[1]); o.y = pk2(hc[2], hc[3]); o.z = pk2(hc[4], hc[5]); o.w = pk2(hc[6], hc[7]); *(u32x4*)(ptr0 + (size_t)c * (16 * 8192)) = o;
                const float d = dd[c];
                hc[0] = hc[0] * d + bflo(sv.x); hc[1] = hc[1] * d + bfhi(sv.x); hc[2] = hc[2] * d + bflo(sv.y); hc[3] = hc[3] * d + bfhi(sv.y);
                hc[4] = hc[4] * d + bflo(sv.z); hc[5] = hc[5] * d + bfhi(sv.z); hc[6] = hc[6] * d + bflo(sv.w); hc[7] = hc[7] * d + bfhi(sv.w); }
            float* op = out + O_SP + ((size_t)(b * 16 + h) * 64 + p) * 128 + n8 * 8;
            __builtin_nontemporal_store((f32x4){hc[0], hc[1], hc[2], hc[3]}, (f32x4*)op); __builtin_nontemporal_store((f32x4){hc[4], hc[5], hc[6], hc[7]}, (f32x4*)(op + 4)); }
    }
    SEAM(4); STAMP(5);
    if (IN(5)) {
        const float* a_log = kin(12); const float* d_skip = kin(13);
        LAS bf16_t* Cs = (LAS bf16_t*)lds; LAS bf16_t* Bs = (LAS bf16_t*)(lds + 34816); LAS bf16_t* CBs = (LAS bf16_t*)(lds + 69632);
        LAS bf16_t* Xt = (LAS bf16_t*)(lds + 104448 + w * 5120);
        LAS float* acs = (LAS float*)(lds + 145408); LAS float* dts = (LAS float*)(lds + 149504); LAS float* ssq = (LAS float*)(lds + 153600);
        for (int unit = bx; unit < 256; unit += G) {
            LOCAL_IDS const int b = unit >> 5, c = (unit >> 1) & 15, g = unit & 1, row0 = b * SEQ + c * 128, h = 8 * g + w;
            __syncthreads();
            { const float A = -__expf(a_log[h]);
              const float d0 = DT[(size_t)(row0 + lane) * 16 + h], d1 = DT[(size_t)(row0 + 64 + lane) * 16 + h];
              float v0 = d0 * A, v1 = d1 * A;
#pragma unroll
              for (int o = 1; o < 64; o <<= 1) { const float t0 = __builtin_bit_cast(float, __builtin_amdgcn_ds_bpermute((lane - o) << 2, __builtin_bit_cast(int, v0))), t1 = __builtin_bit_cast(float, __builtin_amdgcn_ds_bpermute((lane - o) << 2, __builtin_bit_cast(int, v1))); if (lane >= o) { v0 += t0; v1 += t1; } }
              v1 += __builtin_bit_cast(float, __builtin_amdgcn_readlane(__builtin_bit_cast(int, v0), 63));
              acs[w * 128 + lane] = v0; acs[w * 128 + 64 + lane] = v1; dts[w * 128 + lane] = d0; dts[w * 128 + 64 + lane] = d1; }
#pragma unroll 4
            for (int pc = tid; pc < 2048; pc += 512) { const int lr = pc >> 4, part = pc & 15; const bf16_t* rp = XC + (size_t)(row0 + lr) * CONVD + 1024 + g * 128 + part * 8;
                *(LAS u32x4*)(Bs + lr * 136 + part * 8) = __builtin_nontemporal_load((const u32x4*)rp); *(LAS u32x4*)(Cs + lr * 136 + part * 8) = __builtin_nontemporal_load((const u32x4*)(rp + 256)); }
            __syncthreads();
            {
                bf16x8 bfr[4];
#pragma unroll
                for (int ks = 0; ks < 4; ++ks) bfr[ks] = *(const LAS bf16x8*)(Bs + (16 * w + c16) * 136 + ks * 32 + quad * 8);
#pragma unroll
                for (int lt = 0; lt < 8; ++lt) { f32x4 d = (f32x4){0.f, 0.f, 0.f, 0.f};
#pragma unroll
                    for (int ks = 0; ks < 4; ++ks) { const bf16x8 cfr = *(const LAS bf16x8*)(Cs + (lt * 16 + c16) * 136 + ks * 32 + quad * 8); d = MFMA16(bfr[ks], cfr, d); }
                    u32x2 o; o.x = pk2(d[0], d[1]); o.y = pk2(d[2], d[3]); *(LAS u32x2*)(CBs + (lt * 16 + c16) * 136 + 16 * w + quad * 4) = o; }
            }
            __syncthreads();
            f32x4 acc[4][8];
#pragma unroll
            for (int pt = 0; pt < 4; ++pt)
#pragma unroll
                for (int lt = 0; lt < 8; ++lt) acc[pt][lt] = (f32x4){0.f, 0.f, 0.f, 0.f};
            const bf16_t* Hp = STB + (size_t)((b * 16 + c) * 16 + h) * 8192;
#pragma unroll
            for (int kh = 0; kh < 2; ++kh) { bf16x8 hf[2][4];
#pragma unroll
              for (int k2 = 0; k2 < 2; ++k2)
#pragma unroll
                for (int pt = 0; pt < 4; ++pt) hf[k2][pt] = __builtin_nontemporal_load((const bf16x8*)(Hp + (pt * 16 + c16) * 128 + (kh * 2 + k2) * 32 + quad * 8));
#pragma unroll
              for (int k2 = 0; k2 < 2; ++k2) {
#pragma unroll
                for (int lt = 0; lt < 8; ++lt) { const bf16x8 cfr = *(const LAS bf16x8*)(Cs + (lt * 16 + c16) * 136 + (kh * 2 + k2) * 32 + quad * 8);
#pragma unroll
                    for (int pt = 0; pt < 4; ++pt) acc[pt][lt] = MFMA16(hf[k2][pt], cfr, acc[pt][lt]); }
                asm volatile("" ::: "memory"); } }
#pragma unroll
            for (int lt = 0; lt < 8; ++lt) { const float e = __expf(acs[w * 128 + lt * 16 + c16]);
#pragma unroll
                for (int pt = 0; pt < 4; ++pt) acc[pt][lt] = acc[pt][lt] * e; }
            __builtin_amdgcn_sched_barrier(0);
            u32x4 xq[4][4];
#pragma unroll
            for (int k = 0; k < 4; ++k) { const int pc = lane + 64 * k, sr = pc >> 3, part = pc & 7; xq[0][k] = __builtin_nontemporal_load((const u32x4*)(XC + (size_t)(row0 + sr) * CONVD + h * 64 + part * 8)); }
#pragma unroll
            for (int sq = 0; sq < 4; ++sq) {
                asm volatile("s_waitcnt lgkmcnt(0)" ::: "memory");
#pragma unroll
                for (int k = 0; k < 4; ++k) { const int pc = lane + 64 * k, sr = pc >> 3, part = pc & 7; *(LAS u32x4*)(Xt + sr * 72 + part * 8) = xq[sq][k]; }
                if (sq < 3) {
#pragma unroll
                    for (int k = 0; k < 4; ++k) { const int pc = lane + 64 * k, sr = pc >> 3, part = pc & 7; xq[sq + 1][k] = __builtin_nontemporal_load((const u32x4*)(XC + (size_t)(row0 + (sq + 1) * 32 + sr) * CONVD + h * 64 + part * 8)); } }
                asm volatile("s_waitcnt lgkmcnt(0)" ::: "memory");
                bf16x8 xf[4]; tr_frag4<0, 32, 64, 96, 4 * 144>(LDSADDR(Xt) + (unsigned)(((quad * 8 + (c16 >> 2)) * 72 + 4 * (c16 & 3)) * 2), xf);
                const f32x4 as0 = *(const LAS f32x4*)(acs + w * 128 + sq * 32 + quad * 8), as1 = *(const LAS f32x4*)(acs + w * 128 + sq * 32 + quad * 8 + 4);
                const f32x4 ds0 = *(const LAS f32x4*)(dts + w * 128 + sq * 32 + quad * 8), ds1 = *(const LAS f32x4*)(dts + w * 128 + sq * 32 + quad * 8 + 4);
#pragma unroll
                for (int lt = 0; lt < 8; ++lt) { if (lt >= 2 * sq) {
                    const int l = lt * 16 + c16; const float al = acs[w * 128 + l];
                    const u32x4 cb = *(const LAS u32x4*)(CBs + l * 136 + sq * 32 + quad * 8);
                    const int s0 = sq * 32 + quad * 8;
                    float wv[8];
                    wv[0] = bflo(cb.x); wv[1] = bfhi(cb.x); wv[2] = bflo(cb.y); wv[3] = bfhi(cb.y); wv[4] = bflo(cb.z); wv[5] = bfhi(cb.z); wv[6] = bflo(cb.w); wv[7] = bfhi(cb.w);
#pragma unroll
                    for (int i = 0; i < 4; ++i) { wv[i] = (s0 + i <= l) ? wv[i] * __expf(fminf(al - as0[i], 0.f)) * ds0[i] : 0.f; wv[4 + i] = (s0 + 4 + i <= l) ? wv[4 + i] * __expf(fminf(al - as1[i], 0.f)) * ds1[i] : 0.f; }
                    u32x4 ww; ww.x = pk2(wv[0], wv[1]); ww.y = pk2(wv[2], wv[3]); ww.z = pk2(wv[4], wv[5]); ww.w = pk2(wv[6], wv[7]);
                    const bf16x8 wf = __builtin_bit_cast(bf16x8, ww);
#pragma unroll
                    for (int pt = 0; pt < 4; ++pt) acc[pt][lt] = MFMA16(xf[pt], wf, acc[pt][lt]);
                    asm volatile("" ::: "memory"); } }
            }
            const float Dh = d_skip[h];
#pragma unroll
            for (int lt = 0; lt < 8; ++lt) { const int l = lt * 16 + c16; const size_t tok = (size_t)(row0 + l); float ss = 0.f;
#pragma unroll
                for (int pt = 0; pt < 4; ++pt) { const int pb = pt * 16 + quad * 4;
                    const u32x2 xv = *(const u32x2*)(XC + tok * CONVD + h * 64 + pb), zv = *(const u32x2*)(U + tok * INW + OZ + h * 64 + pb);
                    const float xf0 = bflo(xv.x), xf1 = bfhi(xv.x), xf2 = bflo(xv.y), xf3 = bfhi(xv.y);
                    const float z0 = bflo(zv.x), z1 = bfhi(zv.x), z2 = bflo(zv.y), z3 = bfhi(zv.y);
                    f32x4 v = acc[pt][lt];
                    v[0] = (v[0] + Dh * xf0) * siluf_(z0); v[1] = (v[1] + Dh * xf1) * siluf_(z1); v[2] = (v[2] + Dh * xf2) * siluf_(z2); v[3] = (v[3] + Dh * xf3) * siluf_(z3);
                    acc[pt][lt] = v; ss += (v[0] * v[0] + v[1] * v[1]) + (v[2] * v[2] + v[3] * v[3]); }
                ss += __shfl_xor(ss, 16); ss += __shfl_xor(ss, 32);
                if (quad == 0) ssq[w * 128 + l] = ss;
                if (lt & 1) asm volatile("" ::: "memory"); }
            __syncthreads();
#pragma unroll
            for (int lt = 0; lt < 8; ++lt) { const int l = lt * 16 + c16; const size_t tok = (size_t)(row0 + l); float s = 0.f;
#pragma unroll
                for (int ww = 0; ww < 8; ++ww) s += ssq[ww * 128 + l];
                const float r = rsqrtf(s * (1.f / 512.f) + EPS);
#pragma unroll
                for (int pt = 0; pt < 4; ++pt) { const f32x4 v = acc[pt][lt] * r; u32x2 o; o.x = pk2(v[0], v[1]); o.y = pk2(v[2], v[3]);
                    *(u32x2*)(U + tok * INW + OZ + h * 64 + pt * 16 + quad * 4) = o; }
                asm volatile("" ::: "memory"); }
        }
    }
    SEAM(5); STAMP(6);
    if (IN(6)) {
        { pg8::Gemm g{U, WOA, M, DM, 1536, INW, 1536}; pg8::StaticOrder S; S.init(MP, DM, G, bx, 6, 2); EpiGate2 E{U, MERGED}; pg8::gemm_phase<EpiGate2, 256, 244 * MiB, -1, 8>(lds, g, S, E); }
    }
    SEAM(6); STAMP(7);
    if (IN(7)) {
        const float* x_p = kin(0);
        {
            LOCAL_IDS const float* pa = (const float*)(ws + 244 * MiB);
            for (int e4 = bx * 512 + tid; e4 < 512 * 256; e4 += NGT) { const int row = e4 >> 8, c4 = (e4 & 255) * 4;
                f32x4 sa = (f32x4){0.f, 0.f, 0.f, 0.f}, sb = (f32x4){0.f, 0.f, 0.f, 0.f};
#pragma unroll
                for (int sl = 0; sl < 6; ++sl) { const f32x4 v = *(const f32x4*)(pa + ((size_t)sl * 512 + row) * DM + c4); if (sl < 2) sa += v; else sb += v; }
                const bf16_t* up = U + (size_t)(MP + row) * INW; const u32x2 ga = *(const u32x2*)(up + OGA + c4), gb = *(const u32x2*)(up + OGB + c4);
                u32x2 o; o.x = pk2(sigmoidf_(bflo(ga.x)) * sa[0] + sigmoidf_(bflo(gb.x)) * sb[0], sigmoidf_(bfhi(ga.x)) * sa[1] + sigmoidf_(bfhi(gb.x)) * sb[1]);
                o.y = pk2(sigmoidf_(bflo(ga.y)) * sa[2] + sigmoidf_(bflo(gb.y)) * sb[2], sigmoidf_(bfhi(ga.y)) * sa[3] + sigmoidf_(bfhi(gb.y)) * sb[3]);
                st_wt8(MERGED + (size_t)(MP + row) * DM + c4, o.x, o.y); }
            SOFT_ARRIVE(0); }
        pg8::Gemm g{MERGED, WO, M, DM, DM, DM, DM}; pg8::StaticOrder S; S.init(MP, DM, G, bx, 4, 2);
        EpiRes<1> E{x_p, X1B, SSQ2}; pg8::gemm_phase<EpiRes<1>, 256, 244 * MiB, 0>(lds, g, S, E);
    }
    SEAM(7); STAMP(8);
    if (IN(8)) {
        {
            LOCAL_IDS const float* x_s = kin(1); const float* p4 = (const float*)(ws + 244 * MiB);
            for (int row = gw; row < 512; row += NGW) { float ss = 0.f;
#pragma unroll
                for (int j = 0; j < 4; ++j) { const int c = lane * 4 + 256 * j; f32x4 v = *(const f32x4*)(x_s + (size_t)row * DM + c);
#pragma unroll
                    for (int sl = 0; sl < 4; ++sl) v += *(const f32x4*)(p4 + ((size_t)sl * 512 + row) * DM + c);
                    st_wt8(X1B + (size_t)(MP + row) * DM + c, pk2(v[0], v[1]), pk2(v[2], v[3]));
                    ss += (v[0] * v[0] + v[1] * v[1]) + (v[2] * v[2] + v[3] * v[3]); }
                ss = wave_sum(ss); if (lane == 0) __hip_atomic_store(SSQ2 + MP + row, ss, __ATOMIC_RELAXED, __HIP_MEMORY_SCOPE_AGENT); }
            SOFT_ARRIVE(1); }
        pg8::Gemm g{X1B, WUP, M, DFF, DM, DM, DM}; pg8::StaticOrder S; S.init(MP, DFF, G, bx, 4, 2);
        EpiUp E{SSQ2, ACT}; pg8::gemm_phase<EpiUp, 256, WS_MERGED, 1>(lds, g, S, E);
    }
    SEAM(8); STAMP(9);
    if (IN(9)) {
        {
            LOCAL_IDS const float* p5 = (const float*)(ws + WS_MERGED);
            for (int e4 = bx * 512 + tid; e4 < 512 * 1024; e4 += NGT) { const int row = e4 >> 10, c4 = (e4 & 1023) * 4;
                f32x4 v = (f32x4){0.f, 0.f, 0.f, 0.f};
#pragma unroll
                for (int sl = 0; sl < 4; ++sl) v += *(const f32x4*)(p5 + ((size_t)sl * 512 + row) * DFF + c4);
                const float rs = rsqrtf(SSQ2[MP + row] * (1.f / DM) + EPS);
#pragma unroll
                for (int i = 0; i < 4; ++i) { const float t = fmaxf(v[i] * rs, 0.f); v[i] = t * t; }
                st_wt8(ACT + (size_t)(MP + row) * DFF + c4, pk2(v[0], v[1]), pk2(v[2], v[3])); }
            SOFT_ARRIVE(2); }
        pg8::Gemm g{ACT, WDN, M, DM, DFF, DFF, DFF}; pg8::StaticOrder S; S.init(MP, DM, G, bx, 16, 2);
        EpiRes<0> E{nullptr, X1B, nullptr}; pg8::gemm_phase<EpiRes<0>, 256, WS_MERGED, 2>(lds, g, S, E);
    }
    SEAM(9); STAMP(10);
    if (IN(10)) {
        const float* final_norm = kin(21);
        LOCAL_IDS
        const float* p6 = (const float*)(ws + WS_MERGED);
#pragma unroll 2
        for (int m = gw; m < M; m += NGW) { float* xr = X1 + (size_t)m * DM; f32x4 v[4]; float ss = 0.f;
#pragma unroll
            for (int j = 0; j < 4; ++j) { const int cidx = lane * 4 + 256 * j; const u32x2 pv = *(const u32x2*)(X1B + (size_t)m * DM + cidx); v[j] = (f32x4){bflo(pv.x), bfhi(pv.x), bflo(pv.y), bfhi(pv.y)};
                if (m >= MP) {
#pragma unroll
                    for (int sl = 0; sl < 16; ++sl) v[j] += *(const f32x4*)(p6 + ((size_t)sl * 512 + (m - MP)) * DM + cidx); }
                ss += (v[j][0] * v[j][0] + v[j][1] * v[j][1]) + (v[j][2] * v[j][2] + v[j][3] * v[j][3]); }
            const float r = rsqrtf(wave_sum(ss) * (1.f / DM) + EPS);
#pragma unroll
            for (int j = 0; j < 4; ++j) { const int cidx = lane * 4 + 256 * j; const f32x4 fw = *(const f32x4*)(final_norm + cidx); __builtin_nontemporal_store(v[j] * r * fw, (f32x4*)(xr + cidx)); } }
    }
#ifdef PROBE_A
    STAMP(11);
    if (bx == 0 && tid0 == 0) { asm volatile("s_waitcnt vmcnt(0)" ::: "memory"); const float us = (float)(tstamp[PROBE_B] - tstamp[PROBE_A]) * 0.01f; out[0] = out[0] + 16.f + us * (1.f / PROBE_SCALE); }
#endif
#undef IN
#undef SEAM
}

#ifndef N_LAUNCH_MODE
#define N_LAUNCH_MODE 1
#endif
extern "C" void kernel_launch(void* const* d_in, const int* in_sizes, int n_in, void* d_out, int out_size, void* d_ws, size_t ws_size, hipStream_t stream) {
    static int grid = 0;
    if (grid == 0) {
        int dev = 0, cus = 0, per_cu = 0;
        hipGetDevice(&dev); hipDeviceGetAttribute(&cus, hipDeviceAttributeMultiprocessorCount, dev);
        if (hipFuncSetAttribute((const void*)mega, hipFuncAttributeMaxDynamicSharedMemorySize, LDS_BYTES) != hipSuccess) { fprintf(stderr, "hipFuncSetAttribute failed\n"); }
        if (hipOccupancyMaxActiveBlocksPerMultiprocessor(&per_cu, (const void*)mega, 512, LDS_BYTES) != hipSuccess || per_cu < 1) { fprintf(stderr, "occupancy query: %d\n", per_cu); per_cu = 1; }
        (void)hipGetLastError();
        grid = cus * 1;
        if (grid <= 0) grid = 256;
    }
    (void)hipMemsetAsync((unsigned char*)d_ws + WS_BAR, 0, 1024 + XCD_BAR_WORDS * 4, stream);
    Args a{};
    for (int i = 0; i < 22; ++i) a.in[i] = (const float*)d_in[i];
    a.out = (float*)d_out; a.ws = (unsigned char*)d_ws;
#if N_LAUNCH_MODE == 1
    a.ph_lo = 0; a.ph_hi = 11;
    void* args[] = {&a};
    hipError_t e = hipLaunchCooperativeKernel((const void*)mega, dim3(grid), dim3(512), args, LDS_BYTES, stream);
    if (e != hipSuccess) fprintf(stderr, "cooperative launch failed: %s (grid %d)\n", hipGetErrorString(e), grid);
#else
    for (int p = 0; p < 11; ++p) { a.ph_lo = p; a.ph_hi = p + 1; hipLaunchKernelGGL(mega, dim3(grid), dim3(512), LDS_BYTES, stream, a); }
#endif
}
```

```cpp
#include <hip/hip_runtime.h>
#include <hip/hip_cooperative_groups.h>
#include <cstdio>
#include <cstdint>
namespace cg = cooperative_groups;

#define LAS __attribute__((address_space(3)))
typedef unsigned short bf16_t;
typedef short bf16x8 __attribute__((ext_vector_type(8)));
typedef float f32x4 __attribute__((ext_vector_type(4)));
typedef float f32x2 __attribute__((ext_vector_type(2)));
typedef unsigned u32x4 __attribute__((ext_vector_type(4)));
typedef unsigned u32x2 __attribute__((ext_vector_type(2)));

constexpr int DM = 1024, MP = 16384, MS = 512, M = MP + MS, SEQ = 2048, NBATCH = 8, DBATCH = 128;
constexpr int INW = 5392, NPAD = 5632, DFF = 4096, CONVD = 1536;
constexpr int OQ = 0, OZ = 512, OKK = 1536, OV = 1664, OX = 1792, ODT = 3328, OGA = 3344, OGB = 4368;
constexpr float EPS = 1e-6f;
constexpr size_t O_YP = 0, O_YS = 16777216, O_KP = 17301504, O_VP = 17432576, O_CP = 17563648, O_SP = 17600512,
                 O_KS = 18649088, O_VS = 20746240, O_CS = 22843392, O_SS = 23433216;
constexpr size_t MiB = 1u << 20;
constexpr size_t WS_RSTD1 = 0, WS_SSQ2 = 128 * 1024, WS_SSQF = 256 * 1024, WS_CD = 384 * 1024, WS_BAR = 512 * 1024, WS_XB = 512 * 1024 + 1024;
constexpr size_t WS_WIN = 1 * MiB, WS_WOA = 12 * MiB, WS_WOB = 13 * MiB, WS_WO = 15 * MiB, WS_DT = 17 * MiB;
constexpr size_t WS_U = 20 * MiB;
constexpr size_t WS_X1B = 20 * MiB, WS_ACT = 54 * MiB;
constexpr size_t WS_XC = 194 * MiB;
constexpr size_t WS_MERGED = 194 * MiB, WS_WUP = 227 * MiB, WS_WDN = 235 * MiB;
constexpr int LDS_BYTES = 163840;

__device__ __forceinline__ int opaque(int x) { asm volatile("" : "+v"(x)); return x; }
__device__ __forceinline__ unsigned f2bf(float f) { unsigned u = __builtin_bit_cast(unsigned, f); return (u + 0x7fffu + ((u >> 16) & 1u)) >> 16; }
typedef __bf16 bf16x2_t __attribute__((ext_vector_type(2)));
__device__ __forceinline__ unsigned pk2(float lo, float hi) { const f32x2 v = {lo, hi}; const bf16x2_t b = __builtin_convertvector(v, bf16x2_t); return __builtin_bit_cast(unsigned, b); }
__device__ __forceinline__ unsigned cvt_pk_bf16(float lo, float hi) { return pk2(lo, hi); }
__device__ __forceinline__ float bflo(unsigned w) { return __builtin_bit_cast(float, w << 16); }
__device__ __forceinline__ float bfhi(unsigned w) { return __builtin_bit_cast(float, w & 0xffff0000u); }
__device__ __forceinline__ float bf1(bf16_t h) { return __builtin_bit_cast(float, (unsigned)h << 16); }
__device__ __forceinline__ float sigmoidf_(float x) { return __builtin_amdgcn_rcpf(1.f + __expf(-x)); }
__device__ __forceinline__ float siluf_(float x) { return x * __builtin_amdgcn_rcpf(1.f + __expf(-x)); }
__device__ __forceinline__ void st_wt8(void* p, unsigned lo, unsigned hi) { __hip_atomic_store((unsigned long long*)p, ((unsigned long long)hi << 32) | lo, __ATOMIC_RELAXED, __HIP_MEMORY_SCOPE_AGENT); }
__device__ __forceinline__ float row16_sum(float v) {
    v += __builtin_bit_cast(float, __builtin_amdgcn_update_dpp(0, __builtin_bit_cast(int, v), 0xB1, 0xF, 0xF, true));
    v += __builtin_bit_cast(float, __builtin_amdgcn_update_dpp(0, __builtin_bit_cast(int, v), 0x4E, 0xF, 0xF, true));
    v += __builtin_bit_cast(float, __builtin_amdgcn_update_dpp(0, __builtin_bit_cast(int, v), 0x141, 0xF, 0xF, true));
    v += __builtin_bit_cast(float, __builtin_amdgcn_update_dpp(0, __builtin_bit_cast(int, v), 0x140, 0xF, 0xF, true));
    return v;
}
__device__ __forceinline__ float wave_sum(float v) { v = row16_sum(v); v += __shfl_xor(v, 16); v += __shfl_xor(v, 32); return v; }
#define LDS_WAIT() asm volatile("s_waitcnt lgkmcnt(0)" ::: "memory")
#define MFMA16(a, b, c) __builtin_amdgcn_mfma_f32_16x16x32_bf16(a, b, c, 0, 0, 0)

template <int O0, int O1, int O2, int O3, int D> __device__ __forceinline__ void tr_frag4(unsigned addr, bf16x8 (&f)[4]) {
    u32x2 a0, b0, a1, b1, a2, b2, a3, b3;
    asm volatile("ds_read_b64_tr_b16 %0, %8 offset:%9\n\tds_read_b64_tr_b16 %1, %8 offset:%10\n\tds_read_b64_tr_b16 %2, %8 offset:%11\n\tds_read_b64_tr_b16 %3, %8 offset:%12\n\t"
                 "ds_read_b64_tr_b16 %4, %8 offset:%13\n\tds_read_b64_tr_b16 %5, %8 offset:%14\n\tds_read_b64_tr_b16 %6, %8 offset:%15\n\tds_read_b64_tr_b16 %7, %8 offset:%16\n\ts_waitcnt lgkmcnt(0)"
                 : "=&v"(a0), "=&v"(b0), "=&v"(a1), "=&v"(b1), "=&v"(a2), "=&v"(b2), "=&v"(a3), "=&v"(b3)
                 : "v"(addr), "i"(O0), "i"(O0 + D), "i"(O1), "i"(O1 + D), "i"(O2), "i"(O2 + D), "i"(O3), "i"(O3 + D) : "memory");
    f[0] = __builtin_bit_cast(bf16x8, (u32x4){a0.x, a0.y, b0.x, b0.y}); f[1] = __builtin_bit_cast(bf16x8, (u32x4){a1.x, a1.y, b1.x, b1.y});
    f[2] = __builtin_bit_cast(bf16x8, (u32x4){a2.x, a2.y, b2.x, b2.y}); f[3] = __builtin_bit_cast(bf16x8, (u32x4){a3.x, a3.y, b3.x, b3.y});
}
#define LDSADDR(p) ((unsigned)(size_t)(p))

__device__ __forceinline__ const float* kin(int k) {
    const __attribute__((address_space(4))) unsigned char* ka = (const __attribute__((address_space(4))) unsigned char*)__builtin_amdgcn_kernarg_segment_ptr();
    asm volatile("" : "+s"(ka));
    return *(const float* const __attribute__((address_space(4)))*)(ka + 8 * k);
}
__device__ __forceinline__ unsigned char* kws() { return (unsigned char*)kin(23); }

namespace pg8 {
constexpr int BM = 256, BK = 64, HALF = 128, HTB = HALF * BK * 2, STAGE_BYTES = 8 * HTB, NXCD = 8, WGM = 8;
__host__ __device__ __forceinline__ int lds_byte(int r, int c) { const int st = (r >> 4) * 2 + (c >> 5), rr = r & 15, cc = c & 31, ob = rr * 64 + cc * 2; return st * 1024 + (ob ^ (((ob >> 9) & 1) << 5)); }
__host__ __device__ __forceinline__ void stage_rc(int b, int& R, int& C) { const int st = b / 1024, sb = b % 1024, swz = sb ^ (((sb >> 9) & 1) << 5); R = (st >> 1) * 16 + swz / 64; C = (st & 1) * 32 + (swz % 64) / 2; }
__host__ __device__ __forceinline__ int perm32(int rho) { const int n = rho >> 4, i = rho & 15; return 8 * (i >> 2) + 4 * n + (i & 3); }
struct Unit { int pm, pn, ks, split; };
struct Gemm { const bf16_t* A; const bf16_t* Bt; int M, N, K, lda, ldb; };
struct StaticOrder {
    int nM, nN, nwg, G, c, S, Q;
    __device__ __forceinline__ void init(int M_, int N_, int G_, int c_, int S_ = 1, int sample_mtiles = 0) { nM = M_ / BM; nN = N_ / BM; nwg = nM * nN; G = G_; c = c_; S = S_; Q = sample_mtiles * nN * S_; }
    __device__ __forceinline__ bool next(int i, Unit& u) const {
        const long L = (long)i * G + c; const bool isS = L >= nwg; const int q = isS ? (int)(L - nwg) : 0;
        if (isS && q >= Q) return false;
        int wgid = isS ? 0 : (int)L; { const int qq = nwg / NXCD, r = nwg % NXCD, xcd = wgid % NXCD, off = wgid / NXCD; wgid = (xcd < r ? xcd * (qq + 1) : r * (qq + 1) + (xcd - r) * qq) + off; }
        const int nig = WGM * nN, gid = wgid / nig, fm = gid * WGM, gsz = (nM - fm) < WGM ? (nM - fm) : WGM;
        const int pmF = fm + ((wgid % nig) % gsz), pnF = (wgid % nig) / gsz;
        const int tile = q / S;
        u.pm = isS ? nM + tile / nN : pmF; u.pn = isS ? tile % nN : pnF; u.ks = isS ? q - tile * S : 0; u.split = isS ? 1 : 0;
        return true;
    }
};
template <class Epi, int KSL = 128, size_t PART_OFF = 0, int SOFT_IDX = -1, int MID_T = -1, bool PART_BF16 = false>
__device__ __forceinline__ void gemm_phase(LAS unsigned char* lds, const Gemm g, const StaticOrder& S, const Epi& E) {
    const int tid = opaque((int)threadIdx.x), wid = __builtin_amdgcn_readfirstlane(tid >> 6), lane = tid & 63, wr = wid >> 2, wc = wid & 3, fr = lane & 15, fq = lane >> 4;
    const int ntF = g.K / BK; constexpr int ntS = KSL / BK; constexpr size_t ksbytes = (size_t)KSL * 2;
    unsigned voffA[2], voffB[2];
#pragma unroll
    for (int i = 0; i < 2; ++i) { int R, C; stage_rc(tid * 16 + i * 8192, R, C); const int Rb = (R & ~31) + perm32(R & 31);
        voffA[i] = (unsigned)(R * g.lda + C) * 2u; voffB[i] = (unsigned)(Rb * g.ldb + C) * 2u; }
    const size_t kstep = (size_t)(BK * 2);
    const size_t hstepA = (size_t)HALF * g.lda * 2, hstepB = (size_t)HALF * g.ldb * 2;
    const size_t tstepA = 2 * hstepA, tstepB = 2 * hstepB;
    const unsigned ldsw = (unsigned)wid * 1024u;
    const int aoff = lds_byte(wr * 64 + fr, fq * 8), boff = lds_byte(wc * 32 + fr, fq * 8);
#define PG8_SA(b, h) (((b) * 2 + (h)) * HTB)
#define PG8_SB(b, h) ((4 + (b) * 2 + (h)) * HTB)
#define PG8_STAGE(bufoff, gbase, voff) do { _Pragma("unroll") for (int _i = 0; _i < 2; ++_i) \
        __builtin_amdgcn_global_load_lds((const unsigned*)((const char*)(gbase) + (voff)[_i]), (LAS unsigned*)(lds + (bufoff) + ldsw + _i * 8192), 16, 0, 0); } while (0)
#define PG8_LDA(dst, b, h) do { _Pragma("unroll") for (int m = 0; m < 4; ++m) _Pragma("unroll") for (int k = 0; k < 2; ++k) dst[m][k] = *(const LAS bf16x8*)(lds + PG8_SA(b, h) + aoff + m * 2048 + k * 1024); } while (0)
#define PG8_LDB(dst, b, h) do { _Pragma("unroll") for (int n = 0; n < 2; ++n) _Pragma("unroll") for (int k = 0; k < 2; ++k) dst[n][k] = *(const LAS bf16x8*)(lds + PG8_SB(b, h) + boff + n * 2048 + k * 1024); } while (0)
#define PG8_MMA(ai, bj, At, Bt) do { __builtin_amdgcn_s_setprio(1); _Pragma("unroll") for (int m = 0; m < 4; ++m) _Pragma("unroll") for (int n = 0; n < 2; ++n) _Pragma("unroll") for (int k = 0; k < 2; ++k) \
        acc[ai][bj][m][n] = __builtin_amdgcn_mfma_f32_16x16x32_bf16(Bt[n][k], At[m][k], acc[ai][bj][m][n], 0, 0, 0); __builtin_amdgcn_s_setprio(0); } while (0)
#define PG8_WAIT_V(n) asm volatile("s_waitcnt vmcnt(" #n ")" ::: "memory")
#define PG8_WAIT_L(n) asm volatile("s_waitcnt lgkmcnt(" #n ")" ::: "memory")
#define PG8_BAR __builtin_amdgcn_s_barrier()
#define PG8_SCHED __builtin_amdgcn_sched_barrier(0)
    Unit cur, nxt; int ui = 0;
    if (!S.next(0, cur)) return;
    float pre[8];
#pragma unroll
    for (int e = 0; e < 8; ++e) pre[e] = 0.f;
    f32x4 acc[2][2][4][2];
#pragma unroll
    for (int a = 0; a < 2; ++a)
#pragma unroll
        for (int b = 0; b < 2; ++b)
#pragma unroll
            for (int m = 0; m < 4; ++m)
#pragma unroll
                for (int n = 0; n < 2; ++n) acc[a][b][m][n] = (f32x4){0.f, 0.f, 0.f, 0.f};
    bf16x8 At[4][2], B0[2][2], B1[2][2];
    const char* cA = (const char*)g.A + (size_t)cur.pm * tstepA + (cur.split ? cur.ks * ksbytes : 0); const char* cB = (const char*)g.Bt + (size_t)cur.pn * tstepB + (cur.split ? cur.ks * ksbytes : 0);
    PG8_STAGE(PG8_SB(0, 0), cB, voffB); PG8_STAGE(PG8_SB(0, 1), cB + hstepB, voffB); PG8_STAGE(PG8_SA(0, 0), cA, voffA); PG8_STAGE(PG8_SA(0, 1), cA + hstepA, voffA);
    if (wr == 1) PG8_BAR;
    PG8_WAIT_V(2); PG8_BAR;
    PG8_STAGE(PG8_SB(1, 0), cB + kstep, voffB); PG8_STAGE(PG8_SA(1, 0), cA + kstep, voffA); PG8_STAGE(PG8_SB(1, 1), cB + hstepB + kstep, voffB);
    PG8_WAIT_V(6); PG8_BAR;
    for (;;) {
        const bool has_next = S.next(ui + 1, nxt);
        const char* nA = has_next ? (const char*)g.A + (size_t)nxt.pm * tstepA + (nxt.split ? nxt.ks * ksbytes : 0) : cA; const char* nB = has_next ? (const char*)g.Bt + (size_t)nxt.pn * tstepB + (nxt.split ? nxt.ks * ksbytes : 0) : cB;
        const int nt = cur.split ? ntS : ntF;
        if (SOFT_IDX >= 0 && has_next && nxt.split && !cur.split) {
            if (tid == 0) { unsigned* sw = (unsigned*)(kws() + WS_BAR) + 64 + SOFT_IDX; unsigned sp = 0;
                while (__hip_atomic_load(sw, __ATOMIC_RELAXED, __HIP_MEMORY_SCOPE_AGENT) < (unsigned)gridDim.x) { __builtin_amdgcn_s_sleep(2); if (++sp > (1u << 22)) break; }
                __builtin_amdgcn_fence(__ATOMIC_ACQUIRE, "agent"); }
            PG8_BAR; }
        for (int t = 0; t < nt; t += 2) {
            const bool last = (t == nt - 2);
            if (MID_T >= 0 && t == MID_T && !cur.split) { PG8_SCHED; E.mid(acc, cur, wr, wc, fr, fq); PG8_SCHED; }
            if (last && !cur.split) E.prefetch(pre, cur, wr, fr);
            const char* a1 = cA + (size_t)(t + 1) * kstep;
            const char* a2 = last ? nA : cA + (size_t)(t + 2) * kstep; const char* b2 = last ? nB : cB + (size_t)(t + 2) * kstep;
            const char* a3 = a2 + kstep; const char* b3 = b2 + kstep;
            PG8_LDB(B0, 0, 0); PG8_LDB(B1, 0, 1); PG8_SCHED; PG8_LDA(At, 0, 0); PG8_STAGE(PG8_SA(1, 1), a1 + hstepA, voffA);
            PG8_WAIT_V(8); PG8_WAIT_L(0); PG8_BAR; PG8_MMA(0, 0, At, B0); PG8_MMA(0, 1, At, B1); PG8_BAR; PG8_SCHED;
            PG8_LDA(At, 0, 1); PG8_STAGE(PG8_SB(0, 0), b2, voffB); PG8_STAGE(PG8_SB(0, 1), b2 + hstepB, voffB); PG8_STAGE(PG8_SA(0, 0), a2, voffA);
            PG8_WAIT_V(8); PG8_WAIT_L(0); PG8_BAR; PG8_MMA(1, 0, At, B0); PG8_MMA(1, 1, At, B1); PG8_BAR; PG8_SCHED;
            PG8_LDB(B0, 1, 0); PG8_LDB(B1, 1, 1); PG8_SCHED; PG8_LDA(At, 1, 0); PG8_STAGE(PG8_SA(0, 1), a2 + hstepA, voffA);
            PG8_WAIT_V(8); PG8_WAIT_L(0); PG8_BAR; PG8_MMA(0, 0, At, B0); PG8_MMA(0, 1, At, B1); PG8_BAR; PG8_SCHED;
            PG8_LDA(At, 1, 1); PG8_STAGE(PG8_SB(1, 0), b3, voffB); PG8_STAGE(PG8_SB(1, 1), b3 + hstepB, voffB); PG8_STAGE(PG8_SA(1, 0), a3, voffA);
            PG8_WAIT_V(8); PG8_WAIT_L(0); PG8_BAR; PG8_MMA(1, 0, At, B0); PG8_MMA(1, 1, At, B1); PG8_BAR; PG8_SCHED;
        }
        if (wr == 0) PG8_BAR;
        if (cur.split) {
            const size_t pidx = ((size_t)cur.ks * 512 + (cur.pm - S.nM) * 256 + wr * 64 + fr) * g.N + cur.pn * 256 + wc * 32 + 8 * fq;
            if (PART_BF16) {
                bf16_t* pp = (bf16_t*)(kws() + PART_OFF) + pidx;
#pragma unroll
                for (int a = 0; a < 2; ++a)
#pragma unroll
                    for (int m = 0; m < 4; ++m)
#pragma unroll
                        for (int b = 0; b < 2; ++b) { const f32x4 v0 = acc[a][b][m][0], v1 = acc[a][b][m][1]; u32x4 w; w.x = pk2(v0[0], v0[1]); w.y = pk2(v0[2], v0[3]); w.z = pk2(v1[0], v1[1]); w.w = pk2(v1[2], v1[3]);
                            *(u32x4*)(pp + (size_t)(a * 128 + m * 16) * g.N + b * 128) = w; }
            } else {
            float* pp = (float*)(kws() + PART_OFF) + pidx;
#pragma unroll
            for (int a = 0; a < 2; ++a)
#pragma unroll
                for (int m = 0; m < 4; ++m)
#pragma unroll
                    for (int b = 0; b < 2; ++b) { float* q = pp + (size_t)(a * 128 + m * 16) * g.N + b * 128; *(f32x4*)q = acc[a][b][m][0]; *(f32x4*)(q + 4) = acc[a][b][m][1]; }
            }
        } else E(acc, cur, wr, wc, fr, fq, 0, 8, pre);
        if (!has_next) break;
#pragma unroll
        for (int a = 0; a < 2; ++a)
#pragma unroll
            for (int b = 0; b < 2; ++b)
#pragma unroll
                for (int m = 0; m < 4; ++m)
#pragma unroll
                    for (int n = 0; n < 2; ++n) acc[a][b][m][n] = (f32x4){0.f, 0.f, 0.f, 0.f};
        cur = nxt; cA = nA; cB = nB; ++ui;
        if (wr == 1) PG8_BAR;
    }
    PG8_WAIT_V(0);
    PG8_BAR;
#undef PG8_SA
#undef PG8_SB
#undef PG8_STAGE
#undef PG8_LDA
#undef PG8_LDB
#undef PG8_MMA
#undef PG8_WAIT_V
#undef PG8_WAIT_L
#undef PG8_BAR
#undef PG8_SCHED
}
}
typedef f32x4 AccT[2][2][4][2];
#define EPI_LOOP_ROWS for (int ai = 0; ai < 2; ++ai) _Pragma("unroll") for (int m = 0; m < 4; ++m) if (ai * 4 + m < ghi)
#define EPI_ROW (u.pm * 256 + ((ai * 4 + m + glo) >> 2) * 128 + wr * 64 + ((ai * 4 + m + glo) & 3) * 16 + fr)

struct EpiIn {
    static constexpr bool PERM = true;
    bf16_t* U; float* DT; const float* rstd; const float* dtb;
    __device__ __forceinline__ void mid(AccT&, const pg8::Unit&, int, int, int, int) const {}
    __device__ __forceinline__ void prefetch(float (&pre)[8], const pg8::Unit& u, int wr, int fr) const {
#pragma unroll
        for (int e = 0; e < 8; ++e) pre[e] = rstd[u.pm * 256 + (e >> 2) * 128 + wr * 64 + (e & 3) * 16 + fr]; }
    __device__ __forceinline__ void operator()(const AccT& acc, const pg8::Unit& u, int wr, int wc, int fr, int fq, int glo, int ghi, const float (&pre)[8]) const {
#pragma unroll
        EPI_LOOP_ROWS {
            const int row = EPI_ROW; const float rs = pre[ai * 4 + m]; bf16_t* rowp = U + (size_t)row * INW;
#pragma unroll
            for (int bj = 0; bj < 2; ++bj) { const int col0 = u.pn * 256 + bj * 128 + wc * 32 + 8 * fq;
                if (col0 < INW) { const f32x4 v0 = acc[ai][bj][m][0] * rs, v1 = acc[ai][bj][m][1] * rs;
                    u32x4 w; w.x = cvt_pk_bf16(v0[0], v0[1]); w.y = cvt_pk_bf16(v0[2], v0[3]); w.z = cvt_pk_bf16(v1[0], v1[1]); w.w = cvt_pk_bf16(v1[2], v1[3]);
                    *(u32x4*)(rowp + col0) = w;
                    if (col0 >= ODT && col0 < ODT + 16) { const int d0 = col0 - ODT; float* dp = DT + (size_t)row * 16 + d0;
#pragma unroll
                        for (int i = 0; i < 4; ++i) { float x = v0[i] + dtb[d0 + i]; dp[i] = x > 20.f ? x : log1pf(__expf(x)); x = v1[i] + dtb[d0 + 4 + i]; dp[4 + i] = x > 20.f ? x : log1pf(__expf(x)); } } } }
        }
    }
};
struct EpiGate2 {
    static constexpr bool PERM = true;
    const bf16_t* U; bf16_t* MG;
    __device__ __forceinline__ void prefetch(float (&)[8], const pg8::Unit&, int, int) const {}
    __device__ __forceinline__ void mid(AccT& acc, const pg8::Unit& u, int wr, int wc, int fr_, int fq) const {
        const int fr = opaque(fr_);
#pragma unroll
        for (int ai = 0; ai < 2; ++ai)
#pragma unroll
            for (int m = 0; m < 4; ++m) { const int row = u.pm * 256 + ai * 128 + wr * 64 + m * 16 + fr; const bf16_t* gp = U + (size_t)row * INW;
#pragma unroll
                for (int bj = 0; bj < 2; ++bj) { const int col0 = u.pn * 256 + bj * 128 + wc * 32 + 8 * fq;
                    const u32x4 ga = *(const u32x4*)(gp + OGA + col0), gb = *(const u32x4*)(gp + OGB + col0);
                    float r[8];
                    r[0] = (1.f + __expf(-bflo(gb.x))) * __builtin_amdgcn_rcpf(1.f + __expf(-bflo(ga.x))); r[1] = (1.f + __expf(-bfhi(gb.x))) * __builtin_amdgcn_rcpf(1.f + __expf(-bfhi(ga.x)));
                    r[2] = (1.f + __expf(-bflo(gb.y))) * __builtin_amdgcn_rcpf(1.f + __expf(-bflo(ga.y))); r[3] = (1.f + __expf(-bfhi(gb.y))) * __builtin_amdgcn_rcpf(1.f + __expf(-bfhi(ga.y)));
                    r[4] = (1.f + __expf(-bflo(gb.z))) * __builtin_amdgcn_rcpf(1.f + __expf(-bflo(ga.z))); r[5] = (1.f + __expf(-bfhi(gb.z))) * __builtin_amdgcn_rcpf(1.f + __expf(-bfhi(ga.z)));
                    r[6] = (1.f + __expf(-bflo(gb.w))) * __builtin_amdgcn_rcpf(1.f + __expf(-bflo(ga.w))); r[7] = (1.f + __expf(-bfhi(gb.w))) * __builtin_amdgcn_rcpf(1.f + __expf(-bfhi(ga.w)));
                    f32x4 a0 = acc[ai][bj][m][0], a1 = acc[ai][bj][m][1];
                    a0[0] *= r[0]; a0[1] *= r[1]; a0[2] *= r[2]; a0[3] *= r[3]; a1[0] *= r[4]; a1[1] *= r[5]; a1[2] *= r[6]; a1[3] *= r[7];
                    acc[ai][bj][m][0] = a0; acc[ai][bj][m][1] = a1; }
                __builtin_amdgcn_sched_barrier(0); }
    }
    __device__ __forceinline__ void operator()(const AccT& acc, const pg8::Unit& u, int wr, int wc, int fr, int fq, int glo, int ghi, const float (&pre)[8]) const {
#pragma unroll
        EPI_LOOP_ROWS {
            const int row = EPI_ROW; const bf16_t* gp = U + (size_t)row * INW + OGB; bf16_t* op = MG + (size_t)row * DM;
#pragma unroll
            for (int bj = 0; bj < 2; ++bj) { const int col0 = u.pn * 256 + bj * 128 + wc * 32 + 8 * fq;
                const u32x4 gv = *(const u32x4*)(gp + col0); const f32x4 a0 = acc[ai][bj][m][0], a1 = acc[ai][bj][m][1];
                float r[8];
                r[0] = sigmoidf_(bflo(gv.x)) * a0[0]; r[1] = sigmoidf_(bfhi(gv.x)) * a0[1]; r[2] = sigmoidf_(bflo(gv.y)) * a0[2]; r[3] = sigmoidf_(bfhi(gv.y)) * a0[3];
                r[4] = sigmoidf_(bflo(gv.z)) * a1[0]; r[5] = sigmoidf_(bfhi(gv.z)) * a1[1]; r[6] = sigmoidf_(bflo(gv.w)) * a1[2]; r[7] = sigmoidf_(bfhi(gv.w)) * a1[3];
                u32x4 w; w.x = cvt_pk_bf16(r[0], r[1]); w.y = cvt_pk_bf16(r[2], r[3]); w.z = cvt_pk_bf16(r[4], r[5]); w.w = cvt_pk_bf16(r[6], r[7]);
                *(u32x4*)(op + col0) = w; }
        }
    }
};
template <int FIRST> struct EpiRes {
    static constexpr bool PERM = true;
    __device__ __forceinline__ void mid(AccT&, const pg8::Unit&, int, int, int, int) const {}
    __device__ __forceinline__ void prefetch(float (&)[8], const pg8::Unit&, int, int) const {}
    const float* base_p; bf16_t* XB; float* ssq;
    __device__ __forceinline__ void operator()(const AccT& acc, const pg8::Unit& u, int wr, int wc, int fr, int fq, int glo, int ghi, const float (&pre)[8]) const {
#pragma unroll
        EPI_LOOP_ROWS {
            const int row = EPI_ROW; bf16_t* xb = XB + (size_t)row * DM; float ss = 0.f;
#pragma unroll
            for (int bj = 0; bj < 2; ++bj) { const int col0 = u.pn * 256 + bj * 128 + wc * 32 + 8 * fq;
                f32x4 b0, b1;
                if (FIRST) { const float* bp = base_p + (size_t)row * DM + col0; b0 = __builtin_nontemporal_load((const f32x4*)bp); b1 = __builtin_nontemporal_load((const f32x4*)(bp + 4)); }
                else { const u32x4 pv = *(const u32x4*)(xb + col0); b0 = (f32x4){bflo(pv.x), bfhi(pv.x), bflo(pv.y), bfhi(pv.y)}; b1 = (f32x4){bflo(pv.z), bfhi(pv.z), bflo(pv.w), bfhi(pv.w)}; }
                const f32x4 v0 = b0 + acc[ai][bj][m][0], v1 = b1 + acc[ai][bj][m][1];
                if (FIRST) ss += (v0[0] * v0[0] + v0[1] * v0[1]) + (v0[2] * v0[2] + v0[3] * v0[3]) + (v1[0] * v1[0] + v1[1] * v1[1]) + (v1[2] * v1[2] + v1[3] * v1[3]);
                u32x4 w; w.x = cvt_pk_bf16(v0[0], v0[1]); w.y = cvt_pk_bf16(v0[2], v0[3]); w.z = cvt_pk_bf16(v1[0], v1[1]); w.w = cvt_pk_bf16(v1[2], v1[3]);
                *(u32x4*)(xb + col0) = w; }
            if (FIRST) { ss += __shfl_xor(ss, 16); ss += __shfl_xor(ss, 32); if (fq == 0) atomicAdd(ssq + row, ss); }
        }
    }
};
struct EpiUp {
    static constexpr bool PERM = true;
    const float* ssq2; bf16_t* ACT;
    __device__ __forceinline__ void mid(AccT&, const pg8::Unit&, int, int, int, int) const {}
    __device__ __forceinline__ void prefetch(float (&pre)[8], const pg8::Unit& u, int wr, int fr) const {
#pragma unroll
        for (int e = 0; e < 8; ++e) pre[e] = ssq2[u.pm * 256 + (e >> 2) * 128 + wr * 64 + (e & 3) * 16 + fr]; }
    __device__ __forceinline__ void operator()(const AccT& acc, const pg8::Unit& u, int wr, int wc, int fr, int fq, int glo, int ghi, const float (&pre)[8]) const {
#pragma unroll
        EPI_LOOP_ROWS {
            const int row = EPI_ROW; const float rs = rsqrtf(pre[ai * 4 + m] * (1.f / DM) + EPS); bf16_t* op = ACT + (size_t)row * DFF;
#pragma unroll
            for (int bj = 0; bj < 2; ++bj) { const int col0 = u.pn * 256 + bj * 128 + wc * 32 + 8 * fq;
                f32x4 v0 = acc[ai][bj][m][0] * rs, v1 = acc[ai][bj][m][1] * rs;
#pragma unroll
                for (int i = 0; i < 4; ++i) { const float a = fmaxf(v0[i], 0.f), b = fmaxf(v1[i], 0.f); v0[i] = a * a; v1[i] = b * b; }
                u32x4 w; w.x = cvt_pk_bf16(v0[0], v0[1]); w.y = cvt_pk_bf16(v0[2], v0[3]); w.z = cvt_pk_bf16(v1[0], v1[1]); w.w = cvt_pk_bf16(v1[2], v1[3]);
                *(u32x4*)(op + col0) = w; }
        }
    }
};

__device__ __forceinline__ void transpose_item(const float* W, int K, int N, const float* scale, bf16_t* WT, int ldw, int kdst0, LAS float* scr, int kb, int nsrc0, int ndst0, int lane) {
    const int k0 = 64 * kb;
    const int n = nsrc0 + (lane & 15) * 4, kr = lane >> 4;
    f32x4 v[16];
#pragma unroll
    for (int i = 0; i < 16; ++i) { v[i] = (f32x4){0.f, 0.f, 0.f, 0.f}; if (n < N) v[i] = __builtin_nontemporal_load((const f32x4*)(W + (size_t)(k0 + 4 * i + kr) * N + n)); }
#pragma unroll
    for (int i = 0; i < 16; ++i) { const int kk = 4 * i + kr; const float sc = scale ? scale[k0 + kk] : 1.f; LAS float* p = scr + kk * 65 + (lane & 15) * 4;
        p[0] = v[i][0] * sc; p[1] = v[i][1] * sc; p[2] = v[i][2] * sc; p[3] = v[i][3] * sc; }
    LDS_WAIT();
    const int c = lane & 7;
#pragma unroll
    for (int j = 0; j < 8; ++j) { const int nn = (lane >> 3) + 8 * j; const LAS float* sp = scr + (8 * c) * 65 + nn;
        u32x4 o; o.x = pk2(sp[0 * 65], sp[1 * 65]); o.y = pk2(sp[2 * 65], sp[3 * 65]); o.z = pk2(sp[4 * 65], sp[5 * 65]); o.w = pk2(sp[6 * 65], sp[7 * 65]);
        *(u32x4*)(WT + (size_t)(ndst0 + nn) * ldw + kdst0 + k0 + 8 * c) = o; }
    LDS_WAIT();
}

constexpr int KS_LD = 72;
__device__ __forceinline__ void attn_tile(const LAS bf16_t* Ks, const LAS bf16_t* Vt, bf16_t* qptr, const bf16x8 qf0, const bf16x8 qf1, int kt0, int rq, int kmin, float sink, int lane) {
    const int c16 = lane & 15, quad = lane >> 4;
    bf16x8 qf[2]; qf[0] = qf0; qf[1] = qf1;
    f32x4 s[10]; s[9] = (f32x4){0.f, 0.f, 0.f, 0.f};
#pragma unroll
    for (int j = 0; j < 9; ++j) { s[j] = (f32x4){0.f, 0.f, 0.f, 0.f};
#pragma unroll
        for (int ks = 0; ks < 2; ++ks) { const bf16x8 kf = *(const LAS bf16x8*)(Ks + ((kt0 + j) * 16 + c16) * KS_LD + ks * 32 + quad * 8); s[j] = MFMA16(kf, qf[ks], s[j]); } }
    float mx = sink;
#pragma unroll
    for (int j = 0; j < 9; ++j)
#pragma unroll
        for (int jj = 0; jj < 4; ++jj) { const int kidx = (kt0 + j) * 16 + quad * 4 + jj; const bool ok = (kidx >= rq) && (kidx <= rq + 128) && (kidx >= kmin);
            const float v = ok ? s[j][jj] * 0.125f : -INFINITY; s[j][jj] = v; mx = fmaxf(mx, v); }
    mx = fmaxf(mx, __shfl_xor(mx, 16)); mx = fmaxf(mx, __shfl_xor(mx, 32));
    float sum = 0.f;
#pragma unroll
    for (int j = 0; j < 9; ++j)
#pragma unroll
        for (int jj = 0; jj < 4; ++jj) { const float p = __expf(s[j][jj] - mx); s[j][jj] = p; sum += p; }
    sum += __shfl_xor(sum, 16); sum += __shfl_xor(sum, 32); sum += __expf(sink - mx);
    const float inv = 1.f / sum;
    f32x4 o[4];
#pragma unroll
    for (int dt = 0; dt < 4; ++dt) o[dt] = (f32x4){0.f, 0.f, 0.f, 0.f};
    const unsigned vaddr = LDSADDR(Vt) + (unsigned)(((kt0 * 16 + quad * 4 + (c16 >> 2)) * KS_LD + 4 * (c16 & 3)) * 2);
#pragma unroll
    for (int st = 0; st < 5; ++st) {
        u32x4 pw; pw.x = pk2(s[2 * st][0] * inv, s[2 * st][1] * inv); pw.y = pk2(s[2 * st][2] * inv, s[2 * st][3] * inv);
        pw.z = pk2(s[2 * st + 1][0] * inv, s[2 * st + 1][1] * inv); pw.w = pk2(s[2 * st + 1][2] * inv, s[2 * st + 1][3] * inv);
        const bf16x8 pf = __builtin_bit_cast(bf16x8, pw);
        bf16x8 vf[4]; tr_frag4<0, 32, 64, 96, 16 * KS_LD * 2>(vaddr + st * (32 * KS_LD * 2), vf);
#pragma unroll
        for (int dt = 0; dt < 4; ++dt) o[dt] = MFMA16(vf[dt], pf, o[dt]);
    }
#pragma unroll
    for (int dt = 0; dt < 4; ++dt) { u32x2 w; w.x = pk2(o[dt][0], o[dt][1]); w.y = pk2(o[dt][2], o[dt][3]); *(u32x2*)(qptr + dt * 16 + quad * 4) = w; }
}

#define XB_TMO      128
#define XB_XCNT(j)  (256  + 64 * (j))
#define XB_XSUB(j)  (1280 + 64 * (j))
#define XB_XGEN(j)  (2304 + 64 * (j))
#define XB_TOP      3328
#define XB_TOPGEN   3392
#define XCD_BAR_WORDS 3456
#define XB_SPIN_CAP (1u << 18)
__device__ __forceinline__ unsigned xb_ld(unsigned* p)              { return __hip_atomic_load(p, __ATOMIC_RELAXED, __HIP_MEMORY_SCOPE_AGENT); }
__device__ __forceinline__ unsigned xb_add(unsigned* p, unsigned v) { return __hip_atomic_fetch_add(p, v, __ATOMIC_RELAXED, __HIP_MEMORY_SCOPE_AGENT); }
__device__ __forceinline__ unsigned xb_xcc_id() { return (unsigned)__builtin_amdgcn_s_getreg((3 << 11) | 20) & 0xFu; }
#define XB_SPIN(cond, bar) do { unsigned _sp = 0; while (cond) { __builtin_amdgcn_s_sleep(1); \
    if ((++_sp & 255u) == 0u) { if (xb_ld(&(bar)[XB_TMO])) break; if (_sp > XB_SPIN_CAP) { atomicAdd(&(bar)[XB_TMO], 1u); break; } } } } while (0)
__device__ __forceinline__ void xcd_barrier_complete(unsigned* bar, unsigned x, unsigned& nloc, unsigned& nx) {
    const unsigned Gt = gridDim.x;
    unsigned sum, cnt, mine, sp = 0u;
    for (;;) {
        sum = 0u; cnt = 0u; mine = 0u;
#pragma unroll
        for (unsigned j = 0; j < 16; ++j) { const unsigned c = xb_ld(&bar[XB_XCNT(j)]); sum += c; cnt += (c > 0u) ? 1u : 0u; mine = (j == x) ? c : mine; }
        if (sum == Gt) break;
        __builtin_amdgcn_s_sleep(1);
        if ((++sp & 255u) == 0u) { if (xb_ld(&bar[XB_TMO])) break; if (sp > XB_SPIN_CAP) { atomicAdd(&bar[XB_TMO], 1u); break; } }
    }
    nloc = mine > 0u ? mine : 1u; nx = cnt > 0u ? cnt : 1u;
}
__device__ __forceinline__ void xcd_barrier(unsigned* bar, unsigned x, volatile LAS unsigned* st, int tid0) {
    asm volatile("s_waitcnt vmcnt(0) lgkmcnt(0)" ::: "memory");
    __syncthreads();
    if (tid0 == 0) {
        __builtin_amdgcn_s_waitcnt(0);
        unsigned nloc = st[0], nx = st[1];
        if (nloc == 0u) { xcd_barrier_complete(bar, x, nloc, nx); st[0] = nloc; st[1] = nx; }
        const unsigned old = xb_add(&bar[XB_XSUB(x)], 1u);
        const unsigned gen = old / nloc;
        if (old + 1u == (gen + 1u) * nloc) {
            __builtin_amdgcn_fence(__ATOMIC_RELEASE, "agent");
            asm volatile("s_waitcnt vmcnt(0)" ::: "memory");
            const unsigned og = xb_add(&bar[XB_TOP], 1u);
            const unsigned tg = og / nx;
            if (og + 1u == (tg + 1u) * nx) xb_add(&bar[XB_TOPGEN], 1u);
            else XB_SPIN(xb_ld(&bar[XB_TOPGEN]) == tg, bar);
            __builtin_amdgcn_fence(__ATOMIC_ACQUIRE, "agent");
            xb_add(&bar[XB_XGEN(x)], 1u);
            asm volatile("s_waitcnt vmcnt(0)" ::: "memory");
        } else {
            XB_SPIN(xb_ld(&bar[XB_XGEN(x)]) == gen, bar);
            __builtin_amdgcn_fence(__ATOMIC_ACQUIRE, "agent");
            asm volatile("s_waitcnt vmcnt(0)" ::: "memory");
        }
    }
    __syncthreads();
}
struct Args { const float* in[22]; float* out; unsigned char* ws; int ph_lo, ph_hi; };

__global__ void __launch_bounds__(512, 2) mega(Args a) {
    extern __shared__ __attribute__((aligned(16))) unsigned char lds_raw[];
    LAS unsigned char* lds = (LAS unsigned char*)lds_raw;
    cg::grid_group grid = cg::this_grid();
    const int tid0 = threadIdx.x, w = __builtin_amdgcn_readfirstlane(tid0 >> 6), G = gridDim.x, bx = blockIdx.x;
    const int gw = bx * 8 + w, NGW = G * 8, NGT = G * 512;
#define LOCAL_IDS const int tid = opaque(tid0), lane = tid & 63, c16 = lane & 15, quad = lane >> 4; (void)c16; (void)quad; (void)lane;
    unsigned char* ws = a.ws; float* out = a.out;
    float* RSTD1 = (float*)(ws + WS_RSTD1); float* SSQ2 = (float*)(ws + WS_SSQ2); float* SSQF = (float*)(ws + WS_SSQF); float* CD = (float*)(ws + WS_CD);
    bf16_t* WIN = (bf16_t*)(ws + WS_WIN); bf16_t* WOA = (bf16_t*)(ws + WS_WOA); bf16_t* WOB = (bf16_t*)(ws + WS_WOB); bf16_t* WO = (bf16_t*)(ws + WS_WO);
    bf16_t* WUP = (bf16_t*)((unsigned char*)out + 40 * MiB); bf16_t* WDN = (bf16_t*)((unsigned char*)out + 48 * MiB);
    float* DT = (float*)(ws + WS_DT); bf16_t* U = (bf16_t*)(ws + WS_U); bf16_t* XC = (bf16_t*)(ws + WS_XC);
    bf16_t* MERGED = (bf16_t*)(ws + WS_MERGED); bf16_t* X1B = (bf16_t*)(ws + WS_X1B); bf16_t* ACT = (bf16_t*)(ws + WS_ACT);
    bf16_t* XB = (bf16_t*)(out + O_SS);
    bf16_t* STB = (bf16_t*)(out + O_YP);
    float* X1 = out + O_YP;
    const int lo = a.ph_lo, hi = a.ph_hi;
#ifndef PHMASK
#define PHMASK 0x7ff
#endif
#define IN(k) (((PHMASK >> (k)) & 1) && lo <= (k) && (k) < hi)
    unsigned* BARW = (unsigned*)(ws + WS_BAR);
    if (lo < 0) grid.sync();
#ifdef PROBE_A
    unsigned tstamp[12];
#define STAMP(i) tstamp[i] = (unsigned)__builtin_amdgcn_s_memrealtime()
    STAMP(0);
#else
#define STAMP(i)
#endif
    unsigned* XBW = (unsigned*)(ws + WS_XB); volatile LAS unsigned* xst = (volatile LAS unsigned*)(lds + LDS_BYTES - 64);
    const unsigned xcc = xb_xcc_id();
    if (tid0 < 2) xst[tid0] = 0u;
    if (tid0 == 0) (void)xb_add(&XBW[XB_XCNT(xcc)], 1u);
    __syncthreads();
#define SEAM(k) do { if (IN(k) && IN((k) + 1)) xcd_barrier(XBW, xcc, xst, tid0); } while (0)
#define SOFT_ARRIVE(k) do { asm volatile("s_waitcnt vmcnt(0) lgkmcnt(0)" ::: "memory"); __syncthreads(); \
        if (tid0 == 0) { __hip_atomic_fetch_add(BARW + 64 + (k), 1u, __ATOMIC_RELAXED, __HIP_MEMORY_SCOPE_AGENT); } } while (0)
    if (IN(0)) {
        const float* x_p = kin(0); const float* x_s = kin(1); const float* norm1 = kin(6); const float* w_in = kin(7); const float* ssm_norm = kin(14); const float* w_oa = kin(15); const float* w_ob = kin(16); const float* w_o = kin(17);
        LOCAL_IDS const int gtid = bx * 512 + tid;
        LAS float* scr = (LAS float*)(lds + w * 16640);
        constexpr int I_IN = 16 * 88, I_OA = 8 * 16, I_OB = 16 * 16, I_O = 16 * 16;
        for (int it = gw; it < I_IN + I_OA + I_OB + I_O; it += NGW) {
            int r = it;
            if (r < I_IN) { const int kb = r / 88, nd = 64 * (r % 88); const int ns = nd < 512 ? nd : (nd < 1536 ? nd + 256 : (nd < 1792 ? nd - 1024 : nd));
                transpose_item(w_in, DM, INW, norm1, WIN, DM, 0, scr, kb, ns, nd, lane); continue; } r -= I_IN;
            if (r < I_OA) { transpose_item(w_oa, 512, DM, nullptr, WOA, 1536, 0, scr, r / 16, 64 * (r % 16), 64 * (r % 16), lane); continue; } r -= I_OA;
            if (r < I_OB) { transpose_item(w_ob, DM, DM, ssm_norm, WOA, 1536, 512, scr, r / 16, 64 * (r % 16), 64 * (r % 16), lane); continue; } r -= I_OB;
            transpose_item(w_o, DM, DM, nullptr, WO, DM, 0, scr, r / 16, 64 * (r % 16), 64 * (r % 16), lane);
        }
#pragma unroll 2
        for (int m = gw; m < M; m += NGW) {
            const float* xr = m < MP ? x_p + (size_t)m * DM : x_s + (size_t)(m - MP) * DM;
            f32x4 v[4]; float ss = 0.f;
#pragma unroll
            for (int j = 0; j < 4; ++j) { v[j] = __builtin_nontemporal_load((const f32x4*)(xr + lane * 4 + 256 * j)); ss += (v[j][0] * v[j][0] + v[j][1] * v[j][1]) + (v[j][2] * v[j][2] + v[j][3] * v[j][3]); }
            ss = wave_sum(ss);
            if (lane == 0) RSTD1[m] = rsqrtf(ss * (1.f / DM) + EPS);
#pragma unroll
            for (int j = 0; j < 4; ++j) { u32x2 o; o.x = pk2(v[j][0], v[j][1]); o.y = pk2(v[j][2], v[j][3]); *(u32x2*)(XB + (size_t)m * DM + lane * 4 + 256 * j) = o; }
        }
        for (int i = gtid; i < M; i += NGT) { SSQ2[i] = 0.f; SSQF[i] = 0.f; }
    }
    SEAM(0); STAMP(1);
    if (IN(1)) {
        const float* dt_bias = kin(11);
        pg8::Gemm g{XB, WIN, M, NPAD, DM, DM, DM}; pg8::StaticOrder S; S.init(M, NPAD, G, bx);
        EpiIn E{U, DT, RSTD1, dt_bias};
        pg8::gemm_phase<EpiIn>(lds, g, S, E);
        {
            constexpr int NT1 = (M / 256) * (NPAD / 256); const int full = NT1 / G, rem = NT1 - full * G;
            if (bx >= rem && rem > 0) { LOCAL_IDS const float* norm2 = kin(18); const float* w_up = kin(19); const float* w_down = kin(20);
                LAS float* scr = (LAS float*)(lds + w * 16640); const int nidle = (G - rem) * 8;
                for (int it = (bx - rem) * 8 + w; it < 2048; it += nidle) { if (it < 1024) transpose_item(w_up, DM, DFF, norm2, WUP, DM, 0, scr, it / 64, 64 * (it % 64), 64 * (it % 64), lane); else transpose_item(w_down, DFF, DM, nullptr, WDN, DFF, 0, scr, (it - 1024) / 16, 64 * ((it - 1024) % 16), 64 * ((it - 1024) % 16), lane); } } }
    }
    SEAM(1); STAMP(2);
    if (IN(2)) {
        const float* cache_k = kin(2); const float* cache_v = kin(3); const float* state_conv = kin(4); const float* sinks = kin(8); const float* conv_w = kin(9); const float* conv_b = kin(10);
        {   LOCAL_IDS
            if (tid < 384) {
                const int cgi = tid % 192, sub = tid / 192, ch0 = cgi * 8;
                float wv[4][8], bias[8];
#pragma unroll
                for (int i = 0; i < 4; ++i) { const f32x4 t0 = *(const f32x4*)(conv_w + i * CONVD + ch0), t1 = *(const f32x4*)(conv_w + i * CONVD + ch0 + 4);
#pragma unroll
                    for (int k = 0; k < 4; ++k) { wv[i][k] = t0[k]; wv[i][4 + k] = t1[k]; } }
                { const f32x4 t0 = *(const f32x4*)(conv_b + ch0), t1 = *(const f32x4*)(conv_b + ch0 + 4);
#pragma unroll
                  for (int k = 0; k < 4; ++k) { bias[k] = t0[k]; bias[4 + k] = t1[k]; } }
#pragma unroll 1
                for (int rg = bx * 2 + sub; rg < 4096 + 128; rg += 2 * G) {
                    const bool prompt = rg < 4096; const int bs = rg - 4096;
                    const int rowbase = prompt ? rg * 4 : MP + bs * 4; const int t = rowbase & (SEQ - 1);
                    float x[7][8];
                    u32x4 r[7];
#pragma unroll
                    for (int j = 0; j < 7; ++j) r[j] = (u32x4){0u, 0u, 0u, 0u};
#pragma unroll
                    for (int j = 3; j < 7; ++j) r[j] = __builtin_nontemporal_load((const u32x4*)(U + (size_t)(rowbase + j - 3) * INW + OX + ch0));
                    if (prompt && t > 0) {
#pragma unroll
                        for (int j = 0; j < 3; ++j) r[j] = *(const u32x4*)(U + (size_t)(rowbase + j - 3) * INW + OX + ch0); }
#pragma unroll
                    for (int j = 0; j < 7; ++j) { x[j][0] = bflo(r[j].x); x[j][1] = bfhi(r[j].x); x[j][2] = bflo(r[j].y); x[j][3] = bfhi(r[j].y); x[j][4] = bflo(r[j].z); x[j][5] = bfhi(r[j].z); x[j][6] = bflo(r[j].w); x[j][7] = bfhi(r[j].w); }
                    if (!prompt) { const float* sp = state_conv + (size_t)bs * 3 * CONVD + ch0;
#pragma unroll
                        for (int j = 0; j < 3; ++j) { const f32x4 a0 = *(const f32x4*)(sp + j * CONVD), a1 = *(const f32x4*)(sp + j * CONVD + 4);
#pragma unroll
                            for (int k = 0; k < 4; ++k) { x[j][k] = a0[k]; x[j][4 + k] = a1[k]; } } }
#pragma unroll
                    for (int tt = 0; tt < 4; ++tt) { float y[8];
#pragma unroll
                        for (int k = 0; k < 8; ++k) { const float sacc = bias[k] + x[tt][k] * wv[0][k] + x[tt + 1][k] * wv[1][k] + x[tt + 2][k] * wv[2][k] + x[tt + 3][k] * wv[3][k]; y[k] = siluf_(sacc); }
                        u32x4 o; o.x = pk2(y[0], y[1]); o.y = pk2(y[2], y[3]); o.z = pk2(y[4], y[5]); o.w = pk2(y[6], y[7]);
                        *(u32x4*)(XC + (size_t)(rowbase + tt) * CONVD + ch0) = o; }
                    float* obase = nullptr;
                    if (prompt) { if (t == SEQ - 4) obase = out + O_CP + (size_t)(rowbase >> 11) * 3 * CONVD; } else obase = out + O_CS + (size_t)bs * 3 * CONVD;
                    if (obase) {
#pragma unroll
                        for (int j = 0; j < 3; ++j) { float* op = obase + (size_t)j * CONVD + ch0; *(f32x4*)op = (f32x4){x[4 + j][0], x[4 + j][1], x[4 + j][2], x[4 + j][3]}; *(f32x4*)(op + 4) = (f32x4){x[4 + j][4], x[4 + j][5], x[4 + j][6], x[4 + j][7]}; } }
                }
            }
        }
        LAS bf16_t* Ks = (LAS bf16_t*)lds; LAS bf16_t* Vt = (LAS bf16_t*)(lds + 272 * KS_LD * 2);
        LAS bf16_t* Ks2 = (LAS bf16_t*)(lds + 2 * 272 * KS_LD * 2); LAS bf16_t* Vt2 = (LAS bf16_t*)(lds + 2 * 272 * KS_LD * 2 + 160 * KS_LD * 2);
        for (int unit = bx; unit < 256; unit += G) {
            LOCAL_IDS const int b = unit >> 5, qblk = (unit >> 1) & 15, kvh = unit & 1, bs = unit >> 1, kvh2 = unit & 1;
            const int hq = kvh * 4 + (w >> 1), qh = w & 1; const float sink = sinks[hq];
            bf16x8 qf[4][2];
#pragma unroll
            for (int i = 0; i < 4; ++i) { const bf16_t* qp = U + (size_t)(b * SEQ + qblk * 128 + qh * 64 + i * 16 + c16) * INW + hq * 64; qf[i][0] = *(const bf16x8*)(qp + quad * 8); qf[i][1] = *(const bf16x8*)(qp + 32 + quad * 8); }
            const int sw = unit & 7;
            const int gq = c16 >> 2, ts = c16 & 3, hq2 = kvh2 * 4 + gq;
            bf16_t* qp2 = U + (size_t)(MP + bs * 4 + ts) * INW + hq2 * 64; bf16x8 q2a = qf[0][0], q2b = qf[0][1];
            if (w == sw) { q2a = *(const bf16x8*)(qp2 + quad * 8); q2b = *(const bf16x8*)(qp2 + 32 + quad * 8); }
            __syncthreads();
#pragma unroll
            for (int pc = tid; pc < 272 * 8; pc += 512) { const int kidx = pc >> 3, part = pc & 7; const int tok = (qblk - 1) * 128 + kidx;
                u32x4 kv = (u32x4){0u, 0u, 0u, 0u}, vv = (u32x4){0u, 0u, 0u, 0u};
                if (kidx < 256 && tok >= 0) { const bf16_t* rp = U + (size_t)(b * SEQ + tok) * INW + kvh * 64 + part * 8; kv = *(const u32x4*)(rp + OKK); vv = *(const u32x4*)(rp + OV);
                    if (qblk == 15 && kidx >= 128) { const size_t oo = ((size_t)(b * 128 + kidx - 128) * 2 + kvh) * 64 + part * 8;
                        *(f32x4*)(out + O_KP + oo) = (f32x4){bflo(kv.x), bfhi(kv.x), bflo(kv.y), bfhi(kv.y)}; *(f32x4*)(out + O_KP + oo + 4) = (f32x4){bflo(kv.z), bfhi(kv.z), bflo(kv.w), bfhi(kv.w)};
                        *(f32x4*)(out + O_VP + oo) = (f32x4){bflo(vv.x), bfhi(vv.x), bflo(vv.y), bfhi(vv.y)}; *(f32x4*)(out + O_VP + oo + 4) = (f32x4){bflo(vv.z), bfhi(vv.z), bflo(vv.w), bfhi(vv.w)}; } }
                *(LAS u32x4*)(Ks + kidx * KS_LD + part * 8) = kv; *(LAS u32x4*)(Vt + kidx * KS_LD + part * 8) = vv; }
#pragma unroll
            for (int pc = tid; pc < 160 * 8; pc += 512) { const int kidx = pc >> 3, part = pc & 7;
                float kf[8], vf[8];
#pragma unroll
                for (int i = 0; i < 8; ++i) { kf[i] = 0.f; vf[i] = 0.f; }
                if (kidx < 128) { const size_t io = ((size_t)(bs * 128 + kidx) * 2 + kvh2) * 64 + part * 8;
                    const f32x4 k0 = __builtin_nontemporal_load((const f32x4*)(cache_k + io)), k1 = __builtin_nontemporal_load((const f32x4*)(cache_k + io + 4)), v0 = __builtin_nontemporal_load((const f32x4*)(cache_v + io)), v1 = __builtin_nontemporal_load((const f32x4*)(cache_v + io + 4));
#pragma unroll
                    for (int i = 0; i < 4; ++i) { kf[i] = k0[i]; kf[4 + i] = k1[i]; vf[i] = v0[i]; vf[4 + i] = v1[i]; }
                } else if (kidx < 132) { const bf16_t* rp = U + (size_t)(MP + bs * 4 + kidx - 128) * INW + kvh2 * 64 + part * 8; const u32x4 kv = *(const u32x4*)(rp + OKK), vv = *(const u32x4*)(rp + OV);
                    kf[0] = bflo(kv.x); kf[1] = bfhi(kv.x); kf[2] = bflo(kv.y); kf[3] = bfhi(kv.y); kf[4] = bflo(kv.z); kf[5] = bfhi(kv.z); kf[6] = bflo(kv.w); kf[7] = bfhi(kv.w);
                    vf[0] = bflo(vv.x); vf[1] = bfhi(vv.x); vf[2] = bflo(vv.y); vf[3] = bfhi(vv.y); vf[4] = bflo(vv.z); vf[5] = bfhi(vv.z); vf[6] = bflo(vv.w); vf[7] = bfhi(vv.w); }
                if (kidx >= 4 && kidx < 132) { const size_t oo = ((size_t)(bs * 128 + kidx - 4) * 2 + kvh2) * 64 + part * 8;
                    __builtin_nontemporal_store((f32x4){kf[0], kf[1], kf[2], kf[3]}, (f32x4*)(out + O_KS + oo)); __builtin_nontemporal_store((f32x4){kf[4], kf[5], kf[6], kf[7]}, (f32x4*)(out + O_KS + oo + 4));
                    __builtin_nontemporal_store((f32x4){vf[0], vf[1], vf[2], vf[3]}, (f32x4*)(out + O_VS + oo)); __builtin_nontemporal_store((f32x4){vf[4], vf[5], vf[6], vf[7]}, (f32x4*)(out + O_VS + oo + 4)); }
                u32x4 kw; kw.x = pk2(kf[0], kf[1]); kw.y = pk2(kf[2], kf[3]); kw.z = pk2(kf[4], kf[5]); kw.w = pk2(kf[6], kf[7]);
                u32x4 vw; vw.x = pk2(vf[0], vf[1]); vw.y = pk2(vf[2], vf[3]); vw.z = pk2(vf[4], vf[5]); vw.w = pk2(vf[6], vf[7]);
                *(LAS u32x4*)(Ks2 + kidx * KS_LD + part * 8) = kw; *(LAS u32x4*)(Vt2 + kidx * KS_LD + part * 8) = vw; }
            __syncthreads();
#pragma unroll
            for (int i = 0; i < 4; ++i) { const int r0 = qh * 64 + i * 16;
                bf16_t* qp = U + (size_t)(b * SEQ + qblk * 128 + r0 + c16) * INW + hq * 64;
                attn_tile(Ks, Vt, qp, qf[i][0], qf[i][1], r0 >> 4, r0 + c16, qblk == 0 ? 128 : 0, sink, lane); }
            if (w == sw) attn_tile(Ks2, Vt2, qp2, q2a, q2b, 0, ts, 0, sinks[hq2], lane);
        }
    }
    SEAM(2); STAMP(3);
    if (IN(3)) {
        const float* state_ssm = kin(5); const float* a_log = kin(12); const float* d_skip = kin(13);
        for (int ord = 0; ord < 2; ++ord) {
        if (((ord ^ bx) & 1) == 0) {
            LAS bf16_t* Bt = (LAS bf16_t*)lds;
            LAS bf16_t* Xs = (LAS bf16_t*)(lds + 18432);
            LAS float* scl = (LAS float*)(lds + 18432 + 73728);
            for (int unit = bx; unit < 256; unit += G) {
                LOCAL_IDS const int b = unit >> 5, c = (unit >> 1) & 15, g = unit & 1, row0 = b * SEQ + c * 128, h = 8 * g + w;
                __syncthreads();
                { const float A = -__expf(a_log[h]);
                  const float d0 = DT[(size_t)(row0 + lane) * 16 + h], d1 = DT[(size_t)(row0 + 64 + lane) * 16 + h];
                  float v0 = d0 * A, v1 = d1 * A;
#pragma unroll
                  for (int o = 1; o < 64; o <<= 1) { const float t0 = __builtin_bit_cast(float, __builtin_amdgcn_ds_bpermute((lane - o) << 2, __builtin_bit_cast(int, v0))), t1 = __builtin_bit_cast(float, __builtin_amdgcn_ds_bpermute((lane - o) << 2, __builtin_bit_cast(int, v1))); if (lane >= o) { v0 += t0; v1 += t1; } }
                  v1 += __builtin_bit_cast(float, __builtin_amdgcn_readlane(__builtin_bit_cast(int, v0), 63)); const float last = __builtin_bit_cast(float, __builtin_amdgcn_readlane(__builtin_bit_cast(int, v1), 63));
                  scl[w * 128 + lane] = d0 * __expf(last - v0); scl[w * 128 + 64 + lane] = d1 * __expf(last - v1);
                  if (lane == 0) CD[(b * 16 + c) * 16 + h] = __expf(last); }
                f32x4 acc[8][4];
#pragma unroll
                for (int nt = 0; nt < 8; ++nt)
#pragma unroll
                    for (int pt = 0; pt < 4; ++pt) acc[nt][pt] = (f32x4){0.f, 0.f, 0.f, 0.f};
                for (int half = 0; half < 2; ++half) {
                    __syncthreads();
#pragma unroll 2
                    for (int pc = tid; pc < 1024; pc += 512) { const int lr = pc >> 4, part = pc & 15;
                        *(LAS u32x4*)(Bt + lr * 136 + part * 8) = *(const u32x4*)(XC + (size_t)(row0 + half * 64 + lr) * CONVD + 1024 + g * 128 + part * 8); }
#pragma unroll 1
                    for (int pc0 = tid; pc0 < 4096; pc0 += 2048) { u32x4 vv[4];
#pragma unroll
                        for (int k = 0; k < 4; ++k) { const int pc = pc0 + 512 * k, lr = pc >> 6, part = pc & 63; vv[k] = *(const u32x4*)(XC + (size_t)(row0 + half * 64 + lr) * CONVD + g * 512 + part * 8); }
#pragma unroll
                        for (int k = 0; k < 4; ++k) { const int pc = pc0 + 512 * k, lr = pc >> 6, part = pc & 63, hh = part >> 3; const u32x4 v = vv[k];
                            const float sc = scl[hh * 128 + half * 64 + lr];
                            u32x4 o; o.x = pk2(bflo(v.x) * sc, bfhi(v.x) * sc); o.y = pk2(bflo(v.y) * sc, bfhi(v.y) * sc); o.z = pk2(bflo(v.z) * sc, bfhi(v.z) * sc); o.w = pk2(bflo(v.w) * sc, bfhi(v.w) * sc);
                            *(LAS u32x4*)(Xs + (hh * 64 + lr) * 72 + (part & 7) * 8) = o; } }
                    __syncthreads();
                    const unsigned baddr = LDSADDR(Bt) + (unsigned)(((quad * 8 + (c16 >> 2)) * 136 + 4 * (c16 & 3)) * 2);
                    const unsigned xaddr = LDSADDR(Xs) + (unsigned)(((w * 64 + quad * 8 + (c16 >> 2)) * 72 + 4 * (c16 & 3)) * 2);
#pragma unroll
                    for (int ks = 0; ks < 2; ++ks) { bf16x8 xf[4]; tr_frag4<0, 32, 64, 96, 4 * 144>(xaddr + ks * (32 * 144), xf);
#pragma unroll
                        for (int nh = 0; nh < 2; ++nh) { bf16x8 bfr[4]; tr_frag4<0, 32, 64, 96, 4 * 272>(baddr + ks * (32 * 272) + nh * 128, bfr);
#pragma unroll
                            for (int n4 = 0; n4 < 4; ++n4)
#pragma unroll
                                for (int pt = 0; pt < 4; ++pt) acc[nh * 4 + n4][pt] = MFMA16(bfr[n4], xf[pt], acc[nh * 4 + n4][pt]); } }
                }
                bf16_t* sp = STB + ((size_t)((b * 16 + c) * 16 + h) * 64) * 128;
#pragma unroll
                for (int nt = 0; nt < 8; ++nt)
#pragma unroll
                    for (int pt = 0; pt < 4; ++pt) { u32x2 o; o.x = pk2(acc[nt][pt][0], acc[nt][pt][1]); o.y = pk2(acc[nt][pt][2], acc[nt][pt][3]); *(u32x2*)(sp + (size_t)(pt * 16 + c16) * 128 + nt * 16 + quad * 4) = o; }
            }
        }
        else {
            LAS float* xr = (LAS float*)lds;
            LAS float* xdt = (LAS float*)(lds + 8192);
            LAS float* vals = (LAS float*)(lds + 16384);
            LAS float* rs = (LAS float*)(lds + 24576);
            for (int unit = bx; unit < 256; unit += G) {
                LOCAL_IDS const int b = unit >> 1, g = unit & 1, h = 8 * g + w, R0 = MP + b * 4;
                __syncthreads();
                const float A = -__expf(a_log[h]); float dtv[4], dA[4];
#pragma unroll
                for (int t = 0; t < 4; ++t) { dtv[t] = DT[(size_t)(R0 + t) * 16 + h]; dA[t] = __expf(dtv[t] * A); }
                { const int t = quad, p0 = c16 * 4; const u32x2 v = *(const u32x2*)(XC + (size_t)(R0 + t) * CONVD + h * 64 + p0);
                  const float dtt = t == 0 ? dtv[0] : (t == 1 ? dtv[1] : (t == 2 ? dtv[2] : dtv[3]));
                  const float f0 = bflo(v.x), f1 = bfhi(v.x), f2 = bflo(v.y), f3 = bfhi(v.y);
                  LAS float* p = xr + (w * 4 + t) * 64 + p0; p[0] = f0; p[1] = f1; p[2] = f2; p[3] = f3;
                  LAS float* q = xdt + (w * 4 + t) * 64 + p0; q[0] = f0 * dtt; q[1] = f1 * dtt; q[2] = f2 * dtt; q[3] = f3 * dtt; }
                float Bv[4][8], Cv[4][8];
#pragma unroll
                for (int t = 0; t < 4; ++t) { const bf16_t* rp = XC + (size_t)(R0 + t) * CONVD + 1024 + g * 128 + c16 * 4;
                    const u32x2 b0 = *(const u32x2*)rp, b1 = *(const u32x2*)(rp + 64), c0 = *(const u32x2*)(rp + 256), c1 = *(const u32x2*)(rp + 320);
                    Bv[t][0] = bflo(b0.x); Bv[t][1] = bfhi(b0.x); Bv[t][2] = bflo(b0.y); Bv[t][3] = bfhi(b0.y); Bv[t][4] = bflo(b1.x); Bv[t][5] = bfhi(b1.x); Bv[t][6] = bflo(b1.y); Bv[t][7] = bfhi(b1.y);
                    Cv[t][0] = bflo(c0.x); Cv[t][1] = bfhi(c0.x); Cv[t][2] = bflo(c0.y); Cv[t][3] = bfhi(c0.y); Cv[t][4] = bflo(c1.x); Cv[t][5] = bfhi(c1.x); Cv[t][6] = bflo(c1.y); Cv[t][7] = bfhi(c1.y); }
                const float Dh = d_skip[h];
                LDS_WAIT();
                const float* sin_ = state_ssm + (size_t)(b * 16 + h) * 8192; float* sout = out + O_SS + (size_t)(b * 16 + h) * 8192;
#pragma unroll 1
                for (int i0 = 0; i0 < 16; i0 += 4) { f32x4 H0[4], H1[4];
#pragma unroll
                  for (int ii = 0; ii < 4; ++ii) { const int p = 4 * (i0 + ii) + quad; H0[ii] = __builtin_nontemporal_load((const f32x4*)(sin_ + p * 128 + c16 * 4)); H1[ii] = __builtin_nontemporal_load((const f32x4*)(sin_ + p * 128 + 64 + c16 * 4)); }
#pragma unroll
                  for (int ii = 0; ii < 4; ++ii) { const int p = 4 * (i0 + ii) + quad;
                    f32x4 h0 = H0[ii], h1 = H1[ii];
                    float yk = 0.f;
#pragma unroll
                    for (int t = 0; t < 4; ++t) { const float xd = xdt[(w * 4 + t) * 64 + p]; float y = 0.f;
#pragma unroll
                        for (int k = 0; k < 4; ++k) { h0[k] = h0[k] * dA[t] + xd * Bv[t][k]; y += h0[k] * Cv[t][k]; h1[k] = h1[k] * dA[t] + xd * Bv[t][4 + k]; y += h1[k] * Cv[t][4 + k]; }
                        y = row16_sum(y);
                        if (c16 == t) yk = y + Dh * xr[(w * 4 + t) * 64 + p]; }
                    __builtin_nontemporal_store(h0, (f32x4*)(sout + p * 128 + c16 * 4)); __builtin_nontemporal_store(h1, (f32x4*)(sout + p * 128 + 64 + c16 * 4));
                    if (c16 < 4) { const float z = bf1(U[(size_t)(R0 + c16) * INW + OZ + h * 64 + p]); vals[(w * 4 + c16) * 64 + p] = yk * siluf_(z); } } }
                __syncthreads();
                if (w < 4) { float s = 0.f;
#pragma unroll
                    for (int hh = 0; hh < 8; ++hh) { const float v = vals[(hh * 4 + w) * 64 + lane]; s += v * v; }
                    s = wave_sum(s); if (lane == 0) rs[w] = rsqrtf(s * (1.f / 512.f) + EPS); }
                __syncthreads();
                { const int t = tid >> 7, ch4 = (tid & 127) * 4, hh = ch4 >> 6, p = ch4 & 63; const float r = rs[t]; const LAS float* vp = vals + (hh * 4 + t) * 64 + p;
                  u32x2 o; o.x = pk2(vp[0] * r, vp[1] * r); o.y = pk2(vp[2] * r, vp[3] * r);
                  *(u32x2*)(U + (size_t)(R0 + t) * INW + OZ + g * 512 + ch4) = o; }
            }
        }
        }
    }
    SEAM(3); STAMP(4);
    if (IN(4)) {
        LOCAL_IDS const int gtid = bx * 512 + tid;
        for (int idx = gtid; idx < 131072; idx += NGT) { const int n8 = idx & 15, p = (idx >> 4) & 63, h = (idx >> 10) & 15, b = idx >> 14;
            float hc[8];
#pragma unroll
            for (int k = 0; k < 8; ++k) hc[k] = 0.f;
            bf16_t* ptr0 = STB + ((size_t)(b * 16 * 16 + h) * 64 + p) * 128 + n8 * 8; u32x4 svv[16]; float dd[16];
#pragma unroll
            for (int c = 0; c < 16; ++c) { svv[c] = __builtin_nontemporal_load((const u32x4*)(ptr0 + (size_t)c * (16 * 8192))); dd[c] = CD[(b * 16 + c) * 16 + h]; }
#pragma unroll
            for (int c = 0; c < 16; ++c) { const u32x4 sv = svv[c];
                u32x4 o; o.x = pk2(hc[0], hc[1]); o.y = pk2(hc[2], hc[3]); o.z = pk2(hc[4], hc[5]); o.w = pk2(hc[6], hc[7]); *(u32x4*)(ptr0 + (size_t)c * (16 * 8192)) = o;
                const float d = dd[c];
                hc[0] = hc[0] * d + bflo(sv.x); hc[1] = hc[1] * d + bfhi(sv.x); hc[2] = hc[2] * d + bflo(sv.y); hc[3] = hc[3] * d + bfhi(sv.y);
                hc[4] = hc[4] * d + bflo(sv.z); hc[5] = hc[5] * d + bfhi(sv.z); hc[6] = hc[6] * d + bflo(sv.w); hc[7] = hc[7] * d + bfhi(sv.w); }
            float* op = out + O_SP + ((size_t)(b * 16 + h) * 64 + p) * 128 + n8 * 8;
            __builtin_nontemporal_store((f32x4){hc[0], hc[1], hc[2], hc[3]}, (f32x4*)op); __builtin_nontemporal_store((f32x4){hc[4], hc[5], hc[6], hc[7]}, (f32x4*)(op + 4)); }
    }
    SEAM(4); STAMP(5);
    if (IN(5)) {
        const float* a_log = kin(12); const float* d_skip = kin(13);
        LAS bf16_t* Cs = (LAS bf16_t*)lds; LAS bf16_t* Bs = (LAS bf16_t*)(lds + 34816); LAS bf16_t* CBs = (LAS bf16_t*)(lds + 69632);
        LAS bf16_t* Xt = (LAS bf16_t*)(lds + 104448 + w * 5120);
        LAS float* acs = (LAS float*)(lds + 145408); LAS float* dts = (LAS float*)(lds + 149504); LAS float* ssq = (LAS float*)(lds + 153600);
        for (int unit = bx; unit < 256; unit += G) {
            LOCAL_IDS const int b = unit >> 5, c = (unit >> 1) & 15, g = unit & 1, row0 = b * SEQ + c * 128, h = 8 * g + w;
            __syncthreads();
            { const float A = -__expf(a_log[h]);
              const float d0 = DT[(size_t)(row0 + lane) * 16 + h], d1 = DT[(size_t)(row0 + 64 + lane) * 16 + h];
              float v0 = d0 * A, v1 = d1 * A;
#pragma unroll
              for (int o = 1; o < 64; o <<= 1) { const float t0 = __builtin_bit_cast(float, __builtin_amdgcn_ds_bpermute((lane - o) << 2, __builtin_bit_cast(int, v0))), t1 = __builtin_bit_cast(float, __builtin_amdgcn_ds_bpermute((lane - o) << 2, __builtin_bit_cast(int, v1))); if (lane >= o) { v0 += t0; v1 += t1; } }
              v1 += __builtin_bit_cast(float, __builtin_amdgcn_readlane(__builtin_bit_cast(int, v0), 63));
              acs[w * 128 + lane] = v0; acs[w * 128 + 64 + lane] = v1; dts[w * 128 + lane] = d0; dts[w * 128 + 64 + lane] = d1; }
#pragma unroll 4
            for (int pc = tid; pc < 2048; pc += 512) { const int lr = pc >> 4, part = pc & 15; const bf16_t* rp = XC + (size_t)(row0 + lr) * CONVD + 1024 + g * 128 + part * 8;
                *(LAS u32x4*)(Bs + lr * 136 + part * 8) = __builtin_nontemporal_load((const u32x4*)rp); *(LAS u32x4*)(Cs + lr * 136 + part * 8) = __builtin_nontemporal_load((const u32x4*)(rp + 256)); }
            __syncthreads();
            {
                bf16x8 bfr[4];
#pragma unroll
                for (int ks = 0; ks < 4; ++ks) bfr[ks] = *(const LAS bf16x8*)(Bs + (16 * w + c16) * 136 + ks * 32 + quad * 8);
#pragma unroll
                for (int lt = 0; lt < 8; ++lt) { f32x4 d = (f32x4){0.f, 0.f, 0.f, 0.f};
#pragma unroll
                    for (int ks = 0; ks < 4; ++ks) { const bf16x8 cfr = *(const LAS bf16x8*)(Cs + (lt * 16 + c16) * 136 + ks * 32 + quad * 8); d = MFMA16(bfr[ks], cfr, d); }
                    u32x2 o; o.x = pk2(d[0], d[1]); o.y = pk2(d[2], d[3]); *(LAS u32x2*)(CBs + (lt * 16 + c16) * 136 + 16 * w + quad * 4) = o; }
            }
            __syncthreads();
            f32x4 acc[4][8];
#pragma unroll
            for (int pt = 0; pt < 4; ++pt)
#pragma unroll
                for (int lt = 0; lt < 8; ++lt) acc[pt][lt] = (f32x4){0.f, 0.f, 0.f, 0.f};
            const bf16_t* Hp = STB + (size_t)((b * 16 + c) * 16 + h) * 8192;
#pragma unroll
            for (int kh = 0; kh < 2; ++kh) { bf16x8 hf[2][4];
#pragma unroll
              for (int k2 = 0; k2 < 2; ++k2)
#pragma unroll
                for (int pt = 0; pt < 4; ++pt) hf[k2][pt] = __builtin_nontemporal_load((const bf16x8*)(Hp + (pt * 16 + c16) * 128 + (kh * 2 + k2) * 32 + quad * 8));
#pragma unroll
              for (int k2 = 0; k2 < 2; ++k2) {
#pragma unroll
                for (int lt = 0; lt < 8; ++lt) { const bf16x8 cfr = *(const LAS bf16x8*)(Cs + (lt * 16 + c16) * 136 + (kh * 2 + k2) * 32 + quad * 8);
#pragma unroll
                    for (int pt = 0; pt < 4; ++pt) acc[pt][lt] = MFMA16(hf[k2][pt], cfr, acc[pt][lt]); }
                asm volatile("" ::: "memory"); } }
#pragma unroll
            for (int lt = 0; lt < 8; ++lt) { const float e = __expf(acs[w * 128 + lt * 16 + c16]);
#pragma unroll
                for (int pt = 0; pt < 4; ++pt) acc[pt][lt] = acc[pt][lt] * e; }
            __builtin_amdgcn_sched_barrier(0);
            u32x4 xq[4][4];
#pragma unroll
            for (int k = 0; k < 4; ++k) { const int pc = lane + 64 * k, sr = pc >> 3, part = pc & 7; xq[0][k] = __builtin_nontemporal_load((const u32x4*)(XC + (size_t)(row0 + sr) * CONVD + h * 64 + part * 8)); }
#pragma unroll
            for (int sq = 0; sq < 4; ++sq) {
                asm volatile("s_waitcnt lgkmcnt(0)" ::: "memory");
#pragma unroll
                for (int k = 0; k < 4; ++k) { const int pc = lane + 64 * k, sr = pc >> 3, part = pc & 7; *(LAS u32x4*)(Xt + sr * 72 + part * 8) = xq[sq][k]; }
                if (sq < 3) {
#pragma unroll
                    for (int k = 0; k < 4; ++k) { const int pc = lane + 64 * k, sr = pc >> 3, part = pc & 7; xq[sq + 1][k] = __builtin_nontemporal_load((const u32x4*)(XC + (size_t)(row0 + (sq + 1) * 32 + sr) * CONVD + h * 64 + part * 8)); } }
                asm volatile("s_waitcnt lgkmcnt(0)" ::: "memory");
                bf16x8 xf[4]; tr_frag4<0, 32, 64, 96, 4 * 144>(LDSADDR(Xt) + (unsigned)(((quad * 8 + (c16 >> 2)) * 72 + 4 * (c16 & 3)) * 2), xf);
                const f32x4 as0 = *(const LAS f32x4*)(acs + w * 128 + sq * 32 + quad * 8), as1 = *(const LAS f32x4*)(acs + w * 128 + sq * 32 + quad * 8 + 4);
                const f32x4 ds0 = *(const LAS f32x4*)(dts + w * 128 + sq * 32 + quad * 8), ds1 = *(const LAS f32x4*)(dts + w * 128 + sq * 32 + quad * 8 + 4);
#pragma unroll
                for (int lt = 0; lt < 8; ++lt) { if (lt >= 2 * sq) {
                    const int l = lt * 16 + c16; const float al = acs[w * 128 + l];
                    const u32x4 cb = *(const LAS u32x4*)(CBs + l * 136 + sq * 32 + quad * 8);
                    const int s0 = sq * 32 + quad * 8;
                    float wv[8];
                    wv[0] = bflo(cb.x); wv[1] = bfhi(cb.x); wv[2] = bflo(cb.y); wv[3] = bfhi(cb.y); wv[4] = bflo(cb.z); wv[5] = bfhi(cb.z); wv[6] = bflo(cb.w); wv[7] = bfhi(cb.w);
#pragma unroll
                    for (int i = 0; i < 4; ++i) { wv[i] = (s0 + i <= l) ? wv[i] * __expf(fminf(al - as0[i], 0.f)) * ds0[i] : 0.f; wv[4 + i] = (s0 + 4 + i <= l) ? wv[4 + i] * __expf(fminf(al - as1[i], 0.f)) * ds1[i] : 0.f; }
                    u32x4 ww; ww.x = pk2(wv[0], wv[1]); ww.y = pk2(wv[2], wv[3]); ww.z = pk2(wv[4], wv[5]); ww.w = pk2(wv[6], wv[7]);
                    const bf16x8 wf = __builtin_bit_cast(bf16x8, ww);
#pragma unroll
                    for (int pt = 0; pt < 4; ++pt) acc[pt][lt] = MFMA16(xf[pt], wf, acc[pt][lt]);
                    asm volatile("" ::: "memory"); } }
            }
            const float Dh = d_skip[h];
#pragma unroll
            for (int lt = 0; lt < 8; ++lt) { const int l = lt * 16 + c16; const size_t tok = (size_t)(row0 + l); float ss = 0.f;
#pragma unroll
                for (int pt = 0; pt < 4; ++pt) { const int pb = pt * 16 + quad * 4;
                    const u32x2 xv = *(const u32x2*)(XC + tok * CONVD + h * 64 + pb), zv = *(const u32x2*)(U + tok * INW + OZ + h * 64 + pb);
                    const float xf0 = bflo(xv.x), xf1 = bfhi(xv.x), xf2 = bflo(xv.y), xf3 = bfhi(xv.y);
                    const float z0 = bflo(zv.x), z1 = bfhi(zv.x), z2 = bflo(zv.y), z3 = bfhi(zv.y);
                    f32x4 v = acc[pt][lt];
                    v[0] = (v[0] + Dh * xf0) * siluf_(z0); v[1] = (v[1] + Dh * xf1) * siluf_(z1); v[2] = (v[2] + Dh * xf2) * siluf_(z2); v[3] = (v[3] + Dh * xf3) * siluf_(z3);
                    acc[pt][lt] = v; ss += (v[0] * v[0] + v[1] * v[1]) + (v[2] * v[2] + v[3] * v[3]); }
                ss += __shfl_xor(ss, 16); ss += __shfl_xor(ss, 32);
                if (quad == 0) ssq[w * 128 + l] = ss;
                if (lt & 1) asm volatile("" ::: "memory"); }
            __syncthreads();
#pragma unroll
            for (int lt = 0; lt < 8; ++lt) { const int l = lt * 16 + c16; const size_t tok = (size_t)(row0 + l); float s = 0.f;
#pragma unroll
                for (int ww = 0; ww < 8; ++ww) s += ssq[ww * 128 + l];
                const float r = rsqrtf(s * (1.f / 512.f) + EPS);
#pragma unroll
                for (int pt = 0; pt < 4; ++pt) { const f32x4 v = acc[pt][lt] * r; u32x2 o; o.x = pk2(v[0], v[1]); o.y = pk2(v[2], v[3]);
                    *(u32x2*)(U + tok * INW + OZ + h * 64 + pt * 16 + quad * 4) = o; }
                asm volatile("" ::: "memory"); }
        }
    }
    SEAM(5); STAMP(6);
    if (IN(6)) {
        { pg8::Gemm g{U, WOA, M, DM, 1536, INW, 1536}; pg8::StaticOrder S; S.init(MP, DM, G, bx, 6, 2); EpiGate2 E{U, MERGED}; pg8::gemm_phase<EpiGate2, 256, 244 * MiB, -1, 8>(lds, g, S, E); }
    }
    SEAM(6); STAMP(7);
    if (IN(7)) {
        const float* x_p = kin(0);
        {
            LOCAL_IDS const float* pa = (const float*)(ws + 244 * MiB);
            for (int e4 = bx * 512 + tid; e4 < 512 * 256; e4 += NGT) { const int row = e4 >> 8, c4 = (e4 & 255) * 4;
                f32x4 sa = (f32x4){0.f, 0.f, 0.f, 0.f}, sb = (f32x4){0.f, 0.f, 0.f, 0.f};
#pragma unroll
                for (int sl = 0; sl < 6; ++sl) { const f32x4 v = *(const f32x4*)(pa + ((size_t)sl * 512 + row) * DM + c4); if (sl < 2) sa += v; else sb += v; }
                const bf16_t* up = U + (size_t)(MP + row) * INW; const u32x2 ga = *(const u32x2*)(up + OGA + c4), gb = *(const u32x2*)(up + OGB + c4);
                u32x2 o; o.x = pk2(sigmoidf_(bflo(ga.x)) * sa[0] + sigmoidf_(bflo(gb.x)) * sb[0], sigmoidf_(bfhi(ga.x)) * sa[1] + sigmoidf_(bfhi(gb.x)) * sb[1]);
                o.y = pk2(sigmoidf_(bflo(ga.y)) * sa[2] + sigmoidf_(bflo(gb.y)) * sb[2], sigmoidf_(bfhi(ga.y)) * sa[3] + sigmoidf_(bfhi(gb.y)) * sb[3]);
                st_wt8(MERGED + (size_t)(MP + row) * DM + c4, o.x, o.y); }
            SOFT_ARRIVE(0); }
        pg8::Gemm g{MERGED, WO, M, DM, DM, DM, DM}; pg8::StaticOrder S; S.init(MP, DM, G, bx, 4, 2);
        EpiRes<1> E{x_p, X1B, SSQ2}; pg8::gemm_phase<EpiRes<1>, 256, 244 * MiB, 0>(lds, g, S, E);
    }
    SEAM(7); STAMP(8);
    if (IN(8)) {
        {
            LOCAL_IDS const float* x_s = kin(1); const float* p4 = (const float*)(ws + 244 * MiB);
            for (int row = gw; row < 512; row += NGW) { float ss = 0.f;
#pragma unroll
                for (int j = 0; j < 4; ++j) { const int c = lane * 4 + 256 * j; f32x4 v = *(const f32x4*)(x_s + (size_t)row * DM + c);
#pragma unroll
                    for (int sl = 0; sl < 4; ++sl) v += *(const f32x4*)(p4 + ((size_t)sl * 512 + row) * DM + c);
                    st_wt8(X1B + (size_t)(MP + row) * DM + c, pk2(v[0], v[1]), pk2(v[2], v[3]));
                    ss += (v[0] * v[0] + v[1] * v[1]) + (v[2] * v[2] + v[3] * v[3]); }
                ss = wave_sum(ss); if (lane == 0) __hip_atomic_store(SSQ2 + MP + row, ss, __ATOMIC_RELAXED, __HIP_MEMORY_SCOPE_AGENT); }
            SOFT_ARRIVE(1); }
        pg8::Gemm g{X1B, WUP, M, DFF, DM, DM, DM}; pg8::StaticOrder S; S.init(MP, DFF, G, bx, 4, 2);
        EpiUp E{SSQ2, ACT}; pg8::gemm_phase<EpiUp, 256, WS_MERGED, 1, -1, true>(lds, g, S, E);
    }
    SEAM(8); STAMP(9);
    if (IN(9)) {
        {
            LOCAL_IDS const bf16_t* p5 = (const bf16_t*)(ws + WS_MERGED);
            for (int e4 = bx * 512 + tid; e4 < 512 * 1024; e4 += NGT) { const int row = e4 >> 10, c4 = (e4 & 1023) * 4;
                f32x4 v = (f32x4){0.f, 0.f, 0.f, 0.f};
#pragma unroll
                for (int sl = 0; sl < 4; ++sl) { const u32x2 pv = *(const u32x2*)(p5 + ((size_t)sl * 512 + row) * DFF + c4); v += (f32x4){bflo(pv.x), bfhi(pv.x), bflo(pv.y), bfhi(pv.y)}; }
                const float rs = rsqrtf(SSQ2[MP + row] * (1.f / DM) + EPS);
#pragma unroll
                for (int i = 0; i < 4; ++i) { const float t = fmaxf(v[i] * rs, 0.f); v[i] = t * t; }
                st_wt8(ACT + (size_t)(MP + row) * DFF + c4, pk2(v[0], v[1]), pk2(v[2], v[3])); }
            SOFT_ARRIVE(2); }
        pg8::Gemm g{ACT, WDN, M, DM, DFF, DFF, DFF}; pg8::StaticOrder S; S.init(MP, DM, G, bx, 16, 2);
        EpiRes<0> E{nullptr, X1B, nullptr}; pg8::gemm_phase<EpiRes<0>, 256, WS_MERGED, 2>(lds, g, S, E);
    }
    SEAM(9); STAMP(10);
    if (IN(10)) {
        const float* final_norm = kin(21);
        LOCAL_IDS
        const float* p6 = (const float*)(ws + WS_MERGED);
#pragma unroll 2
        for (int m = gw; m < M; m += NGW) { float* xr = X1 + (size_t)m * DM; f32x4 v[4]; float ss = 0.f;
#pragma unroll
            for (int j = 0; j < 4; ++j) { const int cidx = lane * 4 + 256 * j; const u32x2 pv = *(const u32x2*)(X1B + (size_t)m * DM + cidx); v[j] = (f32x4){bflo(pv.x), bfhi(pv.x), bflo(pv.y), bfhi(pv.y)};
                if (m >= MP) {
#pragma unroll
                    for (int sl = 0; sl < 16; ++sl) v[j] += *(const f32x4*)(p6 + ((size_t)sl * 512 + (m - MP)) * DM + cidx); }
                ss += (v[j][0] * v[j][0] + v[j][1] * v[j][1]) + (v[j][2] * v[j][2] + v[j][3] * v[j][3]); }
            const float r = rsqrtf(wave_sum(ss) * (1.f / DM) + EPS);
#pragma unroll
            for (int j = 0; j < 4; ++j) { const int cidx = lane * 4 + 256 * j; const f32x4 fw = *(const f32x4*)(final_norm + cidx); __builtin_nontemporal_store(v[j] * r * fw, (f32x4*)(xr + cidx)); } }
    }
#ifdef PROBE_A
    STAMP(11);
    if (bx == 0 && tid0 == 0) { asm volatile("s_waitcnt vmcnt(0)" ::: "memory"); const float us = (float)(tstamp[PROBE_B] - tstamp[PROBE_A]) * 0.01f; out[0] = out[0] + 16.f + us * (1.f / PROBE_SCALE); }
#endif
#undef IN
#undef SEAM
}

#ifndef N_LAUNCH_MODE
#define N_LAUNCH_MODE 1
#endif
extern "C" void kernel_launch(void* const* d_in, const int* in_sizes, int n_in, void* d_out, int out_size, void* d_ws, size_t ws_size, hipStream_t stream) {
    static int grid = 0;
    if (grid == 0) {
        int dev = 0, cus = 0, per_cu = 0;
        hipGetDevice(&dev); hipDeviceGetAttribute(&cus, hipDeviceAttributeMultiprocessorCount, dev);
        if (hipFuncSetAttribute((const void*)mega, hipFuncAttributeMaxDynamicSharedMemorySize, LDS_BYTES) != hipSuccess) { fprintf(stderr, "hipFuncSetAttribute failed\n"); }
        if (hipOccupancyMaxActiveBlocksPerMultiprocessor(&per_cu, (const void*)mega, 512, LDS_BYTES) != hipSuccess || per_cu < 1) { fprintf(stderr, "occupancy query: %d\n", per_cu); per_cu = 1; }
        (void)hipGetLastError();
        grid = cus * 1;
        if (grid <= 0) grid = 256;
    }
    (void)hipMemsetAsync((unsigned char*)d_ws + WS_BAR, 0, 1024 + XCD_BAR_WORDS * 4, stream);
    Args a{};
    for (int i = 0; i < 22; ++i) a.in[i] = (const float*)d_in[i];
    a.out = (float*)d_out; a.ws = (unsigned char*)d_ws;
#if N_LAUNCH_MODE == 1
    a.ph_lo = 0; a.ph_hi = 11;
    void* args[] = {&a};
    hipError_t e = hipLaunchCooperativeKernel((const void*)mega, dim3(grid), dim3(512), args, LDS_BYTES, stream);
    if (e != hipSuccess) fprintf(stderr, "cooperative launch failed: %s (grid %d)\n", hipGetErrorString(e), grid);
#else
    for (int p = 0; p < 11; ++p) { a.ph_lo = p; a.ph_hi = p + 1; hipLaunchKernelGGL(mega, dim3(grid), dim3(512), LDS_BYTES, stream, a); }
#endif
}
```

```cpp
#include <hip/hip_runtime.h>
#include <hip/hip_cooperative_groups.h>
#include <cstdio>
#include <cstdint>
namespace cg = cooperative_groups;

#define LAS __attribute__((address_space(3)))
typedef unsigned short bf16_t;
typedef short bf16x8 __attribute__((ext_vector_type(8)));
typedef float f32x4 __attribute__((ext_vector_type(4)));
typedef float f32x2 __attribute__((ext_vector_type(2)));
typedef unsigned u32x4 __attribute__((ext_vector_type(4)));
typedef unsigned u32x2 __attribute__((ext_vector_type(2)));

constexpr int DM = 1024, MP = 16384, MS = 512, M = MP + MS, SEQ = 2048, NBATCH = 8, DBATCH = 128;
constexpr int INW = 5392, NPAD = 5632, DFF = 4096, CONVD = 1536;
constexpr int OQ = 0, OZ = 512, OKK = 1536, OV = 1664, OX = 1792, ODT = 3328, OGA = 3344, OGB = 4368;
constexpr float EPS = 1e-6f;
constexpr size_t O_YP = 0, O_YS = 16777216, O_KP = 17301504, O_VP = 17432576, O_CP = 17563648, O_SP = 17600512,
                 O_KS = 18649088, O_VS = 20746240, O_CS = 22843392, O_SS = 23433216;
constexpr size_t MiB = 1u << 20;
constexpr size_t WS_RSTD1 = 0, WS_SSQ2 = 128 * 1024, WS_SSQF = 256 * 1024, WS_CD = 384 * 1024, WS_BAR = 512 * 1024, WS_XB = 512 * 1024 + 1024;
constexpr size_t WS_WIN = 1 * MiB, WS_WOA = 12 * MiB, WS_WOB = 13 * MiB, WS_WO = 15 * MiB, WS_DT = 17 * MiB;
constexpr size_t WS_U = 20 * MiB;
constexpr size_t WS_X1B = 20 * MiB, WS_ACT = 54 * MiB;
constexpr size_t WS_XC = 194 * MiB;
constexpr size_t WS_MERGED = 194 * MiB, WS_WUP = 227 * MiB, WS_WDN = 235 * MiB;
constexpr int LDS_BYTES = 163840;

__device__ __forceinline__ int opaque(int x) { asm volatile("" : "+v"(x)); return x; }
__device__ __forceinline__ unsigned f2bf(float f) { unsigned u = __builtin_bit_cast(unsigned, f); return (u + 0x7fffu + ((u >> 16) & 1u)) >> 16; }
typedef __bf16 bf16x2_t __attribute__((ext_vector_type(2)));
__device__ __forceinline__ unsigned pk2(float lo, float hi) { const f32x2 v = {lo, hi}; const bf16x2_t b = __builtin_convertvector(v, bf16x2_t); return __builtin_bit_cast(unsigned, b); }
__device__ __forceinline__ unsigned cvt_pk_bf16(float lo, float hi) { return pk2(lo, hi); }
__device__ __forceinline__ float bflo(unsigned w) { return __builtin_bit_cast(float, w << 16); }
__device__ __forceinline__ float bfhi(unsigned w) { return __builtin_bit_cast(float, w & 0xffff0000u); }
__device__ __forceinline__ float bf1(bf16_t h) { return __builtin_bit_cast(float, (unsigned)h << 16); }
__device__ __forceinline__ float sigmoidf_(float x) { return __builtin_amdgcn_rcpf(1.f + __expf(-x)); }
__device__ __forceinline__ float siluf_(float x) { return x * __builtin_amdgcn_rcpf(1.f + __expf(-x)); }
__device__ __forceinline__ void st_wt8(void* p, unsigned lo, unsigned hi) { __hip_atomic_store((unsigned long long*)p, ((unsigned long long)hi << 32) | lo, __ATOMIC_RELAXED, __HIP_MEMORY_SCOPE_AGENT); }
__device__ __forceinline__ float row16_sum(float v) {
    v += __builtin_bit_cast(float, __builtin_amdgcn_update_dpp(0, __builtin_bit_cast(int, v), 0xB1, 0xF, 0xF, true));
    v += __builtin_bit_cast(float, __builtin_amdgcn_update_dpp(0, __builtin_bit_cast(int, v), 0x4E, 0xF, 0xF, true));
    v += __builtin_bit_cast(float, __builtin_amdgcn_update_dpp(0, __builtin_bit_cast(int, v), 0x141, 0xF, 0xF, true));
    v += __builtin_bit_cast(float, __builtin_amdgcn_update_dpp(0, __builtin_bit_cast(int, v), 0x140, 0xF, 0xF, true));
    return v;
}
__device__ __forceinline__ float wave_sum(float v) { v = row16_sum(v); v += __shfl_xor(v, 16); v += __shfl_xor(v, 32); return v; }
#define LDS_WAIT() asm volatile("s_waitcnt lgkmcnt(0)" ::: "memory")
#define MFMA16(a, b, c) __builtin_amdgcn_mfma_f32_16x16x32_bf16(a, b, c, 0, 0, 0)

template <int O0, int O1, int O2, int O3, int D> __device__ __forceinline__ void tr_frag4(unsigned addr, bf16x8 (&f)[4]) {
    u32x2 a0, b0, a1, b1, a2, b2, a3, b3;
    asm volatile("ds_read_b64_tr_b16 %0, %8 offset:%9\n\tds_read_b64_tr_b16 %1, %8 offset:%10\n\tds_read_b64_tr_b16 %2, %8 offset:%11\n\tds_read_b64_tr_b16 %3, %8 offset:%12\n\t"
                 "ds_read_b64_tr_b16 %4, %8 offset:%13\n\tds_read_b64_tr_b16 %5, %8 offset:%14\n\tds_read_b64_tr_b16 %6, %8 offset:%15\n\tds_read_b64_tr_b16 %7, %8 offset:%16\n\ts_waitcnt lgkmcnt(0)"
                 : "=&v"(a0), "=&v"(b0), "=&v"(a1), "=&v"(b1), "=&v"(a2), "=&v"(b2), "=&v"(a3), "=&v"(b3)
                 : "v"(addr), "i"(O0), "i"(O0 + D), "i"(O1), "i"(O1 + D), "i"(O2), "i"(O2 + D), "i"(O3), "i"(O3 + D) : "memory");
    f[0] = __builtin_bit_cast(bf16x8, (u32x4){a0.x, a0.y, b0.x, b0.y}); f[1] = __builtin_bit_cast(bf16x8, (u32x4){a1.x, a1.y, b1.x, b1.y});
    f[2] = __builtin_bit_cast(bf16x8, (u32x4){a2.x, a2.y, b2.x, b2.y}); f[3] = __builtin_bit_cast(bf16x8, (u32x4){a3.x, a3.y, b3.x, b3.y});
}
#define LDSADDR(p) ((unsigned)(size_t)(p))

__device__ __forceinline__ const float* kin(int k) {
    const __attribute__((address_space(4))) unsigned char* ka = (const __attribute__((address_space(4))) unsigned char*)__builtin_amdgcn_kernarg_segment_ptr();
    asm volatile("" : "+s"(ka));
    return *(const float* const __attribute__((address_space(4)))*)(ka + 8 * k);
}
__device__ __forceinline__ unsigned char* kws() { return (unsigned char*)kin(23); }

namespace pg8 {
constexpr int BM = 256, BK = 64, HALF = 128, HTB = HALF * BK * 2, STAGE_BYTES = 8 * HTB, NXCD = 8, WGM = 8;
__host__ __device__ __forceinline__ int lds_byte(int r, int c) { const int st = (r >> 4) * 2 + (c >> 5), rr = r & 15, cc = c & 31, ob = rr * 64 + cc * 2; return st * 1024 + (ob ^ (((ob >> 9) & 1) << 5)); }
__host__ __device__ __forceinline__ void stage_rc(int b, int& R, int& C) { const int st = b / 1024, sb = b % 1024, swz = sb ^ (((sb >> 9) & 1) << 5); R = (st >> 1) * 16 + swz / 64; C = (st & 1) * 32 + (swz % 64) / 2; }
__host__ __device__ __forceinline__ int perm32(int rho) { const int n = rho >> 4, i = rho & 15; return 8 * (i >> 2) + 4 * n + (i & 3); }
struct Unit { int pm, pn, ks, split; };
struct Gemm { const bf16_t* A; const bf16_t* Bt; int M, N, K, lda, ldb; };
struct StaticOrder {
    int nM, nN, nwg, G, c, S, Q;
    __device__ __forceinline__ void init(int M_, int N_, int G_, int c_, int S_ = 1, int sample_mtiles = 0) { nM = M_ / BM; nN = N_ / BM; nwg = nM * nN; G = G_; c = c_; S = S_; Q = sample_mtiles * nN * S_; }
    __device__ __forceinline__ bool next(int i, Unit& u) const {
        const long L = (long)i * G + c; const bool isS = L >= nwg; const int q = isS ? (int)(L - nwg) : 0;
        if (isS && q >= Q) return false;
        int wgid = isS ? 0 : (int)L; { const int qq = nwg / NXCD, r = nwg % NXCD, xcd = wgid % NXCD, off = wgid / NXCD; wgid = (xcd < r ? xcd * (qq + 1) : r * (qq + 1) + (xcd - r) * qq) + off; }
        const int nig = WGM * nN, gid = wgid / nig, fm = gid * WGM, gsz = (nM - fm) < WGM ? (nM - fm) : WGM;
        const int pmF = fm + ((wgid % nig) % gsz), pnF = (wgid % nig) / gsz;
        const int tile = q / S;
        u.pm = isS ? nM + tile / nN : pmF; u.pn = isS ? tile % nN : pnF; u.ks = isS ? q - tile * S : 0; u.split = isS ? 1 : 0;
        return true;
    }
};
template <class Epi, int KSL = 128, size_t PART_OFF = 0, int SOFT_IDX = -1, int MID_T = -1, bool PART_BF16 = false>
__device__ __forceinline__ void gemm_phase(LAS unsigned char* lds, const Gemm g, const StaticOrder& S, const Epi& E) {
    const int tid = opaque((int)threadIdx.x), wid = __builtin_amdgcn_readfirstlane(tid >> 6), lane = tid & 63, wr = wid >> 2, wc = wid & 3, fr = lane & 15, fq = lane >> 4;
    const int ntF = g.K / BK; constexpr int ntS = KSL / BK; constexpr size_t ksbytes = (size_t)KSL * 2;
    unsigned voffA[2], voffB[2];
#pragma unroll
    for (int i = 0; i < 2; ++i) { int R, C; stage_rc(tid * 16 + i * 8192, R, C); const int Rb = (R & ~31) + perm32(R & 31);
        voffA[i] = (unsigned)(R * g.lda + C) * 2u; voffB[i] = (unsigned)(Rb * g.ldb + C) * 2u; }
    const size_t kstep = (size_t)(BK * 2);
    const size_t hstepA = (size_t)HALF * g.lda * 2, hstepB = (size_t)HALF * g.ldb * 2;
    const size_t tstepA = 2 * hstepA, tstepB = 2 * hstepB;
    const unsigned ldsw = (unsigned)wid * 1024u;
    const int aoff = lds_byte(wr * 64 + fr, fq * 8), boff = lds_byte(wc * 32 + fr, fq * 8);
#define PG8_SA(b, h) (((b) * 2 + (h)) * HTB)
#define PG8_SB(b, h) ((4 + (b) * 2 + (h)) * HTB)
#define PG8_STAGE(bufoff, gbase, voff) do { _Pragma("unroll") for (int _i = 0; _i < 2; ++_i) \
        __builtin_amdgcn_global_load_lds((const unsigned*)((const char*)(gbase) + (voff)[_i]), (LAS unsigned*)(lds + (bufoff) + ldsw + _i * 8192), 16, 0, 0); } while (0)
#define PG8_LDA(dst, b, h) do { _Pragma("unroll") for (int m = 0; m < 4; ++m) _Pragma("unroll") for (int k = 0; k < 2; ++k) dst[m][k] = *(const LAS bf16x8*)(lds + PG8_SA(b, h) + aoff + m * 2048 + k * 1024); } while (0)
#define PG8_LDB(dst, b, h) do { _Pragma("unroll") for (int n = 0; n < 2; ++n) _Pragma("unroll") for (int k = 0; k < 2; ++k) dst[n][k] = *(const LAS bf16x8*)(lds + PG8_SB(b, h) + boff + n * 2048 + k * 1024); } while (0)
#define PG8_MMA(ai, bj, At, Bt) do { __builtin_amdgcn_s_setprio(1); _Pragma("unroll") for (int m = 0; m < 4; ++m) _Pragma("unroll") for (int n = 0; n < 2; ++n) _Pragma("unroll") for (int k = 0; k < 2; ++k) \
        acc[ai][bj][m][n] = __builtin_amdgcn_mfma_f32_16x16x32_bf16(Bt[n][k], At[m][k], acc[ai][bj][m][n], 0, 0, 0); __builtin_amdgcn_s_setprio(0); } while (0)
#define PG8_WAIT_V(n) asm volatile("s_waitcnt vmcnt(" #n ")" ::: "memory")
#define PG8_WAIT_L(n) asm volatile("s_waitcnt lgkmcnt(" #n ")" ::: "memory")
#define PG8_BAR __builtin_amdgcn_s_barrier()
#define PG8_SCHED __builtin_amdgcn_sched_barrier(0)
    Unit cur, nxt; int ui = 0;
    if (!S.next(0, cur)) return;
    float pre[8];
#pragma unroll
    for (int e = 0; e < 8; ++e) pre[e] = 0.f;
    f32x4 acc[2][2][4][2];
#pragma unroll
    for (int a = 0; a < 2; ++a)
#pragma unroll
        for (int b = 0; b < 2; ++b)
#pragma unroll
            for (int m = 0; m < 4; ++m)
#pragma unroll
                for (int n = 0; n < 2; ++n) acc[a][b][m][n] = (f32x4){0.f, 0.f, 0.f, 0.f};
    bf16x8 At[4][2], B0[2][2], B1[2][2];
    const char* cA = (const char*)g.A + (size_t)cur.pm * tstepA + (cur.split ? cur.ks * ksbytes : 0); const char* cB = (const char*)g.Bt + (size_t)cur.pn * tstepB + (cur.split ? cur.ks * ksbytes : 0);
    PG8_STAGE(PG8_SB(0, 0), cB, voffB); PG8_STAGE(PG8_SB(0, 1), cB + hstepB, voffB); PG8_STAGE(PG8_SA(0, 0), cA, voffA); PG8_STAGE(PG8_SA(0, 1), cA + hstepA, voffA);
    if (wr == 1) PG8_BAR;
    PG8_WAIT_V(2); PG8_BAR;
    PG8_STAGE(PG8_SB(1, 0), cB + kstep, voffB); PG8_STAGE(PG8_SA(1, 0), cA + kstep, voffA); PG8_STAGE(PG8_SB(1, 1), cB + hstepB + kstep, voffB);
    PG8_WAIT_V(6); PG8_BAR;
    for (;;) {
        const bool has_next = S.next(ui + 1, nxt);
        const char* nA = has_next ? (const char*)g.A + (size_t)nxt.pm * tstepA + (nxt.split ? nxt.ks * ksbytes : 0) : cA; const char* nB = has_next ? (const char*)g.Bt + (size_t)nxt.pn * tstepB + (nxt.split ? nxt.ks * ksbytes : 0) : cB;
        const int nt = cur.split ? ntS : ntF;
        if (SOFT_IDX >= 0 && has_next && nxt.split && !cur.split) {
            if (tid == 0) { unsigned* sw = (unsigned*)(kws() + WS_BAR) + 64 + SOFT_IDX; unsigned sp = 0;
                while (__hip_atomic_load(sw, __ATOMIC_RELAXED, __HIP_MEMORY_SCOPE_AGENT) < (unsigned)gridDim.x) { __builtin_amdgcn_s_sleep(2); if (++sp > (1u << 22)) break; }
                __builtin_amdgcn_fence(__ATOMIC_ACQUIRE, "agent"); }
            PG8_BAR; }
        for (int t = 0; t < nt; t += 2) {
            const bool last = (t == nt - 2);
            if (MID_T >= 0 && t == MID_T && !cur.split) { PG8_SCHED; E.mid(acc, cur, wr, wc, fr, fq); PG8_SCHED; }
            if (last && !cur.split) E.prefetch(pre, cur, wr, fr);
            const char* a1 = cA + (size_t)(t + 1) * kstep;
            const char* a2 = last ? nA : cA + (size_t)(t + 2) * kstep; const char* b2 = last ? nB : cB + (size_t)(t + 2) * kstep;
            const char* a3 = a2 + kstep; const char* b3 = b2 + kstep;
            PG8_LDB(B0, 0, 0); PG8_LDB(B1, 0, 1); PG8_SCHED; PG8_LDA(At, 0, 0); PG8_STAGE(PG8_SA(1, 1), a1 + hstepA, voffA);
            PG8_WAIT_V(8); PG8_WAIT_L(0); PG8_BAR; PG8_MMA(0, 0, At, B0); PG8_MMA(0, 1, At, B1); PG8_BAR; PG8_SCHED;
            PG8_LDA(At, 0, 1); PG8_STAGE(PG8_SB(0, 0), b2, voffB); PG8_STAGE(PG8_SB(0, 1), b2 + hstepB, voffB); PG8_STAGE(PG8_SA(0, 0), a2, voffA);
            PG8_WAIT_V(8); PG8_WAIT_L(0); PG8_BAR; PG8_MMA(1, 0, At, B0); PG8_MMA(1, 1, At, B1); PG8_BAR; PG8_SCHED;
            PG8_LDB(B0, 1, 0); PG8_LDB(B1, 1, 1); PG8_SCHED; PG8_LDA(At, 1, 0); PG8_STAGE(PG8_SA(0, 1), a2 + hstepA, voffA);
            PG8_WAIT_V(8); PG8_WAIT_L(0); PG8_BAR; PG8_MMA(0, 0, At, B0); PG8_MMA(0, 1, At, B1); PG8_BAR; PG8_SCHED;
            PG8_LDA(At, 1, 1); PG8_STAGE(PG8_SB(1, 0), b3, voffB); PG8_STAGE(PG8_SB(1, 1), b3 + hstepB, voffB); PG8_STAGE(PG8_SA(1, 0), a3, voffA);
            PG8_WAIT_V(8); PG8_WAIT_L(0); PG8_BAR; PG8_MMA(1, 0, At, B0); PG8_MMA(1, 1, At, B1); PG8_BAR; PG8_SCHED;
        }
        if (wr == 0) PG8_BAR;
        if (cur.split) {
            const size_t pidx = ((size_t)cur.ks * 512 + (cur.pm - S.nM) * 256 + wr * 64 + fr) * g.N + cur.pn * 256 + wc * 32 + 8 * fq;
            if (PART_BF16) {
                bf16_t* pp = (bf16_t*)(kws() + PART_OFF) + pidx;
#pragma unroll
                for (int a = 0; a < 2; ++a)
#pragma unroll
                    for (int m = 0; m < 4; ++m)
#pragma unroll
                        for (int b = 0; b < 2; ++b) { const f32x4 v0 = acc[a][b][m][0], v1 = acc[a][b][m][1]; u32x4 w; w.x = pk2(v0[0], v0[1]); w.y = pk2(v0[2], v0[3]); w.z = pk2(v1[0], v1[1]); w.w = pk2(v1[2], v1[3]);
                            *(u32x4*)(pp + (size_t)(a * 128 + m * 16) * g.N + b * 128) = w; }
            } else {
            float* pp = (float*)(kws() + PART_OFF) + pidx;
#pragma unroll
            for (int a = 0; a < 2; ++a)
#pragma unroll
                for (int m = 0; m < 4; ++m)
#pragma unroll
                    for (int b = 0; b < 2; ++b) { float* q = pp + (size_t)(a * 128 + m * 16) * g.N + b * 128; *(f32x4*)q = acc[a][b][m][0]; *(f32x4*)(q + 4) = acc[a][b][m][1]; }
            }
        } else E(acc, cur, wr, wc, fr, fq, 0, 8, pre);
        if (!has_next) break;
#pragma unroll
        for (int a = 0; a < 2; ++a)
#pragma unroll
            for (int b = 0; b < 2; ++b)
#pragma unroll
                for (int m = 0; m < 4; ++m)
#pragma unroll
                    for (int n = 0; n < 2; ++n) acc[a][b][m][n] = (f32x4){0.f, 0.f, 0.f, 0.f};
        cur = nxt; cA = nA; cB = nB; ++ui;
        if (wr == 1) PG8_BAR;
    }
    PG8_WAIT_V(0);
    PG8_BAR;
#undef PG8_SA
#undef PG8_SB
#undef PG8_STAGE
#undef PG8_LDA
#undef PG8_LDB
#undef PG8_MMA
#undef PG8_WAIT_V
#undef PG8_WAIT_L
#undef PG8_BAR
#undef PG8_SCHED
}
}
typedef f32x4 AccT[2][2][4][2];
#define EPI_LOOP_ROWS for (int ai = 0; ai < 2; ++ai) _Pragma("unroll") for (int m = 0; m < 4; ++m) if (ai * 4 + m < ghi)
#define EPI_ROW (u.pm * 256 + ((ai * 4 + m + glo) >> 2) * 128 + wr * 64 + ((ai * 4 + m + glo) & 3) * 16 + fr)

struct EpiIn {
    static constexpr bool PERM = true;
    bf16_t* U; float* DT; const float* rstd; const float* dtb;
    __device__ __forceinline__ void mid(AccT&, const pg8::Unit&, int, int, int, int) const {}
    __device__ __forceinline__ void prefetch(float (&pre)[8], const pg8::Unit& u, int wr, int fr) const {
#pragma unroll
        for (int e = 0; e < 8; ++e) pre[e] = rstd[u.pm * 256 + (e >> 2) * 128 + wr * 64 + (e & 3) * 16 + fr]; }
    __device__ __forceinline__ void operator()(const AccT& acc, const pg8::Unit& u, int wr, int wc, int fr, int fq, int glo, int ghi, const float (&pre)[8]) const {
#pragma unroll
        EPI_LOOP_ROWS {
            const int row = EPI_ROW; const float rs = pre[ai * 4 + m]; bf16_t* rowp = U + (size_t)row * INW;
#pragma unroll
            for (int bj = 0; bj < 2; ++bj) { const int col0 = u.pn * 256 + bj * 128 + wc * 32 + 8 * fq;
                if (col0 < INW) { const f32x4 v0 = acc[ai][bj][m][0] * rs, v1 = acc[ai][bj][m][1] * rs;
                    u32x4 w; w.x = cvt_pk_bf16(v0[0], v0[1]); w.y = cvt_pk_bf16(v0[2], v0[3]); w.z = cvt_pk_bf16(v1[0], v1[1]); w.w = cvt_pk_bf16(v1[2], v1[3]);
                    *(u32x4*)(rowp + col0) = w;
                    if (col0 >= ODT && col0 < ODT + 16) { const int d0 = col0 - ODT; float* dp = DT + (size_t)row * 16 + d0;
#pragma unroll
                        for (int i = 0; i < 4; ++i) { float x = v0[i] + dtb[d0 + i]; dp[i] = x > 20.f ? x : log1pf(__expf(x)); x = v1[i] + dtb[d0 + 4 + i]; dp[4 + i] = x > 20.f ? x : log1pf(__expf(x)); } } } }
        }
    }
};
struct EpiGate2 {
    static constexpr bool PERM = true;
    const bf16_t* U; bf16_t* MG;
    __device__ __forceinline__ void prefetch(float (&)[8], const pg8::Unit&, int, int) const {}
    __device__ __forceinline__ void mid(AccT& acc, const pg8::Unit& u, int wr, int wc, int fr_, int fq) const {
        const int fr = opaque(fr_);
#pragma unroll
        for (int ai = 0; ai < 2; ++ai)
#pragma unroll
            for (int m = 0; m < 4; ++m) { const int row = u.pm * 256 + ai * 128 + wr * 64 + m * 16 + fr; const bf16_t* gp = U + (size_t)row * INW;
#pragma unroll
                for (int bj = 0; bj < 2; ++bj) { const int col0 = u.pn * 256 + bj * 128 + wc * 32 + 8 * fq;
                    const u32x4 ga = *(const u32x4*)(gp + OGA + col0), gb = *(const u32x4*)(gp + OGB + col0);
                    float r[8];
                    r[0] = (1.f + __expf(-bflo(gb.x))) * __builtin_amdgcn_rcpf(1.f + __expf(-bflo(ga.x))); r[1] = (1.f + __expf(-bfhi(gb.x))) * __builtin_amdgcn_rcpf(1.f + __expf(-bfhi(ga.x)));
                    r[2] = (1.f + __expf(-bflo(gb.y))) * __builtin_amdgcn_rcpf(1.f + __expf(-bflo(ga.y))); r[3] = (1.f + __expf(-bfhi(gb.y))) * __builtin_amdgcn_rcpf(1.f + __expf(-bfhi(ga.y)));
                    r[4] = (1.f + __expf(-bflo(gb.z))) * __builtin_amdgcn_rcpf(1.f + __expf(-bflo(ga.z))); r[5] = (1.f + __expf(-bfhi(gb.z))) * __builtin_amdgcn_rcpf(1.f + __expf(-bfhi(ga.z)));
                    r[6] = (1.f + __expf(-bflo(gb.w))) * __builtin_amdgcn_rcpf(1.f + __expf(-bflo(ga.w))); r[7] = (1.f + __expf(-bfhi(gb.w))) * __builtin_amdgcn_rcpf(1.f + __expf(-bfhi(ga.w)));
                    f32x4 a0 = acc[ai][bj][m][0], a1 = acc[ai][bj][m][1];
                    a0[0] *= r[0]; a0[1] *= r[1]; a0[2] *= r[2]; a0[3] *= r[3]; a1[0] *= r[4]; a1[1] *= r[5]; a1[2] *= r[6]; a1[3] *= r[7];
                    acc[ai][bj][m][0] = a0; acc[ai][bj][m][1] = a1; }
                __builtin_amdgcn_sched_barrier(0); }
    }
    __device__ __forceinline__ void operator()(const AccT& acc, const pg8::Unit& u, int wr, int wc, int fr, int fq, int glo, int ghi, const float (&pre)[8]) const {
#pragma unroll
        EPI_LOOP_ROWS {
            const int row = EPI_ROW; const bf16_t* gp = U + (size_t)row * INW + OGB; bf16_t* op = MG + (size_t)row * DM;
#pragma unroll
            for (int bj = 0; bj < 2; ++bj) { const int col0 = u.pn * 256 + bj * 128 + wc * 32 + 8 * fq;
                const u32x4 gv = *(const u32x4*)(gp + col0); const f32x4 a0 = acc[ai][bj][m][0], a1 = acc[ai][bj][m][1];
                float r[8];
                r[0] = sigmoidf_(bflo(gv.x)) * a0[0]; r[1] = sigmoidf_(bfhi(gv.x)) * a0[1]; r[2] = sigmoidf_(bflo(gv.y)) * a0[2]; r[3] = sigmoidf_(bfhi(gv.y)) * a0[3];
                r[4] = sigmoidf_(bflo(gv.z)) * a1[0]; r[5] = sigmoidf_(bfhi(gv.z)) * a1[1]; r[6] = sigmoidf_(bflo(gv.w)) * a1[2]; r[7] = sigmoidf_(bfhi(gv.w)) * a1[3];
                u32x4 w; w.x = cvt_pk_bf16(r[0], r[1]); w.y = cvt_pk_bf16(r[2], r[3]); w.z = cvt_pk_bf16(r[4], r[5]); w.w = cvt_pk_bf16(r[6], r[7]);
                *(u32x4*)(op + col0) = w; }
        }
    }
};
template <int FIRST> struct EpiRes {
    static constexpr bool PERM = true;
    __device__ __forceinline__ void mid(AccT&, const pg8::Unit&, int, int, int, int) const {}
    __device__ __forceinline__ void prefetch(float (&)[8], const pg8::Unit&, int, int) const {}
    const float* base_p; bf16_t* XB; float* ssq;
    __device__ __forceinline__ void operator()(const AccT& acc, const pg8::Unit& u, int wr, int wc, int fr, int fq, int glo, int ghi, const float (&pre)[8]) const {
#pragma unroll
        EPI_LOOP_ROWS {
            const int row = EPI_ROW; bf16_t* xb = XB + (size_t)row * DM; float ss = 0.f;
#pragma unroll
            for (int bj = 0; bj < 2; ++bj) { const int col0 = u.pn * 256 + bj * 128 + wc * 32 + 8 * fq;
                f32x4 b0, b1;
                if (FIRST) { const float* bp = base_p + (size_t)row * DM + col0; b0 = __builtin_nontemporal_load((const f32x4*)bp); b1 = __builtin_nontemporal_load((const f32x4*)(bp + 4)); }
                else { const u32x4 pv = *(const u32x4*)(xb + col0); b0 = (f32x4){bflo(pv.x), bfhi(pv.x), bflo(pv.y), bfhi(pv.y)}; b1 = (f32x4){bflo(pv.z), bfhi(pv.z), bflo(pv.w), bfhi(pv.w)}; }
                const f32x4 v0 = b0 + acc[ai][bj][m][0], v1 = b1 + acc[ai][bj][m][1];
                if (FIRST) ss += (v0[0] * v0[0] + v0[1] * v0[1]) + (v0[2] * v0[2] + v0[3] * v0[3]) + (v1[0] * v1[0] + v1[1] * v1[1]) + (v1[2] * v1[2] + v1[3] * v1[3]);
                u32x4 w; w.x = cvt_pk_bf16(v0[0], v0[1]); w.y = cvt_pk_bf16(v0[2], v0[3]); w.z = cvt_pk_bf16(v1[0], v1[1]); w.w = cvt_pk_bf16(v1[2], v1[3]);
                *(u32x4*)(xb + col0) = w; }
            if (FIRST) { ss += __shfl_xor(ss, 16); ss += __shfl_xor(ss, 32); if (fq == 0) atomicAdd(ssq + row, ss); }
        }
    }
};
struct EpiUp {
    static constexpr bool PERM = true;
    const float* ssq2; bf16_t* ACT;
    __device__ __forceinline__ void mid(AccT&, const pg8::Unit&, int, int, int, int) const {}
    __device__ __forceinline__ void prefetch(float (&pre)[8], const pg8::Unit& u, int wr, int fr) const {
#pragma unroll
        for (int e = 0; e < 8; ++e) pre[e] = ssq2[u.pm * 256 + (e >> 2) * 128 + wr * 64 + (e & 3) * 16 + fr]; }
    __device__ __forceinline__ void operator()(const AccT& acc, const pg8::Unit& u, int wr, int wc, int fr, int fq, int glo, int ghi, const float (&pre)[8]) const {
#pragma unroll
        EPI_LOOP_ROWS {
            const int row = EPI_ROW; const float rs = rsqrtf(pre[ai * 4 + m] * (1.f / DM) + EPS); bf16_t* op = ACT + (size_t)row * DFF;
#pragma unroll
            for (int bj = 0; bj < 2; ++bj) { const int col0 = u.pn * 256 + bj * 128 + wc * 32 + 8 * fq;
                f32x4 v0 = acc[ai][bj][m][0] * rs, v1 = acc[ai][bj][m][1] * rs;
#pragma unroll
                for (int i = 0; i < 4; ++i) { const float a = fmaxf(v0[i], 0.f), b = fmaxf(v1[i], 0.f); v0[i] = a * a; v1[i] = b * b; }
                u32x4 w; w.x = cvt_pk_bf16(v0[0], v0[1]); w.y = cvt_pk_bf16(v0[2], v0[3]); w.z = cvt_pk_bf16(v1[0], v1[1]); w.w = cvt_pk_bf16(v1[2], v1[3]);
                *(u32x4*)(op + col0) = w; }
        }
    }
};

__device__ __forceinline__ void transpose_item(const float* W, int K, int N, const float* scale, bf16_t* WT, int ldw, int kdst0, LAS float* scr, int kb, int nsrc0, int ndst0, int lane) {
    const int k0 = 64 * kb;
    const int n = nsrc0 + (lane & 15) * 4, kr = lane >> 4;
    f32x4 v[16];
#pragma unroll
    for (int i = 0; i < 16; ++i) { v[i] = (f32x4){0.f, 0.f, 0.f, 0.f}; if (n < N) v[i] = __builtin_nontemporal_load((const f32x4*)(W + (size_t)(k0 + 4 * i + kr) * N + n)); }
#pragma unroll
    for (int i = 0; i < 16; ++i) { const int kk = 4 * i + kr; const float sc = scale ? scale[k0 + kk] : 1.f; LAS float* p = scr + kk * 65 + (lane & 15) * 4;
        p[0] = v[i][0] * sc; p[1] = v[i][1] * sc; p[2] = v[i][2] * sc; p[3] = v[i][3] * sc; }
    LDS_WAIT();
    const int c = lane & 7;
#pragma unroll
    for (int j = 0; j < 8; ++j) { const int nn = (lane >> 3) + 8 * j; const LAS float* sp = scr + (8 * c) * 65 + nn;
        u32x4 o; o.x = pk2(sp[0 * 65], sp[1 * 65]); o.y = pk2(sp[2 * 65], sp[3 * 65]); o.z = pk2(sp[4 * 65], sp[5 * 65]); o.w = pk2(sp[6 * 65], sp[7 * 65]);
        *(u32x4*)(WT + (size_t)(ndst0 + nn) * ldw + kdst0 + k0 + 8 * c) = o; }
    LDS_WAIT();
}

constexpr int KS_LD = 72;
__device__ __forceinline__ void attn_tile(const LAS bf16_t* Ks, const LAS bf16_t* Vt, bf16_t* qptr, const bf16x8 qf0, const bf16x8 qf1, int kt0, int rq, int kmin, float sink, int lane) {
    const int c16 = lane & 15, quad = lane >> 4;
    bf16x8 qf[2]; qf[0] = qf0; qf[1] = qf1;
    f32x4 s[10]; s[9] = (f32x4){0.f, 0.f, 0.f, 0.f};
#pragma unroll
    for (int j = 0; j < 9; ++j) { s[j] = (f32x4){0.f, 0.f, 0.f, 0.f};
#pragma unroll
        for (int ks = 0; ks < 2; ++ks) { const bf16x8 kf = *(const LAS bf16x8*)(Ks + ((kt0 + j) * 16 + c16) * KS_LD + ks * 32 + quad * 8); s[j] = MFMA16(kf, qf[ks], s[j]); } }
    float mx = sink;
#pragma unroll
    for (int j = 0; j < 9; ++j)
#pragma unroll
        for (int jj = 0; jj < 4; ++jj) { const int kidx = (kt0 + j) * 16 + quad * 4 + jj; const bool ok = (kidx >= rq) && (kidx <= rq + 128) && (kidx >= kmin);
            const float v = ok ? s[j][jj] * 0.125f : -INFINITY; s[j][jj] = v; mx = fmaxf(mx, v); }
    mx = fmaxf(mx, __shfl_xor(mx, 16)); mx = fmaxf(mx, __shfl_xor(mx, 32));
    float sum = 0.f;
#pragma unroll
    for (int j = 0; j < 9; ++j)
#pragma unroll
        for (int jj = 0; jj < 4; ++jj) { const float p = __expf(s[j][jj] - mx); s[j][jj] = p; sum += p; }
    sum += __shfl_xor(sum, 16); sum += __shfl_xor(sum, 32); sum += __expf(sink - mx);
    const float inv = 1.f / sum;
    f32x4 o[4];
#pragma unroll
    for (int dt = 0; dt < 4; ++dt) o[dt] = (f32x4){0.f, 0.f, 0.f, 0.f};
    const unsigned vaddr = LDSADDR(Vt) + (unsigned)(((kt0 * 16 + quad * 4 + (c16 >> 2)) * KS_LD + 4 * (c16 & 3)) * 2);
#pragma unroll
    for (int st = 0; st < 5; ++st) {
        u32x4 pw; pw.x = pk2(s[2 * st][0] * inv, s[2 * st][1] * inv); pw.y = pk2(s[2 * st][2] * inv, s[2 * st][3] * inv);
        pw.z = pk2(s[2 * st + 1][0] * inv, s[2 * st + 1][1] * inv); pw.w = pk2(s[2 * st + 1][2] * inv, s[2 * st + 1][3] * inv);
        const bf16x8 pf = __builtin_bit_cast(bf16x8, pw);
        bf16x8 vf[4]; tr_frag4<0, 32, 64, 96, 16 * KS_LD * 2>(vaddr + st * (32 * KS_LD * 2), vf);
#pragma unroll
        for (int dt = 0; dt < 4; ++dt) o[dt] = MFMA16(vf[dt], pf, o[dt]);
    }
#pragma unroll
    for (int dt = 0; dt < 4; ++dt) { u32x2 w; w.x = pk2(o[dt][0], o[dt][1]); w.y = pk2(o[dt][2], o[dt][3]); *(u32x2*)(qptr + dt * 16 + quad * 4) = w; }
}

#define XB_TMO      128
#define XB_XCNT(j)  (256  + 64 * (j))
#define XB_XSUB(j)  (1280 + 64 * (j))
#define XB_XGEN(j)  (2304 + 64 * (j))
#define XB_TOP      3328
#define XB_TOPGEN   3392
#define XCD_BAR_WORDS 3456
#define XB_SPIN_CAP (1u << 18)
__device__ __forceinline__ unsigned xb_ld(unsigned* p)              { return __hip_atomic_load(p, __ATOMIC_RELAXED, __HIP_MEMORY_SCOPE_AGENT); }
__device__ __forceinline__ unsigned xb_add(unsigned* p, unsigned v) { return __hip_atomic_fetch_add(p, v, __ATOMIC_RELAXED, __HIP_MEMORY_SCOPE_AGENT); }
__device__ __forceinline__ unsigned xb_xcc_id() { return (unsigned)__builtin_amdgcn_s_getreg((3 << 11) | 20) & 0xFu; }
#define XB_SPIN(cond, bar) do { unsigned _sp = 0; while (cond) { __builtin_amdgcn_s_sleep(1); \
    if ((++_sp & 255u) == 0u) { if (xb_ld(&(bar)[XB_TMO])) break; if (_sp > XB_SPIN_CAP) { atomicAdd(&(bar)[XB_TMO], 1u); break; } } } } while (0)
__device__ __forceinline__ void xcd_barrier_complete(unsigned* bar, unsigned x, unsigned& nloc, unsigned& nx) {
    const unsigned Gt = gridDim.x;
    unsigned sum, cnt, mine, sp = 0u;
    for (;;) {
        sum = 0u; cnt = 0u; mine = 0u;
#pragma unroll
        for (unsigned j = 0; j < 16; ++j) { const unsigned c = xb_ld(&bar[XB_XCNT(j)]); sum += c; cnt += (c > 0u) ? 1u : 0u; mine = (j == x) ? c : mine; }
        if (sum == Gt) break;
        __builtin_amdgcn_s_sleep(1);
        if ((++sp & 255u) == 0u) { if (xb_ld(&bar[XB_TMO])) break; if (sp > XB_SPIN_CAP) { atomicAdd(&bar[XB_TMO], 1u); break; } }
    }
    nloc = mine > 0u ? mine : 1u; nx = cnt > 0u ? cnt : 1u;
}
__device__ __forceinline__ void xcd_barrier(unsigned* bar, unsigned x, volatile LAS unsigned* st, int tid0) {
    asm volatile("s_waitcnt vmcnt(0) lgkmcnt(0)" ::: "memory");
    __syncthreads();
    if (tid0 == 0) {
        __builtin_amdgcn_s_waitcnt(0);
        unsigned nloc = st[0], nx = st[1];
        if (nloc == 0u) { xcd_barrier_complete(bar, x, nloc, nx); st[0] = nloc; st[1] = nx; }
        const unsigned old = xb_add(&bar[XB_XSUB(x)], 1u);
        const unsigned gen = old / nloc;
        if (old + 1u == (gen + 1u) * nloc) {
            __builtin_amdgcn_fence(__ATOMIC_RELEASE, "agent");
            asm volatile("s_waitcnt vmcnt(0)" ::: "memory");
            const unsigned og = xb_add(&bar[XB_TOP], 1u);
            const unsigned tg = og / nx;
            if (og + 1u == (tg + 1u) * nx) xb_add(&bar[XB_TOPGEN], 1u);
            else XB_SPIN(xb_ld(&bar[XB_TOPGEN]) == tg, bar);
            __builtin_amdgcn_fence(__ATOMIC_ACQUIRE, "agent");
            xb_add(&bar[XB_XGEN(x)], 1u);
            asm volatile("s_waitcnt vmcnt(0)" ::: "memory");
        } else {
            XB_SPIN(xb_ld(&bar[XB_XGEN(x)]) == gen, bar);
            __builtin_amdgcn_fence(__ATOMIC_ACQUIRE, "agent");
            asm volatile("s_waitcnt vmcnt(0)" ::: "memory");
        }
    }
    __syncthreads();
}
struct Args { const float* in[22]; float* out; unsigned char* ws; int ph_lo, ph_hi; };

__global__ void __launch_bounds__(512, 2) mega(Args a) {
    extern __shared__ __attribute__((aligned(16))) unsigned char lds_raw[];
    LAS unsigned char* lds = (LAS unsigned char*)lds_raw;
    cg::grid_group grid = cg::this_grid();
    const int tid0 = threadIdx.x, w = __builtin_amdgcn_readfirstlane(tid0 >> 6), G = gridDim.x, bx = blockIdx.x;
    const int gw = bx * 8 + w, NGW = G * 8, NGT = G * 512;
#define LOCAL_IDS const int tid = opaque(tid0), lane = tid & 63, c16 = lane & 15, quad = lane >> 4; (void)c16; (void)quad; (void)lane;
    unsigned char* ws = a.ws; float* out = a.out;
    float* RSTD1 = (float*)(ws + WS_RSTD1); float* SSQ2 = (float*)(ws + WS_SSQ2); float* SSQF = (float*)(ws + WS_SSQF); float* CD = (float*)(ws + WS_CD);
    bf16_t* WIN = (bf16_t*)(ws + WS_WIN); bf16_t* WOA = (bf16_t*)(ws + WS_WOA); bf16_t* WOB = (bf16_t*)(ws + WS_WOB); bf16_t* WO = (bf16_t*)(ws + WS_WO);
    bf16_t* WUP = (bf16_t*)((unsigned char*)out + 40 * MiB); bf16_t* WDN = (bf16_t*)((unsigned char*)out + 48 * MiB);
    float* DT = (float*)(ws + WS_DT); bf16_t* U = (bf16_t*)(ws + WS_U); bf16_t* XC = (bf16_t*)(ws + WS_XC);
    bf16_t* MERGED = (bf16_t*)(ws + WS_MERGED); bf16_t* X1B = (bf16_t*)(ws + WS_X1B); bf16_t* ACT = (bf16_t*)(ws + WS_ACT);
    bf16_t* XB = (bf16_t*)(out + O_SS);
    bf16_t* STB = (bf16_t*)(out + O_YP);
    float* X1 = out + O_YP;
    const int lo = a.ph_lo, hi = a.ph_hi;
#ifndef PHMASK
#define PHMASK 0x7ff
#endif
#define IN(k) (((PHMASK >> (k)) & 1) && lo <= (k) && (k) < hi)
    unsigned* BARW = (unsigned*)(ws + WS_BAR);
    if (lo < 0) grid.sync();
#ifdef PROBE_A
    unsigned tstamp[12];
#define STAMP(i) tstamp[i] = (unsigned)__builtin_amdgcn_s_memrealtime()
    STAMP(0);
#else
#define STAMP(i)
#endif
    unsigned* XBW = (unsigned*)(ws + WS_XB); volatile LAS unsigned* xst = (volatile LAS unsigned*)(lds + LDS_BYTES - 64);
    const unsigned xcc = xb_xcc_id();
    if (tid0 < 2) xst[tid0] = 0u;
    if (tid0 == 0) (void)xb_add(&XBW[XB_XCNT(xcc)], 1u);
    __syncthreads();
#define SEAM(k) do { if (IN(k) && IN((k) + 1)) xcd_barrier(XBW, xcc, xst, tid0); } while (0)
#define SOFT_ARRIVE(k) do { asm volatile("s_waitcnt vmcnt(0) lgkmcnt(0)" ::: "memory"); __syncthreads(); \
        if (tid0 == 0) { __hip_atomic_fetch_add(BARW + 64 + (k), 1u, __ATOMIC_RELAXED, __HIP_MEMORY_SCOPE_AGENT); } } while (0)
    if (IN(0)) {
        const float* x_p = kin(0); const float* x_s = kin(1); const float* norm1 = kin(6); const float* w_in = kin(7); const float* ssm_norm = kin(14); const float* w_oa = kin(15); const float* w_ob = kin(16); const float* w_o = kin(17);
        LOCAL_IDS const int gtid = bx * 512 + tid;
        LAS float* scr = (LAS float*)(lds + w * 16640);
        constexpr int I_IN = 16 * 88, I_OA = 8 * 16, I_OB = 16 * 16, I_O = 16 * 16;
        for (int it = gw; it < I_IN + I_OA + I_OB + I_O; it += NGW) {
            int r = it;
            if (r < I_IN) { const int kb = r / 88, nd = 64 * (r % 88); const int ns = nd < 512 ? nd : (nd < 1536 ? nd + 256 : (nd < 1792 ? nd - 1024 : nd));
                transpose_item(w_in, DM, INW, norm1, WIN, DM, 0, scr, kb, ns, nd, lane); continue; } r -= I_IN;
            if (r < I_OA) { transpose_item(w_oa, 512, DM, nullptr, WOA, 1536, 0, scr, r / 16, 64 * (r % 16), 64 * (r % 16), lane); continue; } r -= I_OA;
            if (r < I_OB) { transpose_item(w_ob, DM, DM, ssm_norm, WOA, 1536, 512, scr, r / 16, 64 * (r % 16), 64 * (r % 16), lane); continue; } r -= I_OB;
            transpose_item(w_o, DM, DM, nullptr, WO, DM, 0, scr, r / 16, 64 * (r % 16), 64 * (r % 16), lane);
        }
#pragma unroll 2
        for (int m = gw; m < M; m += NGW) {
            const float* xr = m < MP ? x_p + (size_t)m * DM : x_s + (size_t)(m - MP) * DM;
            f32x4 v[4]; float ss = 0.f;
#pragma unroll
            for (int j = 0; j < 4; ++j) { v[j] = __builtin_nontemporal_load((const f32x4*)(xr + lane * 4 + 256 * j)); ss += (v[j][0] * v[j][0] + v[j][1] * v[j][1]) + (v[j][2] * v[j][2] + v[j][3] * v[j][3]); }
            ss = wave_sum(ss);
            if (lane == 0) RSTD1[m] = rsqrtf(ss * (1.f / DM) + EPS);
#pragma unroll
            for (int j = 0; j < 4; ++j) { u32x2 o; o.x = pk2(v[j][0], v[j][1]); o.y = pk2(v[j][2], v[j][3]); *(u32x2*)(XB + (size_t)m * DM + lane * 4 + 256 * j) = o; }
        }
        for (int i = gtid; i < M; i += NGT) { SSQ2[i] = 0.f; SSQF[i] = 0.f; }
    }
    SEAM(0); STAMP(1);
    if (IN(1)) {
        const float* dt_bias = kin(11);
        pg8::Gemm g{XB, WIN, M, NPAD, DM, DM, DM}; pg8::StaticOrder S; S.init(M, NPAD, G, bx);
        EpiIn E{U, DT, RSTD1, dt_bias};
        pg8::gemm_phase<EpiIn>(lds, g, S, E);
        {
            constexpr int NT1 = (M / 256) * (NPAD / 256); const int full = NT1 / G, rem = NT1 - full * G;
            if (bx >= rem && rem > 0) { LOCAL_IDS const float* norm2 = kin(18); const float* w_up = kin(19); const float* w_down = kin(20);
                LAS float* scr = (LAS float*)(lds + w * 16640); const int nidle = (G - rem) * 8;
                for (int it = (bx - rem) * 8 + w; it < 2048; it += nidle) { if (it < 1024) transpose_item(w_up, DM, DFF, norm2, WUP, DM, 0, scr, it / 64, 64 * (it % 64), 64 * (it % 64), lane); else transpose_item(w_down, DFF, DM, nullptr, WDN, DFF, 0, scr, (it - 1024) / 16, 64 * ((it - 1024) % 16), 64 * ((it - 1024) % 16), lane); } } }
    }
    SEAM(1); STAMP(2);
    if (IN(2)) {
        const float* cache_k = kin(2); const float* cache_v = kin(3); const float* state_conv = kin(4); const float* sinks = kin(8); const float* conv_w = kin(9); const float* conv_b = kin(10);
        {   LOCAL_IDS
            if (tid < 384) {
                const int cgi = tid % 192, sub = tid / 192, ch0 = cgi * 8;
                float wv[4][8], bias[8];
#pragma unroll
                for (int i = 0; i < 4; ++i) { const f32x4 t0 = *(const f32x4*)(conv_w + i * CONVD + ch0), t1 = *(const f32x4*)(conv_w + i * CONVD + ch0 + 4);
#pragma unroll
                    for (int k = 0; k < 4; ++k) { wv[i][k] = t0[k]; wv[i][4 + k] = t1[k]; } }
                { const f32x4 t0 = *(const f32x4*)(conv_b + ch0), t1 = *(const f32x4*)(conv_b + ch0 + 4);
#pragma unroll
                  for (int k = 0; k < 4; ++k) { bias[k] = t0[k]; bias[4 + k] = t1[k]; } }
#pragma unroll 1
                for (int rg = bx * 2 + sub; rg < 4096 + 128; rg += 2 * G) {
                    const bool prompt = rg < 4096; const int bs = rg - 4096;
                    const int rowbase = prompt ? rg * 4 : MP + bs * 4; const int t = rowbase & (SEQ - 1);
                    float x[7][8];
                    u32x4 r[7];
#pragma unroll
                    for (int j = 0; j < 7; ++j) r[j] = (u32x4){0u, 0u, 0u, 0u};
#pragma unroll
                    for (int j = 3; j < 7; ++j) r[j] = __builtin_nontemporal_load((const u32x4*)(U + (size_t)(rowbase + j - 3) * INW + OX + ch0));
                    if (prompt && t > 0) {
#pragma unroll
                        for (int j = 0; j < 3; ++j) r[j] = *(const u32x4*)(U + (size_t)(rowbase + j - 3) * INW + OX + ch0); }
#pragma unroll
                    for (int j = 0; j < 7; ++j) { x[j][0] = bflo(r[j].x); x[j][1] = bfhi(r[j].x); x[j][2] = bflo(r[j].y); x[j][3] = bfhi(r[j].y); x[j][4] = bflo(r[j].z); x[j][5] = bfhi(r[j].z); x[j][6] = bflo(r[j].w); x[j][7] = bfhi(r[j].w); }
                    if (!prompt) { const float* sp = state_conv + (size_t)bs * 3 * CONVD + ch0;
#pragma unroll
                        for (int j = 0; j < 3; ++j) { const f32x4 a0 = *(const f32x4*)(sp + j * CONVD), a1 = *(const f32x4*)(sp + j * CONVD + 4);
#pragma unroll
                            for (int k = 0; k < 4; ++k) { x[j][k] = a0[k]; x[j][4 + k] = a1[k]; } } }
#pragma unroll
                    for (int tt = 0; tt < 4; ++tt) { float y[8];
#pragma unroll
                        for (int k = 0; k < 8; ++k) { const float sacc = bias[k] + x[tt][k] * wv[0][k] + x[tt + 1][k] * wv[1][k] + x[tt + 2][k] * wv[2][k] + x[tt + 3][k] * wv[3][k]; y[k] = siluf_(sacc); }
                        u32x4 o; o.x = pk2(y[0], y[1]); o.y = pk2(y[2], y[3]); o.z = pk2(y[4], y[5]); o.w = pk2(y[6], y[7]);
                        *(u32x4*)(XC + (size_t)(rowbase + tt) * CONVD + ch0) = o; }
                    float* obase = nullptr;
                    if (prompt) { if (t == SEQ - 4) obase = out + O_CP + (size_t)(rowbase >> 11) * 3 * CONVD; } else obase = out + O_CS + (size_t)bs * 3 * CONVD;
                    if (obase) {
#pragma unroll
                        for (int j = 0; j < 3; ++j) { float* op = obase + (size_t)j * CONVD + ch0; *(f32x4*)op = (f32x4){x[4 + j][0], x[4 + j][1], x[4 + j][2], x[4 + j][3]}; *(f32x4*)(op + 4) = (f32x4){x[4 + j][4], x[4 + j][5], x[4 + j][6], x[4 + j][7]}; } }
                }
            }
        }
        LAS bf16_t* Ks = (LAS bf16_t*)lds; LAS bf16_t* Vt = (LAS bf16_t*)(lds + 272 * KS_LD * 2);
        LAS bf16_t* Ks2 = (LAS bf16_t*)(lds + 2 * 272 * KS_LD * 2); LAS bf16_t* Vt2 = (LAS bf16_t*)(lds + 2 * 272 * KS_LD * 2 + 160 * KS_LD * 2);
        for (int unit = bx; unit < 256; unit += G) {
            LOCAL_IDS const int b = unit >> 5, qblk = (unit >> 1) & 15, kvh = unit & 1, bs = unit >> 1, kvh2 = unit & 1;
            const int hq = kvh * 4 + (w >> 1), qh = w & 1; const float sink = sinks[hq];
            bf16x8 qf[4][2];
#pragma unroll
            for (int i = 0; i < 4; ++i) { const bf16_t* qp = U + (size_t)(b * SEQ + qblk * 128 + qh * 64 + i * 16 + c16) * INW + hq * 64; qf[i][0] = *(const bf16x8*)(qp + quad * 8); qf[i][1] = *(const bf16x8*)(qp + 32 + quad * 8); }
            const int sw = unit & 7;
            const int gq = c16 >> 2, ts = c16 & 3, hq2 = kvh2 * 4 + gq;
            bf16_t* qp2 = U + (size_t)(MP + bs * 4 + ts) * INW + hq2 * 64; bf16x8 q2a = qf[0][0], q2b = qf[0][1];
            if (w == sw) { q2a = *(const bf16x8*)(qp2 + quad * 8); q2b = *(const bf16x8*)(qp2 + 32 + quad * 8); }
            __syncthreads();
#pragma unroll
            for (int pc = tid; pc < 272 * 8; pc += 512) { const int kidx = pc >> 3, part = pc & 7; const int tok = (qblk - 1) * 128 + kidx;
                u32x4 kv = (u32x4){0u, 0u, 0u, 0u}, vv = (u32x4){0u, 0u, 0u, 0u};
                if (kidx < 256 && tok >= 0) { const bf16_t* rp = U + (size_t)(b * SEQ + tok) * INW + kvh * 64 + part * 8; kv = *(const u32x4*)(rp + OKK); vv = *(const u32x4*)(rp + OV);
                    if (qblk == 15 && kidx >= 128) { const size_t oo = ((size_t)(b * 128 + kidx - 128) * 2 + kvh) * 64 + part * 8;
                        *(f32x4*)(out + O_KP + oo) = (f32x4){bflo(kv.x), bfhi(kv.x), bflo(kv.y), bfhi(kv.y)}; *(f32x4*)(out + O_KP + oo + 4) = (f32x4){bflo(kv.z), bfhi(kv.z), bflo(kv.w), bfhi(kv.w)};
                        *(f32x4*)(out + O_VP + oo) = (f32x4){bflo(vv.x), bfhi(vv.x), bflo(vv.y), bfhi(vv.y)}; *(f32x4*)(out + O_VP + oo + 4) = (f32x4){bflo(vv.z), bfhi(vv.z), bflo(vv.w), bfhi(vv.w)}; } }
                *(LAS u32x4*)(Ks + kidx * KS_LD + part * 8) = kv; *(LAS u32x4*)(Vt + kidx * KS_LD + part * 8) = vv; }
#pragma unroll
            for (int pc = tid; pc < 160 * 8; pc += 512) { const int kidx = pc >> 3, part = pc & 7;
                float kf[8], vf[8];
#pragma unroll
                for (int i = 0; i < 8; ++i) { kf[i] = 0.f; vf[i] = 0.f; }
                if (kidx < 128) { const size_t io = ((size_t)(bs * 128 + kidx) * 2 + kvh2) * 64 + part * 8;
                    const f32x4 k0 = __builtin_nontemporal_load((const f32x4*)(cache_k + io)), k1 = __builtin_nontemporal_load((const f32x4*)(cache_k + io + 4)), v0 = __builtin_nontemporal_load((const f32x4*)(cache_v + io)), v1 = __builtin_nontemporal_load((const f32x4*)(cache_v + io + 4));
#pragma unroll
                    for (int i = 0; i < 4; ++i) { kf[i] = k0[i]; kf[4 + i] = k1[i]; vf[i] = v0[i]; vf[4 + i] = v1[i]; }
                } else if (kidx < 132) { const bf16_t* rp = U + (size_t)(MP + bs * 4 + kidx - 128) * INW + kvh2 * 64 + part * 8; const u32x4 kv = *(const u32x4*)(rp + OKK), vv = *(const u32x4*)(rp + OV);
                    kf[0] = bflo(kv.x); kf[1] = bfhi(kv.x); kf[2] = bflo(kv.y); kf[3] = bfhi(kv.y); kf[4] = bflo(kv.z); kf[5] = bfhi(kv.z); kf[6] = bflo(kv.w); kf[7] = bfhi(kv.w);
                    vf[0] = bflo(vv.x); vf[1] = bfhi(vv.x); vf[2] = bflo(vv.y); vf[3] = bfhi(vv.y); vf[4] = bflo(vv.z); vf[5] = bfhi(vv.z); vf[6] = bflo(vv.w); vf[7] = bfhi(vv.w); }
                if (kidx >= 4 && kidx < 132) { const size_t oo = ((size_t)(bs * 128 + kidx - 4) * 2 + kvh2) * 64 + part * 8;
                    __builtin_nontemporal_store((f32x4){kf[0], kf[1], kf[2], kf[3]}, (f32x4*)(out + O_KS + oo)); __builtin_nontemporal_store((f32x4){kf[4], kf[5], kf[6], kf[7]}, (f32x4*)(out + O_KS + oo + 4));
                    __builtin_nontemporal_store((f32x4){vf[0], vf[1], vf[2], vf[3]}, (f32x4*)(out + O_VS + oo)); __builtin_nontemporal_store((f32x4){vf[4], vf[5], vf[6], vf[7]}, (f32x4*)(out + O_VS + oo + 4)); }
                u32x4 kw; kw.x = pk2(kf[0], kf[1]); kw.y = pk2(kf[2], kf[3]); kw.z = pk2(kf[4], kf[5]); kw.w = pk2(kf[6], kf[7]);
                u32x4 vw; vw.x = pk2(vf[0], vf[1]); vw.y = pk2(vf[2], vf[3]); vw.z = pk2(vf[4], vf[5]); vw.w = pk2(vf[6], vf[7]);
                *(LAS u32x4*)(Ks2 + kidx * KS_LD + part * 8) = kw; *(LAS u32x4*)(Vt2 + kidx * KS_LD + part * 8) = vw; }
            __syncthreads();
#pragma unroll
            for (int i = 0; i < 4; ++i) { const int r0 = qh * 64 + i * 16;
                bf16_t* qp = U + (size_t)(b * SEQ + qblk * 128 + r0 + c16) * INW + hq * 64;
                attn_tile(Ks, Vt, qp, qf[i][0], qf[i][1], r0 >> 4, r0 + c16, qblk == 0 ? 128 : 0, sink, lane); }
            if (w == sw) attn_tile(Ks2, Vt2, qp2, q2a, q2b, 0, ts, 0, sinks[hq2], lane);
        }
    }
    SEAM(2); STAMP(3);
    if (IN(3)) {
        const float* state_ssm = kin(5); const float* a_log = kin(12); const float* d_skip = kin(13);
        for (int ord = 0; ord < 2; ++ord) {
        if (((ord ^ bx) & 1) == 0) {
            LAS bf16_t* Bt = (LAS bf16_t*)lds;
            LAS bf16_t* Xs = (LAS bf16_t*)(lds + 18432);
            LAS float* scl = (LAS float*)(lds + 18432 + 73728);
            for (int unit = bx; unit < 256; unit += G) {
                LOCAL_IDS const int b = unit >> 5, c = (unit >> 1) & 15, g = unit & 1, row0 = b * SEQ + c * 128, h = 8 * g + w;
                __syncthreads();
                { const float A = -__expf(a_log[h]);
                  const float d0 = DT[(size_t)(row0 + lane) * 16 + h], d1 = DT[(size_t)(row0 + 64 + lane) * 16 + h];
                  float v0 = d0 * A, v1 = d1 * A;
#pragma unroll
                  for (int o = 1; o < 64; o <<= 1) { const float t0 = __builtin_bit_cast(float, __builtin_amdgcn_ds_bpermute((lane - o) << 2, __builtin_bit_cast(int, v0))), t1 = __builtin_bit_cast(float, __builtin_amdgcn_ds_bpermute((lane - o) << 2, __builtin_bit_cast(int, v1))); if (lane >= o) { v0 += t0; v1 += t1; } }
                  v1 += __builtin_bit_cast(float, __builtin_amdgcn_readlane(__builtin_bit_cast(int, v0), 63)); const float last = __builtin_bit_cast(float, __builtin_amdgcn_readlane(__builtin_bit_cast(int, v1), 63));
                  scl[w * 128 + lane] = d0 * __expf(last - v0); scl[w * 128 + 64 + lane] = d1 * __expf(last - v1);
                  if (lane == 0) CD[(b * 16 + c) * 16 + h] = __expf(last); }
                f32x4 acc[8][4];
#pragma unroll
                for (int nt = 0; nt < 8; ++nt)
#pragma unroll
                    for (int pt = 0; pt < 4; ++pt) acc[nt][pt] = (f32x4){0.f, 0.f, 0.f, 0.f};
                for (int half = 0; half < 2; ++half) {
                    __syncthreads();
#pragma unroll 2
                    for (int pc = tid; pc < 1024; pc += 512) { const int lr = pc >> 4, part = pc & 15;
                        *(LAS u32x4*)(Bt + lr * 136 + part * 8) = *(const u32x4*)(XC + (size_t)(row0 + half * 64 + lr) * CONVD + 1024 + g * 128 + part * 8); }
#pragma unroll 1
                    for (int pc0 = tid; pc0 < 4096; pc0 += 2048) { u32x4 vv[4];
#pragma unroll
                        for (int k = 0; k < 4; ++k) { const int pc = pc0 + 512 * k, lr = pc >> 6, part = pc & 63; vv[k] = *(const u32x4*)(XC + (size_t)(row0 + half * 64 + lr) * CONVD + g * 512 + part * 8); }
#pragma unroll
                        for (int k = 0; k < 4; ++k) { const int pc = pc0 + 512 * k, lr = pc >> 6, part = pc & 63, hh = part >> 3; const u32x4 v = vv[k];
                            const float sc = scl[hh * 128 + half * 64 + lr];
                            u32x4 o; o.x = pk2(bflo(v.x) * sc, bfhi(v.x) * sc); o.y = pk2(bflo(v.y) * sc, bfhi(v.y) * sc); o.z = pk2(bflo(v.z) * sc, bfhi(v.z) * sc); o.w = pk2(bflo(v.w) * sc, bfhi(v.w) * sc);
                            *(LAS u32x4*)(Xs + (hh * 64 + lr) * 72 + (part & 7) * 8) = o; } }
                    __syncthreads();
                    const unsigned baddr = LDSADDR(Bt) + (unsigned)(((quad * 8 + (c16 >> 2)) * 136 + 4 * (c16 & 3)) * 2);
                    const unsigned xaddr = LDSADDR(Xs) + (unsigned)(((w * 64 + quad * 8 + (c16 >> 2)) * 72 + 4 * (c16 & 3)) * 2);
#pragma unroll
                    for (int ks = 0; ks < 2; ++ks) { bf16x8 xf[4]; tr_frag4<0, 32, 64, 96, 4 * 144>(xaddr + ks * (32 * 144), xf);
#pragma unroll
                        for (int nh = 0; nh < 2; ++nh) { bf16x8 bfr[4]; tr_frag4<0, 32, 64, 96, 4 * 272>(baddr + ks * (32 * 272) + nh * 128, bfr);
#pragma unroll
                            for (int n4 = 0; n4 < 4; ++n4)
#pragma unroll
                                for (int pt = 0; pt < 4; ++pt) acc[nh * 4 + n4][pt] = MFMA16(bfr[n4], xf[pt], acc[nh * 4 + n4][pt]); } }
                }
                bf16_t* sp = STB + ((size_t)((b * 16 + c) * 16 + h) * 64) * 128;
#pragma unroll
                for (int nt = 0; nt < 8; ++nt)
#pragma unroll
                    for (int pt = 0; pt < 4; ++pt) { u32x2 o; o.x = pk2(acc[nt][pt][0], acc[nt][pt][1]); o.y = pk2(acc[nt][pt][2], acc[nt][pt][3]); *(u32x2*)(sp + (size_t)(pt * 16 + c16) * 128 + nt * 16 + quad * 4) = o; }
            }
        }
        else {
            LAS float* xr = (LAS float*)lds;
            LAS float* xdt = (LAS float*)(lds + 8192);
            LAS float* vals = (LAS float*)(lds + 16384);
            LAS float* rs = (LAS float*)(lds + 24576);
            for (int unit = bx; unit < 256; unit += G) {
                LOCAL_IDS const int b = unit >> 1, g = unit & 1, h = 8 * g + w, R0 = MP + b * 4;
                __syncthreads();
                const float A = -__expf(a_log[h]); float dtv[4], dA[4];
#pragma unroll
                for (int t = 0; t < 4; ++t) { dtv[t] = DT[(size_t)(R0 + t) * 16 + h]; dA[t] = __expf(dtv[t] * A); }
                { const int t = quad, p0 = c16 * 4; const u32x2 v = *(const u32x2*)(XC + (size_t)(R0 + t) * CONVD + h * 64 + p0);
                  const float dtt = t == 0 ? dtv[0] : (t == 1 ? dtv[1] : (t == 2 ? dtv[2] : dtv[3]));
                  const float f0 = bflo(v.x), f1 = bfhi(v.x), f2 = bflo(v.y), f3 = bfhi(v.y);
                  LAS float* p = xr + (w * 4 + t) * 64 + p0; p[0] = f0; p[1] = f1; p[2] = f2; p[3] = f3;
                  LAS float* q = xdt + (w * 4 + t) * 64 + p0; q[0] = f0 * dtt; q[1] = f1 * dtt; q[2] = f2 * dtt; q[3] = f3 * dtt; }
                float Bv[4][8], Cv[4][8];
#pragma unroll
                for (int t = 0; t < 4; ++t) { const bf16_t* rp = XC + (size_t)(R0 + t) * CONVD + 1024 + g * 128 + c16 * 4;
                    const u32x2 b0 = *(const u32x2*)rp, b1 = *(const u32x2*)(rp + 64), c0 = *(const u32x2*)(rp + 256), c1 = *(const u32x2*)(rp + 320);
                    Bv[t][0] = bflo(b0.x); Bv[t][1] = bfhi(b0.x); Bv[t][2] = bflo(b0.y); Bv[t][3] = bfhi(b0.y); Bv[t][4] = bflo(b1.x); Bv[t][5] = bfhi(b1.x); Bv[t][6] = bflo(b1.y); Bv[t][7] = bfhi(b1.y);
                    Cv[t][0] = bflo(c0.x); Cv[t][1] = bfhi(c0.x); Cv[t][2] = bflo(c0.y); Cv[t][3] = bfhi(c0.y); Cv[t][4] = bflo(c1.x); Cv[t][5] = bfhi(c1.x); Cv[t][6] = bflo(c1.y); Cv[t][7] = bfhi(c1.y); }
                const float Dh = d_skip[h];
                LDS_WAIT();
                const float* sin_ = state_ssm + (size_t)(b * 16 + h) * 8192; float* sout = out + O_SS + (size_t)(b * 16 + h) * 8192;
#pragma unroll 1
                for (int i0 = 0; i0 < 16; i0 += 4) { f32x4 H0[4], H1[4];
#pragma unroll
                  for (int ii = 0; ii < 4; ++ii) { const int p = 4 * (i0 + ii) + quad; H0[ii] = __builtin_nontemporal_load((const f32x4*)(sin_ + p * 128 + c16 * 4)); H1[ii] = __builtin_nontemporal_load((const f32x4*)(sin_ + p * 128 + 64 + c16 * 4)); }
#pragma unroll
                  for (int ii = 0; ii < 4; ++ii) { const int p = 4 * (i0 + ii) + quad;
                    f32x4 h0 = H0[ii], h1 = H1[ii];
                    float yk = 0.f;
#pragma unroll
                    for (int t = 0; t < 4; ++t) { const float xd = xdt[(w * 4 + t) * 64 + p]; float y = 0.f;
#pragma unroll
                        for (int k = 0; k < 4; ++k) { h0[k] = h0[k] * dA[t] + xd * Bv[t][k]; y += h0[k] * Cv[t][k]; h1[k] = h1[k] * dA[t] + xd * Bv[t][4 + k]; y += h1[k] * Cv[t][4 + k]; }
                        y = row16_sum(y);
                        if (c16 == t) yk = y + Dh * xr[(w * 4 + t) * 64 + p]; }
                    __builtin_nontemporal_store(h0, (f32x4*)(sout + p * 128 + c16 * 4)); __builtin_nontemporal_store(h1, (f32x4*)(sout + p * 128 + 64 + c16 * 4));
                    if (c16 < 4) { const float z = bf1(U[(size_t)(R0 + c16) * INW + OZ + h * 64 + p]); vals[(w * 4 + c16) * 64 + p] = yk * siluf_(z); } } }
                __syncthreads();
                if (w < 4) { float s = 0.f;
#pragma unroll
                    for (int hh = 0; hh < 8; ++hh) { const float v = vals[(hh * 4 + w) * 64 + lane]; s += v * v; }
                    s = wave_sum(s); if (lane == 0) rs[w] = rsqrtf(s * (1.f / 512.f) + EPS); }
                __syncthreads();
                { const int t = tid >> 7, ch4 = (tid & 127) * 4, hh = ch4 >> 6, p = ch4 & 63; const float r = rs[t]; const LAS float* vp = vals + (hh * 4 + t) * 64 + p;
                  u32x2 o; o.x = pk2(vp[0] * r, vp[1] * r); o.y = pk2(vp[2] * r, vp[3] * r);
                  *(u32x2*)(U + (size_t)(R0 + t) * INW + OZ + g * 512 + ch4) = o; }
            }
        }
        }
    }
    SEAM(3); STAMP(4);
    if (IN(4)) {
        LOCAL_IDS const int gtid = bx * 512 + tid;
        for (int idx = gtid; idx < 131072; idx += NGT) { const int n8 = idx & 15, p = (idx >> 4) & 63, h = (idx >> 10) & 15, b = idx >> 14;
            float hc[8];
#pragma unroll
            for (int k = 0; k < 8; ++k) hc[k] = 0.f;
            bf16_t* ptr0 = STB + ((size_t)(b * 16 * 16 + h) * 64 + p) * 128 + n8 * 8; u32x4 svv[16]; float dd[16];
#pragma unroll
            for (int c = 0; c < 16; ++c) { svv[c] = __builtin_nontemporal_load((const u32x4*)(ptr0 + (size_t)c * (16 * 8192))); dd[c] = CD[(b * 16 + c) * 16 + h]; }
#pragma unroll
            for (int c = 0; c < 16; ++c) { const u32x4 sv = svv[c];
                u32x4 o; o.x = pk2(hc[0], hc[1]); o.y = pk2(hc[2], hc[3]); o.z = pk2(hc[4], hc[5]); o.w = pk2(hc[6], hc[7]); *(u32x4*)(ptr0 + (size_t)c * (16 * 8192)) = o;
                const float d = dd[c];
                hc[0] = hc[0] * d + bflo(sv.x); hc[1] = hc[1] * d + bfhi(sv.x); hc[2] = hc[2] * d + bflo(sv.y); hc[3] = hc[3] * d + bfhi(sv.y);
                hc[4] = hc[4] * d + bflo(sv.z); hc[5] = hc[5] * d + bfhi(sv.z); hc[6] = hc[6] * d + bflo(sv.w); hc[7] = hc[7] * d + bfhi(sv.w); }
            float* op = out + O_SP + ((size_t)(b * 16 + h) * 64 + p) * 128 + n8 * 8;
            __builtin_nontemporal_store((f32x4){hc[0], hc[1], hc[2], hc[3]}, (f32x4*)op); __builtin_nontemporal_store((f32x4){hc[4], hc[5], hc[6], hc[7]}, (f32x4*)(op + 4)); }
    }
    SEAM(4); STAMP(5);
    if (IN(5)) {
        const float* a_log = kin(12); const float* d_skip = kin(13);
        LAS bf16_t* Cs = (LAS bf16_t*)lds; LAS bf16_t* Bs = (LAS bf16_t*)(lds + 34816); LAS bf16_t* CBs = (LAS bf16_t*)(lds + 69632);
        LAS bf16_t* Xt = (LAS bf16_t*)(lds + 104448 + w * 5120);
        LAS float* acs = (LAS float*)(lds + 145408); LAS float* dts = (LAS float*)(lds + 149504); LAS float* ssq = (LAS float*)(lds + 153600);
        for (int unit = bx; unit < 256; unit += G) {
            LOCAL_IDS const int b = unit >> 5, c = (unit >> 1) & 15, g = unit & 1, row0 = b * SEQ + c * 128, h = 8 * g + w;
            __syncthreads();
            { const float A = -__expf(a_log[h]);
              const float d0 = DT[(size_t)(row0 + lane) * 16 + h], d1 = DT[(size_t)(row0 + 64 + lane) * 16 + h];
              float v0 = d0 * A, v1 = d1 * A;
#pragma unroll
              for (int o = 1; o < 64; o <<= 1) { const float t0 = __builtin_bit_cast(float, __builtin_amdgcn_ds_bpermute((lane - o) << 2, __builtin_bit_cast(int, v0))), t1 = __builtin_bit_cast(float, __builtin_amdgcn_ds_bpermute((lane - o) << 2, __builtin_bit_cast(int, v1))); if (lane >= o) { v0 += t0; v1 += t1; } }
              v1 += __builtin_bit_cast(float, __builtin_amdgcn_readlane(__builtin_bit_cast(int, v0), 63));
              acs[w * 128 + lane] = v0; acs[w * 128 + 64 + lane] = v1; dts[w * 128 + lane] = d0; dts[w * 128 + 64 + lane] = d1; }
#pragma unroll 4
            for (int pc = tid; pc < 2048; pc += 512) { const int lr = pc >> 4, part = pc & 15; const bf16_t* rp = XC + (size_t)(row0 + lr) * CONVD + 1024 + g * 128 + part * 8;
                *(LAS u32x4*)(Bs + lr * 136 + part * 8) = __builtin_nontemporal_load((const u32x4*)rp); *(LAS u32x4*)(Cs + lr * 136 + part * 8) = __builtin_nontemporal_load((const u32x4*)(rp + 256)); }
            __syncthreads();
            {
                bf16x8 bfr[4];
#pragma unroll
                for (int ks = 0; ks < 4; ++ks) bfr[ks] = *(const LAS bf16x8*)(Bs + (16 * w + c16) * 136 + ks * 32 + quad * 8);
#pragma unroll
                for (int lt = 0; lt < 8; ++lt) { f32x4 d = (f32x4){0.f, 0.f, 0.f, 0.f};
#pragma unroll
                    for (int ks = 0; ks < 4; ++ks) { const bf16x8 cfr = *(const LAS bf16x8*)(Cs + (lt * 16 + c16) * 136 + ks * 32 + quad * 8); d = MFMA16(bfr[ks], cfr, d); }
                    u32x2 o; o.x = pk2(d[0], d[1]); o.y = pk2(d[2], d[3]); *(LAS u32x2*)(CBs + (lt * 16 + c16) * 136 + 16 * w + quad * 4) = o; }
            }
            __syncthreads();
            f32x4 acc[4][8];
#pragma unroll
            for (int pt = 0; pt < 4; ++pt)
#pragma unroll
                for (int lt = 0; lt < 8; ++lt) acc[pt][lt] = (f32x4){0.f, 0.f, 0.f, 0.f};
            const bf16_t* Hp = STB + (size_t)((b * 16 + c) * 16 + h) * 8192;
#pragma unroll
            for (int kh = 0; kh < 2; ++kh) { bf16x8 hf[2][4];
#pragma unroll
              for (int k2 = 0; k2 < 2; ++k2)
#pragma unroll
                for (int pt = 0; pt < 4; ++pt) hf[k2][pt] = __builtin_nontemporal_load((const bf16x8*)(Hp + (pt * 16 + c16) * 128 + (kh * 2 + k2) * 32 + quad * 8));
#pragma unroll
              for (int k2 = 0; k2 < 2; ++k2) {
#pragma unroll
                for (int lt = 0; lt < 8; ++lt) { const bf16x8 cfr = *(const LAS bf16x8*)(Cs + (lt * 16 + c16) * 136 + (kh * 2 + k2) * 32 + quad * 8);
#pragma unroll
                    for (int pt = 0; pt < 4; ++pt) acc[pt][lt] = MFMA16(hf[k2][pt], cfr, acc[pt][lt]); }
                asm volatile("" ::: "memory"); } }
#pragma unroll
            for (int lt = 0; lt < 8; ++lt) { const float e = __expf(acs[w * 128 + lt * 16 + c16]);
#pragma unroll
                for (int pt = 0; pt < 4; ++pt) acc[pt][lt] = acc[pt][lt] * e; }
            __builtin_amdgcn_sched_barrier(0);
            u32x4 xq[4][4];
#pragma unroll
            for (int k = 0; k < 4; ++k) { const int pc = lane + 64 * k, sr = pc >> 3, part = pc & 7; xq[0][k] = __builtin_nontemporal_load((const u32x4*)(XC + (size_t)(row0 + sr) * CONVD + h * 64 + part * 8)); }
#pragma unroll
            for (int sq = 0; sq < 4; ++sq) {
                asm volatile("s_waitcnt lgkmcnt(0)" ::: "memory");
#pragma unroll
                for (int k = 0; k < 4; ++k) { const int pc = lane + 64 * k, sr = pc >> 3, part = pc & 7; *(LAS u32x4*)(Xt + sr * 72 + part * 8) = xq[sq][k]; }
                if (sq < 3) {
#pragma unroll
                    for (int k = 0; k < 4; ++k) { const int pc = lane + 64 * k, sr = pc >> 3, part = pc & 7; xq[sq + 1][k] = __builtin_nontemporal_load((const u32x4*)(XC + (size_t)(row0 + (sq + 1) * 32 + sr) * CONVD + h * 64 + part * 8)); } }
                asm volatile("s_waitcnt lgkmcnt(0)" ::: "memory");
                bf16x8 xf[4]; tr_frag4<0, 32, 64, 96, 4 * 144>(LDSADDR(Xt) + (unsigned)(((quad * 8 + (c16 >> 2)) * 72 + 4 * (c16 & 3)) * 2), xf);
                const f32x4 as0 = *(const LAS f32x4*)(acs + w * 128 + sq * 32 + quad * 8), as1 = *(const LAS f32x4*)(acs + w * 128 + sq * 32 + quad * 8 + 4);
                const f32x4 ds0 = *(const LAS f32x4*)(dts + w * 128 + sq * 32 + quad * 8), ds1 = *(const LAS f32x4*)(dts + w * 128 + sq * 32 + quad * 8 + 4);
#pragma unroll
                for (int lt = 0; lt < 8; ++lt) { if (lt >= 2 * sq) {
                    const int l = lt * 16 + c16; const float al = acs[w * 128 + l];
                    const u32x4 cb = *(const LAS u32x4*)(CBs + l * 136 + sq * 32 + quad * 8);
                    const int s0 = sq * 32 + quad * 8;
                    float wv[8];
                    wv[0] = bflo(cb.x); wv[1] = bfhi(cb.x); wv[2] = bflo(cb.y); wv[3] = bfhi(cb.y); wv[4] = bflo(cb.z); wv[5] = bfhi(cb.z); wv[6] = bflo(cb.w); wv[7] = bfhi(cb.w);
#pragma unroll
                    for (int i = 0; i < 4; ++i) { wv[i] = (s0 + i <= l) ? wv[i] * __expf(fminf(al - as0[i], 0.f)) * ds0[i] : 0.f; wv[4 + i] = (s0 + 4 + i <= l) ? wv[4 + i] * __expf(fminf(al - as1[i], 0.f)) * ds1[i] : 0.f; }
                    u32x4 ww; ww.x = pk2(wv[0], wv[1]); ww.y = pk2(wv[2], wv[3]); ww.z = pk2(wv[4], wv[5]); ww.w = pk2(wv[6], wv[7]);
                    const bf16x8 wf = __builtin_bit_cast(bf16x8, ww);
#pragma unroll
                    for (int pt = 0; pt < 4; ++pt) acc[pt][lt] = MFMA16(xf[pt], wf, acc[pt][lt]);
                    asm volatile("" ::: "memory"); } }
            }
            const float Dh = d_skip[h];
#pragma unroll
            for (int lt = 0; lt < 8; ++lt) { const int l = lt * 16 + c16; const size_t tok = (size_t)(row0 + l); float ss = 0.f;
#pragma unroll
                for (int pt = 0; pt < 4; ++pt) { const int pb = pt * 16 + quad * 4;
                    const u32x2 xv = *(const u32x2*)(XC + tok * CONVD + h * 64 + pb), zv = *(const u32x2*)(U + tok * INW + OZ + h * 64 + pb);
                    const float xf0 = bflo(xv.x), xf1 = bfhi(xv.x), xf2 = bflo(xv.y), xf3 = bfhi(xv.y);
                    const float z0 = bflo(zv.x), z1 = bfhi(zv.x), z2 = bflo(zv.y), z3 = bfhi(zv.y);
                    f32x4 v = acc[pt][lt];
                    v[0] = (v[0] + Dh * xf0) * siluf_(z0); v[1] = (v[1] + Dh * xf1) * siluf_(z1); v[2] = (v[2] + Dh * xf2) * siluf_(z2); v[3] = (v[3] + Dh * xf3) * siluf_(z3);
                    acc[pt][lt] = v; ss += (v[0] * v[0] + v[1] * v[1]) + (v[2] * v[2] + v[3] * v[3]); }
                ss += __shfl_xor(ss, 16); ss += __shfl_xor(ss, 32);
                if (quad == 0) ssq[w * 128 + l] = ss;
                if (lt & 1) asm volatile("" ::: "memory"); }
            __syncthreads();
#pragma unroll
            for (int lt = 0; lt < 8; ++lt) { const int l = lt * 16 + c16; const size_t tok = (size_t)(row0 + l); float s = 0.f;
#pragma unroll
                for (int ww = 0; ww < 8; ++ww) s += ssq[ww * 128 + l];
                const float r = rsqrtf(s * (1.f / 512.f) + EPS);
#pragma unroll
                for (int pt = 0; pt < 4; ++pt) { const f32x4 v = acc[pt][lt] * r; u32x2 o; o.x = pk2(v[0], v[1]); o.y = pk2(v[2], v[3]);
                    *(u32x2*)(U + tok * INW + OZ + h * 64 + pt * 16 + quad * 4) = o; }
                asm volatile("" ::: "memory"); }
        }
    }
    SEAM(5); STAMP(6);
    if (IN(6)) {
        { pg8::Gemm g{U, WOA, M, DM, 1536, INW, 1536}; pg8::StaticOrder S; S.init(MP, DM, G, bx, 6, 2); EpiGate2 E{U, MERGED}; pg8::gemm_phase<EpiGate2, 256, 244 * MiB, -1, 8>(lds, g, S, E); }
    }
    SEAM(6); STAMP(7);
    if (IN(7)) {
        const float* x_p = kin(0);
        {
            LOCAL_IDS const float* pa = (const float*)(ws + 244 * MiB);
            for (int e4 = bx * 512 + tid; e4 < 512 * 256; e4 += NGT) { const int row = e4 >> 8, c4 = (e4 & 255) * 4;
                f32x4 sa = (f32x4){0.f, 0.f, 0.f, 0.f}, sb = (f32x4){0.f, 0.f, 0.f, 0.f};
#pragma unroll
                for (int sl = 0; sl < 6; ++sl) { const f32x4 v = *(const f32x4*)(pa + ((size_t)sl * 512 + row) * DM + c4); if (sl < 2) sa += v; else sb += v; }
                const bf16_t* up = U + (size_t)(MP + row) * INW; const u32x2 ga = *(const u32x2*)(up + OGA + c4), gb = *(const u32x2*)(up + OGB + c4);
                u32x2 o; o.x = pk2(sigmoidf_(bflo(ga.x)) * sa[0] + sigmoidf_(bflo(gb.x)) * sb[0], sigmoidf_(bfhi(ga.x)) * sa[1] + sigmoidf_(bfhi(gb.x)) * sb[1]);
                o.y = pk2(sigmoidf_(bflo(ga.y)) * sa[2] + sigmoidf_(bflo(gb.y)) * sb[2], sigmoidf_(bfhi(ga.y)) * sa[3] + sigmoidf_(bfhi(gb.y)) * sb[3]);
                st_wt8(MERGED + (size_t)(MP + row) * DM + c4, o.x, o.y); }
            SOFT_ARRIVE(0); }
        pg8::Gemm g{MERGED, WO, M, DM, DM, DM, DM}; pg8::StaticOrder S; S.init(MP, DM, G, bx, 4, 2);
        EpiRes<1> E{x_p, X1B, SSQ2}; pg8::gemm_phase<EpiRes<1>, 256, 244 * MiB, 0>(lds, g, S, E);
    }
    SEAM(7); STAMP(8);
    if (IN(8)) {
        {
            LOCAL_IDS const float* x_s = kin(1); const float* p4 = (const float*)(ws + 244 * MiB);
            for (int row = gw; row < 512; row += NGW) { float ss = 0.f;
#pragma unroll
                for (int j = 0; j < 4; ++j) { const int c = lane * 4 + 256 * j; f32x4 v = *(const f32x4*)(x_s + (size_t)row * DM + c);
#pragma unroll
                    for (int sl = 0; sl < 4; ++sl) v += *(const f32x4*)(p4 + ((size_t)sl * 512 + row) * DM + c);
                    st_wt8(X1B + (size_t)(MP + row) * DM + c, pk2(v[0], v[1]), pk2(v[2], v[3]));
                    ss += (v[0] * v[0] + v[1] * v[1]) + (v[2] * v[2] + v[3] * v[3]); }
                ss = wave_sum(ss); if (lane == 0) __hip_atomic_store(SSQ2 + MP + row, ss, __ATOMIC_RELAXED, __HIP_MEMORY_SCOPE_AGENT); }
            SOFT_ARRIVE(1); }
        pg8::Gemm g{X1B, WUP, M, DFF, DM, DM, DM}; pg8::StaticOrder S; S.init(MP, DFF, G, bx, 4, 2);
        EpiUp E{SSQ2, ACT}; pg8::gemm_phase<EpiUp, 256, WS_MERGED, 1, -1, true>(lds, g, S, E);
    }
    SEAM(8); STAMP(9);
    if (IN(9)) {
        {
            LOCAL_IDS const bf16_t* p5 = (const bf16_t*)(ws + WS_MERGED);
            for (int e4 = bx * 512 + tid; e4 < 512 * 1024; e4 += NGT) { const int row = e4 >> 10, c4 = (e4 & 1023) * 4;
                f32x4 v = (f32x4){0.f, 0.f, 0.f, 0.f};
#pragma unroll
                for (int sl = 0; sl < 4; ++sl) { const u32x2 pv = *(const u32x2*)(p5 + ((size_t)sl * 512 + row) * DFF + c4); v += (f32x4){bflo(pv.x), bfhi(pv.x), bflo(pv.y), bfhi(pv.y)}; }
                const float rs = rsqrtf(SSQ2[MP + row] * (1.f / DM) + EPS);
#pragma unroll
                for (int i = 0; i < 4; ++i) { const float t = fmaxf(v[i] * rs, 0.f); v[i] = t * t; }
                st_wt8(ACT + (size_t)(MP + row) * DFF + c4, pk2(v[0], v[1]), pk2(v[2], v[3])); }
            SOFT_ARRIVE(2); }
        pg8::Gemm g{ACT, WDN, M, DM, DFF, DFF, DFF}; pg8::StaticOrder S; S.init(MP, DM, G, bx, 16, 2);
        EpiRes<0> E{nullptr, X1B, nullptr}; pg8::gemm_phase<EpiRes<0>, 256, WS_MERGED, 2, -1, true>(lds, g, S, E);
    }
    SEAM(9); STAMP(10);
    if (IN(10)) {
        const float* final_norm = kin(21);
        LOCAL_IDS
        const bf16_t* p6 = (const bf16_t*)(ws + WS_MERGED);
#pragma unroll 2
        for (int m = gw; m < M; m += NGW) { float* xr = X1 + (size_t)m * DM; f32x4 v[4]; float ss = 0.f;
#pragma unroll
            for (int j = 0; j < 4; ++j) { const int cidx = lane * 4 + 256 * j; const u32x2 pv = *(const u32x2*)(X1B + (size_t)m * DM + cidx); v[j] = (f32x4){bflo(pv.x), bfhi(pv.x), bflo(pv.y), bfhi(pv.y)};
                if (m >= MP) {
#pragma unroll
                    for (int sl = 0; sl < 16; ++sl) { const u32x2 qv = *(const u32x2*)(p6 + ((size_t)sl * 512 + (m - MP)) * DM + cidx); v[j] += (f32x4){bflo(qv.x), bfhi(qv.x), bflo(qv.y), bfhi(qv.y)}; } }
                ss += (v[j][0] * v[j][0] + v[j][1] * v[j][1]) + (v[j][2] * v[j][2] + v[j][3] * v[j][3]); }
            const float r = rsqrtf(wave_sum(ss) * (1.f / DM) + EPS);
#pragma unroll
            for (int j = 0; j < 4; ++j) { const int cidx = lane * 4 + 256 * j; const f32x4 fw = *(const f32x4*)(final_norm + cidx); __builtin_nontemporal_store(v[j] * r * fw, (f32x4*)(xr + cidx)); } }
    }
#ifdef PROBE_A
    STAMP(11);
    if (bx == 0 && tid0 == 0) { asm volatile("s_waitcnt vmcnt(0)" ::: "memory"); const float us = (float)(tstamp[PROBE_B] - tstamp[PROBE_A]) * 0.01f; out[0] = out[0] + 16.f + us * (1.f / PROBE_SCALE); }
#endif
#undef IN
#undef SEAM
}

#ifndef N_LAUNCH_MODE
#define N_LAUNCH_MODE 1
#endif
extern "C" void kernel_launch(void* const* d_in, const int* in_sizes, int n_in, void* d_out, int out_size, void* d_ws, size_t ws_size, hipStream_t stream) {
    static int grid = 0;
    if (grid == 0) {
        int dev = 0, cus = 0, per_cu = 0;
        hipGetDevice(&dev); hipDeviceGetAttribute(&cus, hipDeviceAttributeMultiprocessorCount, dev);
        if (hipFuncSetAttribute((const void*)mega, hipFuncAttributeMaxDynamicSharedMemorySize, LDS_BYTES) != hipSuccess) { fprintf(stderr, "hipFuncSetAttribute failed\n"); }
        if (hipOccupancyMaxActiveBlocksPerMultiprocessor(&per_cu, (const void*)mega, 512, LDS_BYTES) != hipSuccess || per_cu < 1) { fprintf(stderr, "occupancy query: %d\n", per_cu); per_cu = 1; }
        (void)hipGetLastError();
        grid = cus * 1;
        if (grid <= 0) grid = 256;
    }
    (void)hipMemsetAsync((unsigned char*)d_ws + WS_BAR, 0, 1024 + XCD_BAR_WORDS * 4, stream);
    Args a{};
    for (int i = 0; i < 22; ++i) a.in[i] = (const float*)d_in[i];
    a.out = (float*)d_out; a.ws = (unsigned char*)d_ws;
#if N_LAUNCH_MODE == 1
    a.ph_lo = 0; a.ph_hi = 11;
    void* args[] = {&a};
    hipError_t e = hipLaunchCooperativeKernel((const void*)mega, dim3(grid), dim3(512), args, LDS_BYTES, stream);
    if (e != hipSuccess) fprintf(stderr, "cooperative launch failed: %s (grid %d)\n", hipGetErrorString(e), grid);
#else
    for (int p = 0; p < 11; ++p) { a.ph_lo = p; a.ph_hi = p + 1; hipLaunchKernelGGL(mega, dim3(grid), dim3(512), LDS_BYTES, stream, a); }
#endif
}
```

```cpp
#include <hip/hip_runtime.h>
#include <hip/hip_cooperative_groups.h>
#include <cstdio>
#include <cstdint>
namespace cg = cooperative_groups;

#define LAS __attribute__((address_space(3)))
typedef unsigned short bf16_t;
typedef short bf16x8 __attribute__((ext_vector_type(8)));
typedef float f32x4 __attribute__((ext_vector_type(4)));
typedef float f32x2 __attribute__((ext_vector_type(2)));
typedef unsigned u32x4 __attribute__((ext_vector_type(4)));
typedef unsigned u32x2 __attribute__((ext_vector_type(2)));

constexpr int DM = 1024, MP = 16384, MS = 512, M = MP + MS, SEQ = 2048, NBATCH = 8, DBATCH = 128;
constexpr int INW = 5392, NPAD = 5632, DFF = 4096, CONVD = 1536;
constexpr int OQ = 0, OZ = 512, OKK = 1536, OV = 1664, OX = 1792, ODT = 3328, OGA = 3344, OGB = 4368;
constexpr float EPS = 1e-6f;
constexpr size_t O_YP = 0, O_YS = 16777216, O_KP = 17301504, O_VP = 17432576, O_CP = 17563648, O_SP = 17600512,
                 O_KS = 18649088, O_VS = 20746240, O_CS = 22843392, O_SS = 23433216;
constexpr size_t MiB = 1u << 20;
constexpr size_t WS_RSTD1 = 0, WS_SSQ2 = 128 * 1024, WS_SSQF = 256 * 1024, WS_CD = 384 * 1024, WS_BAR = 512 * 1024, WS_XB = 512 * 1024 + 1024;
constexpr size_t WS_WIN = 1 * MiB, WS_WOA = 12 * MiB, WS_WOB = 13 * MiB, WS_WO = 15 * MiB, WS_DT = 17 * MiB;
constexpr size_t WS_U = 20 * MiB;
constexpr size_t WS_X1B = 20 * MiB, WS_ACT = 54 * MiB;
constexpr size_t WS_XC = 194 * MiB;
constexpr size_t WS_MERGED = 194 * MiB, WS_WUP = 227 * MiB, WS_WDN = 235 * MiB;
constexpr int LDS_BYTES = 163840;

__device__ __forceinline__ int opaque(int x) { asm volatile("" : "+v"(x)); return x; }
__device__ __forceinline__ unsigned f2bf(float f) { unsigned u = __builtin_bit_cast(unsigned, f); return (u + 0x7fffu + ((u >> 16) & 1u)) >> 16; }
typedef __bf16 bf16x2_t __attribute__((ext_vector_type(2)));
__device__ __forceinline__ unsigned pk2(float lo, float hi) { const f32x2 v = {lo, hi}; const bf16x2_t b = __builtin_convertvector(v, bf16x2_t); return __builtin_bit_cast(unsigned, b); }
__device__ __forceinline__ unsigned cvt_pk_bf16(float lo, float hi) { return pk2(lo, hi); }
__device__ __forceinline__ float bflo(unsigned w) { return __builtin_bit_cast(float, w << 16); }
__device__ __forceinline__ float bfhi(unsigned w) { return __builtin_bit_cast(float, w & 0xffff0000u); }
__device__ __forceinline__ float bf1(bf16_t h) { return __builtin_bit_cast(float, (unsigned)h << 16); }
__device__ __forceinline__ float sigmoidf_(float x) { return __builtin_amdgcn_rcpf(1.f + __expf(-x)); }
__device__ __forceinline__ float siluf_(float x) { return x * __builtin_amdgcn_rcpf(1.f + __expf(-x)); }
__device__ __forceinline__ void st_wt8(void* p, unsigned lo, unsigned hi) { __hip_atomic_store((unsigned long long*)p, ((unsigned long long)hi << 32) | lo, __ATOMIC_RELAXED, __HIP_MEMORY_SCOPE_AGENT); }
__device__ __forceinline__ float row16_sum(float v) {
    v += __builtin_bit_cast(float, __builtin_amdgcn_update_dpp(0, __builtin_bit_cast(int, v), 0xB1, 0xF, 0xF, true));
    v += __builtin_bit_cast(float, __builtin_amdgcn_update_dpp(0, __builtin_bit_cast(int, v), 0x4E, 0xF, 0xF, true));
    v += __builtin_bit_cast(float, __builtin_amdgcn_update_dpp(0, __builtin_bit_cast(int, v), 0x141, 0xF, 0xF, true));
    v += __builtin_bit_cast(float, __builtin_amdgcn_update_dpp(0, __builtin_bit_cast(int, v), 0x140, 0xF, 0xF, true));
    return v;
}
__device__ __forceinline__ float wave_sum(float v) { v = row16_sum(v); v += __shfl_xor(v, 16); v += __shfl_xor(v, 32); return v; }
#define LDS_WAIT() asm volatile("s_waitcnt lgkmcnt(0)" ::: "memory")
#define MFMA16(a, b, c) __builtin_amdgcn_mfma_f32_16x16x32_bf16(a, b, c, 0, 0, 0)

template <int O0, int O1, int O2, int O3, int D> __device__ __forceinline__ void tr_frag4(unsigned addr, bf16x8 (&f)[4]) {
    u32x2 a0, b0, a1, b1, a2, b2, a3, b3;
    asm volatile("ds_read_b64_tr_b16 %0, %8 offset:%9\n\tds_read_b64_tr_b16 %1, %8 offset:%10\n\tds_read_b64_tr_b16 %2, %8 offset:%11\n\tds_read_b64_tr_b16 %3, %8 offset:%12\n\t"
                 "ds_read_b64_tr_b16 %4, %8 offset:%13\n\tds_read_b64_tr_b16 %5, %8 offset:%14\n\tds_read_b64_tr_b16 %6, %8 offset:%15\n\tds_read_b64_tr_b16 %7, %8 offset:%16\n\ts_waitcnt lgkmcnt(0)"
                 : "=&v"(a0), "=&v"(b0), "=&v"(a1), "=&v"(b1), "=&v"(a2), "=&v"(b2), "=&v"(a3), "=&v"(b3)
                 : "v"(addr), "i"(O0), "i"(O0 + D), "i"(O1), "i"(O1 + D), "i"(O2), "i"(O2 + D), "i"(O3), "i"(O3 + D) : "memory");
    f[0] = __builtin_bit_cast(bf16x8, (u32x4){a0.x, a0.y, b0.x, b0.y}); f[1] = __builtin_bit_cast(bf16x8, (u32x4){a1.x, a1.y, b1.x, b1.y});
    f[2] = __builtin_bit_cast(bf16x8, (u32x4){a2.x, a2.y, b2.x, b2.y}); f[3] = __builtin_bit_cast(bf16x8, (u32x4){a3.x, a3.y, b3.x, b3.y});
}
#define LDSADDR(p) ((unsigned)(size_t)(p))

__device__ __forceinline__ const float* kin(int k) {
    const __attribute__((address_space(4))) unsigned char* ka = (const __attribute__((address_space(4))) unsigned char*)__builtin_amdgcn_kernarg_segment_ptr();
    asm volatile("" : "+s"(ka));
    return *(const float* const __attribute__((address_space(4)))*)(ka + 8 * k);
}
__device__ __forceinline__ unsigned char* kws() { return (unsigned char*)kin(23); }

namespace pg8 {
constexpr int BM = 256, BK = 64, HALF = 128, HTB = HALF * BK * 2, STAGE_BYTES = 8 * HTB, NXCD = 8, WGM = 8;
__host__ __device__ __forceinline__ int lds_byte(int r, int c) { const int st = (r >> 4) * 2 + (c >> 5), rr = r & 15, cc = c & 31, ob = rr * 64 + cc * 2; return st * 1024 + (ob ^ (((ob >> 9) & 1) << 5)); }
__host__ __device__ __forceinline__ void stage_rc(int b, int& R, int& C) { const int st = b / 1024, sb = b % 1024, swz = sb ^ (((sb >> 9) & 1) << 5); R = (st >> 1) * 16 + swz / 64; C = (st & 1) * 32 + (swz % 64) / 2; }
__host__ __device__ __forceinline__ int perm32(int rho) { const int n = rho >> 4, i = rho & 15; return 8 * (i >> 2) + 4 * n + (i & 3); }
struct Unit { int pm, pn, ks, split; };
struct Gemm { const bf16_t* A; const bf16_t* Bt; int M, N, K, lda, ldb; };
struct StaticOrder {
    int nM, nN, nwg, G, c, S, Q;
    __device__ __forceinline__ void init(int M_, int N_, int G_, int c_, int S_ = 1, int sample_mtiles = 0) { nM = M_ / BM; nN = N_ / BM; nwg = nM * nN; G = G_; c = c_; S = S_; Q = sample_mtiles * nN * S_; }
    __device__ __forceinline__ bool next(int i, Unit& u) const {
        const long L = (long)i * G + c; const bool isS = L >= nwg; const int q = isS ? (int)(L - nwg) : 0;
        if (isS && q >= Q) return false;
        int wgid = isS ? 0 : (int)L; { const int qq = nwg / NXCD, r = nwg % NXCD, xcd = wgid % NXCD, off = wgid / NXCD; wgid = (xcd < r ? xcd * (qq + 1) : r * (qq + 1) + (xcd - r) * qq) + off; }
        const int nig = WGM * nN, gid = wgid / nig, fm = gid * WGM, gsz = (nM - fm) < WGM ? (nM - fm) : WGM;
        const int pmF = fm + ((wgid % nig) % gsz), pnF = (wgid % nig) / gsz;
        const int tile = q / S;
        u.pm = isS ? nM + tile / nN : pmF; u.pn = isS ? tile % nN : pnF; u.ks = isS ? q - tile * S : 0; u.split = isS ? 1 : 0;
        return true;
    }
};
template <class Epi, int KSL = 128, size_t PART_OFF = 0, int SOFT_IDX = -1, int MID_T = -1, bool PART_BF16 = false>
__device__ __forceinline__ void gemm_phase(LAS unsigned char* lds, const Gemm g, const StaticOrder& S, const Epi& E) {
    const int tid = opaque((int)threadIdx.x), wid = __builtin_amdgcn_readfirstlane(tid >> 6), lane = tid & 63, wr = wid >> 2, wc = wid & 3, fr = lane & 15, fq = lane >> 4;
    const int ntF = g.K / BK; constexpr int ntS = KSL / BK; constexpr size_t ksbytes = (size_t)KSL * 2;
    unsigned voffA[2], voffB[2];
#pragma unroll
    for (int i = 0; i < 2; ++i) { int R, C; stage_rc(tid * 16 + i * 8192, R, C); const int Rb = (R & ~31) + perm32(R & 31);
        voffA[i] = (unsigned)(R * g.lda + C) * 2u; voffB[i] = (unsigned)(Rb * g.ldb + C) * 2u; }
    const size_t kstep = (size_t)(BK * 2);
    const size_t hstepA = (size_t)HALF * g.lda * 2, hstepB = (size_t)HALF * g.ldb * 2;
    const size_t tstepA = 2 * hstepA, tstepB = 2 * hstepB;
    const unsigned ldsw = (unsigned)wid * 1024u;
    const int aoff = lds_byte(wr * 64 + fr, fq * 8), boff = lds_byte(wc * 32 + fr, fq * 8);
#define PG8_SA(b, h) (((b) * 2 + (h)) * HTB)
#define PG8_SB(b, h) ((4 + (b) * 2 + (h)) * HTB)
#define PG8_STAGE(bufoff, gbase, voff) do { _Pragma("unroll") for (int _i = 0; _i < 2; ++_i) \
        __builtin_amdgcn_global_load_lds((const unsigned*)((const char*)(gbase) + (voff)[_i]), (LAS unsigned*)(lds + (bufoff) + ldsw + _i * 8192), 16, 0, 0); } while (0)
#define PG8_LDA(dst, b, h) do { _Pragma("unroll") for (int m = 0; m < 4; ++m) _Pragma("unroll") for (int k = 0; k < 2; ++k) dst[m][k] = *(const LAS bf16x8*)(lds + PG8_SA(b, h) + aoff + m * 2048 + k * 1024); } while (0)
#define PG8_LDB(dst, b, h) do { _Pragma("unroll") for (int n = 0; n < 2; ++n) _Pragma("unroll") for (int k = 0; k < 2; ++k) dst[n][k] = *(const LAS bf16x8*)(lds + PG8_SB(b, h) + boff + n * 2048 + k * 1024); } while (0)
#define PG8_MMA(ai, bj, At, Bt) do { __builtin_amdgcn_s_setprio(1); _Pragma("unroll") for (int m = 0; m < 4; ++m) _Pragma("unroll") for (int n = 0; n < 2; ++n) _Pragma("unroll") for (int k = 0; k < 2; ++k) \
        acc[ai][bj][m][n] = __builtin_amdgcn_mfma_f32_16x16x32_bf16(Bt[n][k], At[m][k], acc[ai][bj][m][n], 0, 0, 0); __builtin_amdgcn_s_setprio(0); } while (0)
#define PG8_WAIT_V(n) asm volatile("s_waitcnt vmcnt(" #n ")" ::: "memory")
#define PG8_WAIT_L(n) asm volatile("s_waitcnt lgkmcnt(" #n ")" ::: "memory")
#define PG8_BAR __builtin_amdgcn_s_barrier()
#define PG8_SCHED __builtin_amdgcn_sched_barrier(0)
    Unit cur, nxt; int ui = 0;
    if (!S.next(0, cur)) return;
    float pre[8];
#pragma unroll
    for (int e = 0; e < 8; ++e) pre[e] = 0.f;
    f32x4 acc[2][2][4][2];
#pragma unroll
    for (int a = 0; a < 2; ++a)
#pragma unroll
        for (int b = 0; b < 2; ++b)
#pragma unroll
            for (int m = 0; m < 4; ++m)
#pragma unroll
                for (int n = 0; n < 2; ++n) acc[a][b][m][n] = (f32x4){0.f, 0.f, 0.f, 0.f};
    bf16x8 At[4][2], B0[2][2], B1[2][2];
    const char* cA = (const char*)g.A + (size_t)cur.pm * tstepA + (cur.split ? cur.ks * ksbytes : 0); const char* cB = (const char*)g.Bt + (size_t)cur.pn * tstepB + (cur.split ? cur.ks * ksbytes : 0);
    PG8_STAGE(PG8_SB(0, 0), cB, voffB); PG8_STAGE(PG8_SB(0, 1), cB + hstepB, voffB); PG8_STAGE(PG8_SA(0, 0), cA, voffA); PG8_STAGE(PG8_SA(0, 1), cA + hstepA, voffA);
    if (wr == 1) PG8_BAR;
    PG8_WAIT_V(2); PG8_BAR;
    PG8_STAGE(PG8_SB(1, 0), cB + kstep, voffB); PG8_STAGE(PG8_SA(1, 0), cA + kstep, voffA); PG8_STAGE(PG8_SB(1, 1), cB + hstepB + kstep, voffB);
    PG8_WAIT_V(6); PG8_BAR;
    for (;;) {
        const bool has_next = S.next(ui + 1, nxt);
        const char* nA = has_next ? (const char*)g.A + (size_t)nxt.pm * tstepA + (nxt.split ? nxt.ks * ksbytes : 0) : cA; const char* nB = has_next ? (const char*)g.Bt + (size_t)nxt.pn * tstepB + (nxt.split ? nxt.ks * ksbytes : 0) : cB;
        const int nt = cur.split ? ntS : ntF;
        if (SOFT_IDX >= 0 && has_next && nxt.split && !cur.split) {
            if (tid == 0) { unsigned* sw = (unsigned*)(kws() + WS_BAR) + 64 + SOFT_IDX; unsigned sp = 0;
                while (__hip_atomic_load(sw, __ATOMIC_RELAXED, __HIP_MEMORY_SCOPE_AGENT) < (unsigned)gridDim.x) { __builtin_amdgcn_s_sleep(2); if (++sp > (1u << 22)) break; }
                __builtin_amdgcn_fence(__ATOMIC_ACQUIRE, "agent"); }
            PG8_BAR; }
        for (int t = 0; t < nt; t += 2) {
            const bool last = (t == nt - 2);
            if (MID_T >= 0 && t == MID_T && !cur.split) { PG8_SCHED; E.mid(acc, cur, wr, wc, fr, fq); PG8_SCHED; }
            if (last && !cur.split) E.prefetch(pre, cur, wr, fr);
            const char* a1 = cA + (size_t)(t + 1) * kstep;
            const char* a2 = last ? nA : cA + (size_t)(t + 2) * kstep; const char* b2 = last ? nB : cB + (size_t)(t + 2) * kstep;
            const char* a3 = a2 + kstep; const char* b3 = b2 + kstep;
            PG8_LDB(B0, 0, 0); PG8_LDB(B1, 0, 1); PG8_SCHED; PG8_LDA(At, 0, 0); PG8_STAGE(PG8_SA(1, 1), a1 + hstepA, voffA);
            PG8_WAIT_V(8); PG8_WAIT_L(0); PG8_BAR; PG8_MMA(0, 0, At, B0); PG8_MMA(0, 1, At, B1); PG8_BAR; PG8_SCHED;
            PG8_LDA(At, 0, 1); PG8_STAGE(PG8_SB(0, 0), b2, voffB); PG8_STAGE(PG8_SB(0, 1), b2 + hstepB, voffB); PG8_STAGE(PG8_SA(0, 0), a2, voffA);
            PG8_WAIT_V(8); PG8_WAIT_L(0); PG8_BAR; PG8_MMA(1, 0, At, B0); PG8_MMA(1, 1, At, B1); PG8_BAR; PG8_SCHED;
            PG8_LDB(B0, 1, 0); PG8_LDB(B1, 1, 1); PG8_SCHED; PG8_LDA(At, 1, 0); PG8_STAGE(PG8_SA(0, 1), a2 + hstepA, voffA);
            PG8_WAIT_V(8); PG8_WAIT_L(0); PG8_BAR; PG8_MMA(0, 0, At, B0); PG8_MMA(0, 1, At, B1); PG8_BAR; PG8_SCHED;
            PG8_LDA(At, 1, 1); PG8_STAGE(PG8_SB(1, 0), b3, voffB); PG8_STAGE(PG8_SB(1, 1), b3 + hstepB, voffB); PG8_STAGE(PG8_SA(1, 0), a3, voffA);
            PG8_WAIT_V(8); PG8_WAIT_L(0); PG8_BAR; PG8_MMA(1, 0, At, B0); PG8_MMA(1, 1, At, B1); PG8_BAR; PG8_SCHED;
        }
        if (wr == 0) PG8_BAR;
        if (cur.split) {
            const size_t pidx = ((size_t)cur.ks * 512 + (cur.pm - S.nM) * 256 + wr * 64 + fr) * g.N + cur.pn * 256 + wc * 32 + 8 * fq;
            if (PART_BF16) {
                bf16_t* pp = (bf16_t*)(kws() + PART_OFF) + pidx;
#pragma unroll
                for (int a = 0; a < 2; ++a)
#pragma unroll
                    for (int m = 0; m < 4; ++m)
#pragma unroll
                        for (int b = 0; b < 2; ++b) { const f32x4 v0 = acc[a][b][m][0], v1 = acc[a][b][m][1]; u32x4 w; w.x = pk2(v0[0], v0[1]); w.y = pk2(v0[2], v0[3]); w.z = pk2(v1[0], v1[1]); w.w = pk2(v1[2], v1[3]);
                            *(u32x4*)(pp + (size_t)(a * 128 + m * 16) * g.N + b * 128) = w; }
            } else {
            float* pp = (float*)(kws() + PART_OFF) + pidx;
#pragma unroll
            for (int a = 0; a < 2; ++a)
#pragma unroll
                for (int m = 0; m < 4; ++m)
#pragma unroll
                    for (int b = 0; b < 2; ++b) { float* q = pp + (size_t)(a * 128 + m * 16) * g.N + b * 128; *(f32x4*)q = acc[a][b][m][0]; *(f32x4*)(q + 4) = acc[a][b][m][1]; }
            }
        } else E(acc, cur, wr, wc, fr, fq, 0, 8, pre);
        if (!has_next) break;
#pragma unroll
        for (int a = 0; a < 2; ++a)
#pragma unroll
            for (int b = 0; b < 2; ++b)
#pragma unroll
                for (int m = 0; m < 4; ++m)
#pragma unroll
                    for (int n = 0; n < 2; ++n) acc[a][b][m][n] = (f32x4){0.f, 0.f, 0.f, 0.f};
        cur = nxt; cA = nA; cB = nB; ++ui;
        if (wr == 1) PG8_BAR;
    }
    PG8_WAIT_V(0);
    PG8_BAR;
#undef PG8_SA
#undef PG8_SB
#undef PG8_STAGE
#undef PG8_LDA
#undef PG8_LDB
#undef PG8_MMA
#undef PG8_WAIT_V
#undef PG8_WAIT_L
#undef PG8_BAR
#undef PG8_SCHED
}
}
typedef f32x4 AccT[2][2][4][2];
#define EPI_LOOP_ROWS for (int ai = 0; ai < 2; ++ai) _Pragma("unroll") for (int m = 0; m < 4; ++m) if (ai * 4 + m < ghi)
#define EPI_ROW (u.pm * 256 + ((ai * 4 + m + glo) >> 2) * 128 + wr * 64 + ((ai * 4 + m + glo) & 3) * 16 + fr)

struct EpiIn {
    static constexpr bool PERM = true;
    bf16_t* U; float* DT; const float* rstd; const float* dtb;
    __device__ __forceinline__ void mid(AccT&, const pg8::Unit&, int, int, int, int) const {}
    __device__ __forceinline__ void prefetch(float (&pre)[8], const pg8::Unit& u, int wr, int fr) const {
#pragma unroll
        for (int e = 0; e < 8; ++e) pre[e] = rstd[u.pm * 256 + (e >> 2) * 128 + wr * 64 + (e & 3) * 16 + fr]; }
    __device__ __forceinline__ void operator()(const AccT& acc, const pg8::Unit& u, int wr, int wc, int fr, int fq, int glo, int ghi, const float (&pre)[8]) const {
#pragma unroll
        EPI_LOOP_ROWS {
            const int row = EPI_ROW; const float rs = pre[ai * 4 + m]; bf16_t* rowp = U + (size_t)row * INW;
#pragma unroll
            for (int bj = 0; bj < 2; ++bj) { const int col0 = u.pn * 256 + bj * 128 + wc * 32 + 8 * fq;
                if (col0 < INW) { const f32x4 v0 = acc[ai][bj][m][0] * rs, v1 = acc[ai][bj][m][1] * rs;
                    u32x4 w; w.x = cvt_pk_bf16(v0[0], v0[1]); w.y = cvt_pk_bf16(v0[2], v0[3]); w.z = cvt_pk_bf16(v1[0], v1[1]); w.w = cvt_pk_bf16(v1[2], v1[3]);
                    *(u32x4*)(rowp + col0) = w;
                    if (col0 >= ODT && col0 < ODT + 16) { const int d0 = col0 - ODT; float* dp = DT + (size_t)row * 16 + d0;
#pragma unroll
                        for (int i = 0; i < 4; ++i) { float x = v0[i] + dtb[d0 + i]; dp[i] = x > 20.f ? x : log1pf(__expf(x)); x = v1[i] + dtb[d0 + 4 + i]; dp[4 + i] = x > 20.f ? x : log1pf(__expf(x)); } } } }
        }
    }
};
struct EpiGate2 {
    static constexpr bool PERM = true;
    const bf16_t* U; bf16_t* MG;
    __device__ __forceinline__ void prefetch(float (&)[8], const pg8::Unit&, int, int) const {}
    __device__ __forceinline__ void mid(AccT& acc, const pg8::Unit& u, int wr, int wc, int fr_, int fq) const {
        const int fr = opaque(fr_);
#pragma unroll
        for (int ai = 0; ai < 2; ++ai)
#pragma unroll
            for (int m = 0; m < 4; ++m) { const int row = u.pm * 256 + ai * 128 + wr * 64 + m * 16 + fr; const bf16_t* gp = U + (size_t)row * INW;
#pragma unroll
                for (int bj = 0; bj < 2; ++bj) { const int col0 = u.pn * 256 + bj * 128 + wc * 32 + 8 * fq;
                    const u32x4 ga = *(const u32x4*)(gp + OGA + col0), gb = *(const u32x4*)(gp + OGB + col0);
                    float r[8];
                    r[0] = (1.f + __expf(-bflo(gb.x))) * __builtin_amdgcn_rcpf(1.f + __expf(-bflo(ga.x))); r[1] = (1.f + __expf(-bfhi(gb.x))) * __builtin_amdgcn_rcpf(1.f + __expf(-bfhi(ga.x)));
                    r[2] = (1.f + __expf(-bflo(gb.y))) * __builtin_amdgcn_rcpf(1.f + __expf(-bflo(ga.y))); r[3] = (1.f + __expf(-bfhi(gb.y))) * __builtin_amdgcn_rcpf(1.f + __expf(-bfhi(ga.y)));
                    r[4] = (1.f + __expf(-bflo(gb.z))) * __builtin_amdgcn_rcpf(1.f + __expf(-bflo(ga.z))); r[5] = (1.f + __expf(-bfhi(gb.z))) * __builtin_amdgcn_rcpf(1.f + __expf(-bfhi(ga.z)));
                    r[6] = (1.f + __expf(-bflo(gb.w))) * __builtin_amdgcn_rcpf(1.f + __expf(-bflo(ga.w))); r[7] = (1.f + __expf(-bfhi(gb.w))) * __builtin_amdgcn_rcpf(1.f + __expf(-bfhi(ga.w)));
                    f32x4 a0 = acc[ai][bj][m][0], a1 = acc[ai][bj][m][1];
                    a0[0] *= r[0]; a0[1] *= r[1]; a0[2] *= r[2]; a0[3] *= r[3]; a1[0] *= r[4]; a1[1] *= r[5]; a1[2] *= r[6]; a1[3] *= r[7];
                    acc[ai][bj][m][0] = a0; acc[ai][bj][m][1] = a1; }
                __builtin_amdgcn_sched_barrier(0); }
    }
    __device__ __forceinline__ void operator()(const AccT& acc, const pg8::Unit& u, int wr, int wc, int fr, int fq, int glo, int ghi, const float (&pre)[8]) const {
#pragma unroll
        EPI_LOOP_ROWS {
            const int row = EPI_ROW; const bf16_t* gp = U + (size_t)row * INW + OGB; bf16_t* op = MG + (size_t)row * DM;
#pragma unroll
            for (int bj = 0; bj < 2; ++bj) { const int col0 = u.pn * 256 + bj * 128 + wc * 32 + 8 * fq;
                const u32x4 gv = *(const u32x4*)(gp + col0); const f32x4 a0 = acc[ai][bj][m][0], a1 = acc[ai][bj][m][1];
                float r[8];
                r[0] = sigmoidf_(bflo(gv.x)) * a0[0]; r[1] = sigmoidf_(bfhi(gv.x)) * a0[1]; r[2] = sigmoidf_(bflo(gv.y)) * a0[2]; r[3] = sigmoidf_(bfhi(gv.y)) * a0[3];
                r[4] = sigmoidf_(bflo(gv.z)) * a1[0]; r[5] = sigmoidf_(bfhi(gv.z)) * a1[1]; r[6] = sigmoidf_(bflo(gv.w)) * a1[2]; r[7] = sigmoidf_(bfhi(gv.w)) * a1[3];
                u32x4 w; w.x = cvt_pk_bf16(r[0], r[1]); w.y = cvt_pk_bf16(r[2], r[3]); w.z = cvt_pk_bf16(r[4], r[5]); w.w = cvt_pk_bf16(r[6], r[7]);
                *(u32x4*)(op + col0) = w; }
        }
    }
};
template <int FIRST> struct EpiRes {
    static constexpr bool PERM = true;
    __device__ __forceinline__ void mid(AccT&, const pg8::Unit&, int, int, int, int) const {}
    __device__ __forceinline__ void prefetch(float (&)[8], const pg8::Unit&, int, int) const {}
    const float* base_p; bf16_t* XB; float* ssq;
    __device__ __forceinline__ void operator()(const AccT& acc, const pg8::Unit& u, int wr, int wc, int fr, int fq, int glo, int ghi, const float (&pre)[8]) const {
#pragma unroll
        EPI_LOOP_ROWS {
            const int row = EPI_ROW; bf16_t* xb = XB + (size_t)row * DM; float ss = 0.f;
#pragma unroll
            for (int bj = 0; bj < 2; ++bj) { const int col0 = u.pn * 256 + bj * 128 + wc * 32 + 8 * fq;
                f32x4 b0, b1;
                if (FIRST) { const float* bp = base_p + (size_t)row * DM + col0; b0 = __builtin_nontemporal_load((const f32x4*)bp); b1 = __builtin_nontemporal_load((const f32x4*)(bp + 4)); }
                else { const u32x4 pv = *(const u32x4*)(xb + col0); b0 = (f32x4){bflo(pv.x), bfhi(pv.x), bflo(pv.y), bfhi(pv.y)}; b1 = (f32x4){bflo(pv.z), bfhi(pv.z), bflo(pv.w), bfhi(pv.w)}; }
                const f32x4 v0 = b0 + acc[ai][bj][m][0], v1 = b1 + acc[ai][bj][m][1];
                if (FIRST) ss += (v0[0] * v0[0] + v0[1] * v0[1]) + (v0[2] * v0[2] + v0[3] * v0[3]) + (v1[0] * v1[0] + v1[1] * v1[1]) + (v1[2] * v1[2] + v1[3] * v1[3]);
                u32x4 w; w.x = cvt_pk_bf16(v0[0], v0[1]); w.y = cvt_pk_bf16(v0[2], v0[3]); w.z = cvt_pk_bf16(v1[0], v1[1]); w.w = cvt_pk_bf16(v1[2], v1[3]);
                *(u32x4*)(xb + col0) = w; }
            if (FIRST) { ss += __shfl_xor(ss, 16); ss += __shfl_xor(ss, 32); if (fq == 0) atomicAdd(ssq + row, ss); }
        }
    }
};
struct EpiUp {
    static constexpr bool PERM = true;
    const float* ssq2; bf16_t* ACT;
    __device__ __forceinline__ void mid(AccT&, const pg8::Unit&, int, int, int, int) const {}
    __device__ __forceinline__ void prefetch(float (&pre)[8], const pg8::Unit& u, int wr, int fr) const {
#pragma unroll
        for (int e = 0; e < 8; ++e) pre[e] = ssq2[u.pm * 256 + (e >> 2) * 128 + wr * 64 + (e & 3) * 16 + fr]; }
    __device__ __forceinline__ void operator()(const AccT& acc, const pg8::Unit& u, int wr, int wc, int fr, int fq, int glo, int ghi, const float (&pre)[8]) const {
#pragma unroll
        EPI_LOOP_ROWS {
            const int row = EPI_ROW; const float rs = rsqrtf(pre[ai * 4 + m] * (1.f / DM) + EPS); bf16_t* op = ACT + (size_t)row * DFF;
#pragma unroll
            for (int bj = 0; bj < 2; ++bj) { const int col0 = u.pn * 256 + bj * 128 + wc * 32 + 8 * fq;
                f32x4 v0 = acc[ai][bj][m][0] * rs, v1 = acc[ai][bj][m][1] * rs;
#pragma unroll
                for (int i = 0; i < 4; ++i) { const float a = fmaxf(v0[i], 0.f), b = fmaxf(v1[i], 0.f); v0[i] = a * a; v1[i] = b * b; }
                u32x4 w; w.x = cvt_pk_bf16(v0[0], v0[1]); w.y = cvt_pk_bf16(v0[2], v0[3]); w.z = cvt_pk_bf16(v1[0], v1[1]); w.w = cvt_pk_bf16(v1[2], v1[3]);
                *(u32x4*)(op + col0) = w; }
        }
    }
};

__device__ __forceinline__ void transpose_item(const float* W, int K, int N, const float* scale, bf16_t* WT, int ldw, int kdst0, LAS float* scr, int kb, int nsrc0, int ndst0, int lane) {
    const int k0 = 64 * kb;
    const int n = nsrc0 + (lane & 15) * 4, kr = lane >> 4;
    f32x4 v[16];
#pragma unroll
    for (int i = 0; i < 16; ++i) { v[i] = (f32x4){0.f, 0.f, 0.f, 0.f}; if (n < N) v[i] = __builtin_nontemporal_load((const f32x4*)(W + (size_t)(k0 + 4 * i + kr) * N + n)); }
#pragma unroll
    for (int i = 0; i < 16; ++i) { const int kk = 4 * i + kr; const float sc = scale ? scale[k0 + kk] : 1.f; LAS float* p = scr + kk * 65 + (lane & 15) * 4;
        p[0] = v[i][0] * sc; p[1] = v[i][1] * sc; p[2] = v[i][2] * sc; p[3] = v[i][3] * sc; }
    LDS_WAIT();
    const int c = lane & 7;
#pragma unroll
    for (int j = 0; j < 8; ++j) { const int nn = (lane >> 3) + 8 * j; const LAS float* sp = scr + (8 * c) * 65 + nn;
        u32x4 o; o.x = pk2(sp[0 * 65], sp[1 * 65]); o.y = pk2(sp[2 * 65], sp[3 * 65]); o.z = pk2(sp[4 * 65], sp[5 * 65]); o.w = pk2(sp[6 * 65], sp[7 * 65]);
        *(u32x4*)(WT + (size_t)(ndst0 + nn) * ldw + kdst0 + k0 + 8 * c) = o; }
    LDS_WAIT();
}

constexpr int KS_LD = 72;
__device__ __forceinline__ void attn_tile(const LAS bf16_t* Ks, const LAS bf16_t* Vt, bf16_t* qptr, const bf16x8 qf0, const bf16x8 qf1, int kt0, int rq, int kmin, float sink, int lane) {
    const int c16 = lane & 15, quad = lane >> 4;
    bf16x8 qf[2]; qf[0] = qf0; qf[1] = qf1;
    f32x4 s[10]; s[9] = (f32x4){0.f, 0.f, 0.f, 0.f};
#pragma unroll
    for (int j = 0; j < 9; ++j) { s[j] = (f32x4){0.f, 0.f, 0.f, 0.f};
#pragma unroll
        for (int ks = 0; ks < 2; ++ks) { const bf16x8 kf = *(const LAS bf16x8*)(Ks + ((kt0 + j) * 16 + c16) * KS_LD + ks * 32 + quad * 8); s[j] = MFMA16(kf, qf[ks], s[j]); } }
    float mx = sink;
#pragma unroll
    for (int j = 0; j < 9; ++j)
#pragma unroll
        for (int jj = 0; jj < 4; ++jj) { const int kidx = (kt0 + j) * 16 + quad * 4 + jj; const bool ok = (kidx >= rq) && (kidx <= rq + 128) && (kidx >= kmin);
            const float v = ok ? s[j][jj] * 0.125f : -INFINITY; s[j][jj] = v; mx = fmaxf(mx, v); }
    mx = fmaxf(mx, __shfl_xor(mx, 16)); mx = fmaxf(mx, __shfl_xor(mx, 32));
    float sum = 0.f;
#pragma unroll
    for (int j = 0; j < 9; ++j)
#pragma unroll
        for (int jj = 0; jj < 4; ++jj) { const float p = __expf(s[j][jj] - mx); s[j][jj] = p; sum += p; }
    sum += __shfl_xor(sum, 16); sum += __shfl_xor(sum, 32); sum += __expf(sink - mx);
    const float inv = 1.f / sum;
    f32x4 o[4];
#pragma unroll
    for (int dt = 0; dt < 4; ++dt) o[dt] = (f32x4){0.f, 0.f, 0.f, 0.f};
    const unsigned vaddr = LDSADDR(Vt) + (unsigned)(((kt0 * 16 + quad * 4 + (c16 >> 2)) * KS_LD + 4 * (c16 & 3)) * 2);
#pragma unroll
    for (int st = 0; st < 5; ++st) {
        u32x4 pw; pw.x = pk2(s[2 * st][0] * inv, s[2 * st][1] * inv); pw.y = pk2(s[2 * st][2] * inv, s[2 * st][3] * inv);
        pw.z = pk2(s[2 * st + 1][0] * inv, s[2 * st + 1][1] * inv); pw.w = pk2(s[2 * st + 1][2] * inv, s[2 * st + 1][3] * inv);
        const bf16x8 pf = __builtin_bit_cast(bf16x8, pw);
        bf16x8 vf[4]; tr_frag4<0, 32, 64, 96, 16 * KS_LD * 2>(vaddr + st * (32 * KS_LD * 2), vf);
#pragma unroll
        for (int dt = 0; dt < 4; ++dt) o[dt] = MFMA16(vf[dt], pf, o[dt]);
    }
#pragma unroll
    for (int dt = 0; dt < 4; ++dt) { u32x2 w; w.x = pk2(o[dt][0], o[dt][1]); w.y = pk2(o[dt][2], o[dt][3]); *(u32x2*)(qptr + dt * 16 + quad * 4) = w; }
}

#define XB_TMO      128
#define XB_XCNT(j)  (256  + 64 * (j))
#define XB_XSUB(j)  (1280 + 64 * (j))
#define XB_XGEN(j)  (2304 + 64 * (j))
#define XB_TOP      3328
#define XB_TOPGEN   3392
#define XCD_BAR_WORDS 3456
#define XB_SPIN_CAP (1u << 18)
__device__ __forceinline__ unsigned xb_ld(unsigned* p)              { return __hip_atomic_load(p, __ATOMIC_RELAXED, __HIP_MEMORY_SCOPE_AGENT); }
__device__ __forceinline__ unsigned xb_add(unsigned* p, unsigned v) { return __hip_atomic_fetch_add(p, v, __ATOMIC_RELAXED, __HIP_MEMORY_SCOPE_AGENT); }
__device__ __forceinline__ unsigned xb_xcc_id() { return (unsigned)__builtin_amdgcn_s_getreg((3 << 11) | 20) & 0xFu; }
#define XB_SPIN(cond, bar) do { unsigned _sp = 0; while (cond) { __builtin_amdgcn_s_sleep(1); \
    if ((++_sp & 255u) == 0u) { if (xb_ld(&(bar)[XB_TMO])) break; if (_sp > XB_SPIN_CAP) { atomicAdd(&(bar)[XB_TMO], 1u); break; } } } } while (0)
__device__ __forceinline__ void xcd_barrier_complete(unsigned* bar, unsigned x, unsigned& nloc, unsigned& nx) {
    const unsigned Gt = gridDim.x;
    unsigned sum, cnt, mine, sp = 0u;
    for (;;) {
        sum = 0u; cnt = 0u; mine = 0u;
#pragma unroll
        for (unsigned j = 0; j < 16; ++j) { const unsigned c = xb_ld(&bar[XB_XCNT(j)]); sum += c; cnt += (c > 0u) ? 1u : 0u; mine = (j == x) ? c : mine; }
        if (sum == Gt) break;
        __builtin_amdgcn_s_sleep(1);
        if ((++sp & 255u) == 0u) { if (xb_ld(&bar[XB_TMO])) break; if (sp > XB_SPIN_CAP) { atomicAdd(&bar[XB_TMO], 1u); break; } }
    }
    nloc = mine > 0u ? mine : 1u; nx = cnt > 0u ? cnt : 1u;
}
__device__ __forceinline__ void xcd_barrier(unsigned* bar, unsigned x, volatile LAS unsigned* st, int tid0) {
    asm volatile("s_waitcnt vmcnt(0) lgkmcnt(0)" ::: "memory");
    __syncthreads();
    if (tid0 == 0) {
        __builtin_amdgcn_s_waitcnt(0);
        unsigned nloc = st[0], nx = st[1];
        if (nloc == 0u) { xcd_barrier_complete(bar, x, nloc, nx); st[0] = nloc; st[1] = nx; }
        const unsigned old = xb_add(&bar[XB_XSUB(x)], 1u);
        const unsigned gen = old / nloc;
        if (old + 1u == (gen + 1u) * nloc) {
            __builtin_amdgcn_fence(__ATOMIC_RELEASE, "agent");
            asm volatile("s_waitcnt vmcnt(0)" ::: "memory");
            const unsigned og = xb_add(&bar[XB_TOP], 1u);
            const unsigned tg = og / nx;
            if (og + 1u == (tg + 1u) * nx) xb_add(&bar[XB_TOPGEN], 1u);
            else XB_SPIN(xb_ld(&bar[XB_TOPGEN]) == tg, bar);
            __builtin_amdgcn_fence(__ATOMIC_ACQUIRE, "agent");
            xb_add(&bar[XB_XGEN(x)], 1u);
            asm volatile("s_waitcnt vmcnt(0)" ::: "memory");
        } else {
            XB_SPIN(xb_ld(&bar[XB_XGEN(x)]) == gen, bar);
            __builtin_amdgcn_fence(__ATOMIC_ACQUIRE, "agent");
            asm volatile("s_waitcnt vmcnt(0)" ::: "memory");
        }
    }
    __syncthreads();
}
struct Args { const float* in[22]; float* out; unsigned char* ws; int ph_lo, ph_hi; };

__global__ void __launch_bounds__(512, 2) mega(Args a) {
    extern __shared__ __attribute__((aligned(16))) unsigned char lds_raw[];
    LAS unsigned char* lds = (LAS unsigned char*)lds_raw;
    cg::grid_group grid = cg::this_grid();
    const int tid0 = threadIdx.x, w = __builtin_amdgcn_readfirstlane(tid0 >> 6), G = gridDim.x, bx = blockIdx.x;
    const int gw = bx * 8 + w, NGW = G * 8, NGT = G * 512;
#define LOCAL_IDS const int tid = opaque(tid0), lane = tid & 63, c16 = lane & 15, quad = lane >> 4; (void)c16; (void)quad; (void)lane;
    unsigned char* ws = a.ws; float* out = a.out;
    float* RSTD1 = (float*)(ws + WS_RSTD1); float* SSQ2 = (float*)(ws + WS_SSQ2); float* SSQF = (float*)(ws + WS_SSQF); float* CD = (float*)(ws + WS_CD);
    bf16_t* WIN = (bf16_t*)(ws + WS_WIN); bf16_t* WOA = (bf16_t*)(ws + WS_WOA); bf16_t* WOB = (bf16_t*)(ws + WS_WOB); bf16_t* WO = (bf16_t*)(ws + WS_WO);
    bf16_t* WUP = (bf16_t*)((unsigned char*)out + 40 * MiB); bf16_t* WDN = (bf16_t*)((unsigned char*)out + 48 * MiB);
    float* DT = (float*)(ws + WS_DT); bf16_t* U = (bf16_t*)(ws + WS_U); bf16_t* XC = (bf16_t*)(ws + WS_XC);
    bf16_t* MERGED = (bf16_t*)(ws + WS_MERGED); bf16_t* X1B = (bf16_t*)(ws + WS_X1B); bf16_t* ACT = (bf16_t*)(ws + WS_ACT);
    bf16_t* XB = (bf16_t*)(out + O_SS);
    bf16_t* STB = (bf16_t*)(out + O_YP);
    float* X1 = out + O_YP;
    const int lo = a.ph_lo, hi = a.ph_hi;
#ifndef PHMASK
#define PHMASK 0x7ff
#endif
#define IN(k) (((PHMASK >> (k)) & 1) && lo <= (k) && (k) < hi)
    unsigned* BARW = (unsigned*)(ws + WS_BAR);
    if (lo < 0) grid.sync();
#ifdef PROBE_A
    unsigned tstamp[12];
#define STAMP(i) tstamp[i] = (unsigned)__builtin_amdgcn_s_memrealtime()
    STAMP(0);
#else
#define STAMP(i)
#endif
    unsigned* XBW = (unsigned*)(ws + WS_XB); volatile LAS unsigned* xst = (volatile LAS unsigned*)(lds + LDS_BYTES - 64);
    const unsigned xcc = xb_xcc_id();
    if (tid0 < 2) xst[tid0] = 0u;
    if (tid0 == 0) (void)xb_add(&XBW[XB_XCNT(xcc)], 1u);
    __syncthreads();
#define SEAM(k) do { if (IN(k) && IN((k) + 1)) xcd_barrier(XBW, xcc, xst, tid0); } while (0)
#define SOFT_ARRIVE(k) do { asm volatile("s_waitcnt vmcnt(0) lgkmcnt(0)" ::: "memory"); __syncthreads(); \
        if (tid0 == 0) { __hip_atomic_fetch_add(BARW + 64 + (k), 1u, __ATOMIC_RELAXED, __HIP_MEMORY_SCOPE_AGENT); } } while (0)
    if (IN(0)) {
        const float* x_p = kin(0); const float* x_s = kin(1); const float* norm1 = kin(6); const float* w_in = kin(7); const float* ssm_norm = kin(14); const float* w_oa = kin(15); const float* w_ob = kin(16); const float* w_o = kin(17);
        LOCAL_IDS const int gtid = bx * 512 + tid;
        LAS float* scr = (LAS float*)(lds + w * 16640);
        constexpr int I_IN = 16 * 88, I_OA = 8 * 16, I_OB = 16 * 16, I_O = 16 * 16;
        for (int it = gw; it < I_IN + I_OA + I_OB + I_O; it += NGW) {
            int r = it;
            if (r < I_IN) { const int kb = r / 88, nd = 64 * (r % 88); const int ns = nd < 512 ? nd : (nd < 1536 ? nd + 256 : (nd < 1792 ? nd - 1024 : nd));
                transpose_item(w_in, DM, INW, norm1, WIN, DM, 0, scr, kb, ns, nd, lane); continue; } r -= I_IN;
            if (r < I_OA) { transpose_item(w_oa, 512, DM, nullptr, WOA, 1536, 0, scr, r / 16, 64 * (r % 16), 64 * (r % 16), lane); continue; } r -= I_OA;
            if (r < I_OB) { transpose_item(w_ob, DM, DM, ssm_norm, WOA, 1536, 512, scr, r / 16, 64 * (r % 16), 64 * (r % 16), lane); continue; } r -= I_OB;
            transpose_item(w_o, DM, DM, nullptr, WO, DM, 0, scr, r / 16, 64 * (r % 16), 64 * (r % 16), lane);
        }
#pragma unroll 2
        for (int m = gw; m < M; m += NGW) {
            const float* xr = m < MP ? x_p + (size_t)m * DM : x_s + (size_t)(m - MP) * DM;
            f32x4 v[4]; float ss = 0.f;
#pragma unroll
            for (int j = 0; j < 4; ++j) { v[j] = __builtin_nontemporal_load((const f32x4*)(xr + lane * 4 + 256 * j)); ss += (v[j][0] * v[j][0] + v[j][1] * v[j][1]) + (v[j][2] * v[j][2] + v[j][3] * v[j][3]); }
            ss = wave_sum(ss);
            if (lane == 0) RSTD1[m] = rsqrtf(ss * (1.f / DM) + EPS);
#pragma unroll
            for (int j = 0; j < 4; ++j) { u32x2 o; o.x = pk2(v[j][0], v[j][1]); o.y = pk2(v[j][2], v[j][3]); *(u32x2*)(XB + (size_t)m * DM + lane * 4 + 256 * j) = o; }
        }
        for (int i = gtid; i < M; i += NGT) { SSQ2[i] = 0.f; SSQF[i] = 0.f; }
    }
    SEAM(0); STAMP(1);
    if (IN(1)) {
        const float* dt_bias = kin(11);
        pg8::Gemm g{XB, WIN, M, NPAD, DM, DM, DM}; pg8::StaticOrder S; S.init(M, NPAD, G, bx);
        EpiIn E{U, DT, RSTD1, dt_bias};
        pg8::gemm_phase<EpiIn>(lds, g, S, E);
        {
            constexpr int NT1 = (M / 256) * (NPAD / 256); const int full = NT1 / G, rem = NT1 - full * G;
            if (bx >= rem && rem > 0) { LOCAL_IDS const float* norm2 = kin(18); const float* w_up = kin(19); const float* w_down = kin(20);
                LAS float* scr = (LAS float*)(lds + w * 16640); const int nidle = (G - rem) * 8;
                for (int it = (bx - rem) * 8 + w; it < 2048; it += nidle) { if (it < 1024) transpose_item(w_up, DM, DFF, norm2, WUP, DM, 0, scr, it / 64, 64 * (it % 64), 64 * (it % 64), lane); else transpose_item(w_down, DFF, DM, nullptr, WDN, DFF, 0, scr, (it - 1024) / 16, 64 * ((it - 1024) % 16), 64 * ((it - 1024) % 16), lane); } } }
    }
    SEAM(1); STAMP(2);
    if (IN(2)) {
        const float* cache_k = kin(2); const float* cache_v = kin(3); const float* state_conv = kin(4); const float* sinks = kin(8); const float* conv_w = kin(9); const float* conv_b = kin(10);
        {   LOCAL_IDS
            if (tid < 384) {
                const int cgi = tid % 192, sub = tid / 192, ch0 = cgi * 8;
                float wv[4][8], bias[8];
#pragma unroll
                for (int i = 0; i < 4; ++i) { const f32x4 t0 = *(const f32x4*)(conv_w + i * CONVD + ch0), t1 = *(const f32x4*)(conv_w + i * CONVD + ch0 + 4);
#pragma unroll
                    for (int k = 0; k < 4; ++k) { wv[i][k] = t0[k]; wv[i][4 + k] = t1[k]; } }
                { const f32x4 t0 = *(const f32x4*)(conv_b + ch0), t1 = *(const f32x4*)(conv_b + ch0 + 4);
#pragma unroll
                  for (int k = 0; k < 4; ++k) { bias[k] = t0[k]; bias[4 + k] = t1[k]; } }
#pragma unroll 1
                for (int rg = bx * 2 + sub; rg < 4096 + 128; rg += 2 * G) {
                    const bool prompt = rg < 4096; const int bs = rg - 4096;
                    const int rowbase = prompt ? rg * 4 : MP + bs * 4; const int t = rowbase & (SEQ - 1);
                    float x[7][8];
                    u32x4 r[7];
#pragma unroll
                    for (int j = 0; j < 7; ++j) r[j] = (u32x4){0u, 0u, 0u, 0u};
#pragma unroll
                    for (int j = 3; j < 7; ++j) r[j] = __builtin_nontemporal_load((const u32x4*)(U + (size_t)(rowbase + j - 3) * INW + OX + ch0));
                    if (prompt && t > 0) {
#pragma unroll
                        for (int j = 0; j < 3; ++j) r[j] = *(const u32x4*)(U + (size_t)(rowbase + j - 3) * INW + OX + ch0); }
#pragma unroll
                    for (int j = 0; j < 7; ++j) { x[j][0] = bflo(r[j].x); x[j][1] = bfhi(r[j].x); x[j][2] = bflo(r[j].y); x[j][3] = bfhi(r[j].y); x[j][4] = bflo(r[j].z); x[j][5] = bfhi(r[j].z); x[j][6] = bflo(r[j].w); x[j][7] = bfhi(r[j].w); }
                    if (!prompt) { const float* sp = state_conv + (size_t)bs * 3 * CONVD + ch0;
#pragma unroll
                        for (int j = 0; j < 3; ++j) { const f32x4 a0 = *(const f32x4*)(sp + j * CONVD), a1 = *(const f32x4*)(sp + j * CONVD + 4);
#pragma unroll
                            for (int k = 0; k < 4; ++k) { x[j][k] = a0[k]; x[j][4 + k] = a1[k]; } } }
#pragma unroll
                    for (int tt = 0; tt < 4; ++tt) { float y[8];
#pragma unroll
                        for (int k = 0; k < 8; ++k) { const float sacc = bias[k] + x[tt][k] * wv[0][k] + x[tt + 1][k] * wv[1][k] + x[tt + 2][k] * wv[2][k] + x[tt + 3][k] * wv[3][k]; y[k] = siluf_(sacc); }
                        u32x4 o; o.x = pk2(y[0], y[1]); o.y = pk2(y[2], y[3]); o.z = pk2(y[4], y[5]); o.w = pk2(y[6], y[7]);
                        *(u32x4*)(XC + (size_t)(rowbase + tt) * CONVD + ch0) = o; }
                    float* obase = nullptr;
                    if (prompt) { if (t == SEQ - 4) obase = out + O_CP + (size_t)(rowbase >> 11) * 3 * CONVD; } else obase = out + O_CS + (size_t)bs * 3 * CONVD;
                    if (obase) {
#pragma unroll
                        for (int j = 0; j < 3; ++j) { float* op = obase + (size_t)j * CONVD + ch0; *(f32x4*)op = (f32x4){x[4 + j][0], x[4 + j][1], x[4 + j][2], x[4 + j][3]}; *(f32x4*)(op + 4) = (f32x4){x[4 + j][4], x[4 + j][5], x[4 + j][6], x[4 + j][7]}; } }
                }
            }
        }
        LAS bf16_t* Ks = (LAS bf16_t*)lds; LAS bf16_t* Vt = (LAS bf16_t*)(lds + 272 * KS_LD * 2);
        LAS bf16_t* Ks2 = (LAS bf16_t*)(lds + 2 * 272 * KS_LD * 2); LAS bf16_t* Vt2 = (LAS bf16_t*)(lds + 2 * 272 * KS_LD * 2 + 160 * KS_LD * 2);
        for (int unit = bx; unit < 256; unit += G) {
            LOCAL_IDS const int b = unit >> 5, qblk = (unit >> 1) & 15, kvh = unit & 1, bs = unit >> 1, kvh2 = unit & 1;
            const int hq = kvh * 4 + (w >> 1), qh = w & 1; const float sink = sinks[hq];
            bf16x8 qf[4][2];
#pragma unroll
            for (int i = 0; i < 4; ++i) { const bf16_t* qp = U + (size_t)(b * SEQ + qblk * 128 + qh * 64 + i * 16 + c16) * INW + hq * 64; qf[i][0] = *(const bf16x8*)(qp + quad * 8); qf[i][1] = *(const bf16x8*)(qp + 32 + quad * 8); }
            const int sw = unit & 7;
            const int gq = c16 >> 2, ts = c16 & 3, hq2 = kvh2 * 4 + gq;
            bf16_t* qp2 = U + (size_t)(MP + bs * 4 + ts) * INW + hq2 * 64; bf16x8 q2a = qf[0][0], q2b = qf[0][1];
            if (w == sw) { q2a = *(const bf16x8*)(qp2 + quad * 8); q2b = *(const bf16x8*)(qp2 + 32 + quad * 8); }
            __syncthreads();
#pragma unroll
            for (int pc = tid; pc < 272 * 8; pc += 512) { const int kidx = pc >> 3, part = pc & 7; const int tok = (qblk - 1) * 128 + kidx;
                u32x4 kv = (u32x4){0u, 0u, 0u, 0u}, vv = (u32x4){0u, 0u, 0u, 0u};
                if (kidx < 256 && tok >= 0) { const bf16_t* rp = U + (size_t)(b * SEQ + tok) * INW + kvh * 64 + part * 8; kv = *(const u32x4*)(rp + OKK); vv = *(const u32x4*)(rp + OV);
                    if (qblk == 15 && kidx >= 128) { const size_t oo = ((size_t)(b * 128 + kidx - 128) * 2 + kvh) * 64 + part * 8;
                        *(f32x4*)(out + O_KP + oo) = (f32x4){bflo(kv.x), bfhi(kv.x), bflo(kv.y), bfhi(kv.y)}; *(f32x4*)(out + O_KP + oo + 4) = (f32x4){bflo(kv.z), bfhi(kv.z), bflo(kv.w), bfhi(kv.w)};
                        *(f32x4*)(out + O_VP + oo) = (f32x4){bflo(vv.x), bfhi(vv.x), bflo(vv.y), bfhi(vv.y)}; *(f32x4*)(out + O_VP + oo + 4) = (f32x4){bflo(vv.z), bfhi(vv.z), bflo(vv.w), bfhi(vv.w)}; } }
                *(LAS u32x4*)(Ks + kidx * KS_LD + part * 8) = kv; *(LAS u32x4*)(Vt + kidx * KS_LD + part * 8) = vv; }
#pragma unroll
            for (int pc = tid; pc < 160 * 8; pc += 512) { const int kidx = pc >> 3, part = pc & 7;
                float kf[8], vf[8];
#pragma unroll
                for (int i = 0; i < 8; ++i) { kf[i] = 0.f; vf[i] = 0.f; }
                if (kidx < 128) { const size_t io = ((size_t)(bs * 128 + kidx) * 2 + kvh2) * 64 + part * 8;
                    const f32x4 k0 = __builtin_nontemporal_load((const f32x4*)(cache_k + io)), k1 = __builtin_nontemporal_load((const f32x4*)(cache_k + io + 4)), v0 = __builtin_nontemporal_load((const f32x4*)(cache_v + io)), v1 = __builtin_nontemporal_load((const f32x4*)(cache_v + io + 4));
#pragma unroll
                    for (int i = 0; i < 4; ++i) { kf[i] = k0[i]; kf[4 + i] = k1[i]; vf[i] = v0[i]; vf[4 + i] = v1[i]; }
                } else if (kidx < 132) { const bf16_t* rp = U + (size_t)(MP + bs * 4 + kidx - 128) * INW + kvh2 * 64 + part * 8; const u32x4 kv = *(const u32x4*)(rp + OKK), vv = *(const u32x4*)(rp + OV);
                    kf[0] = bflo(kv.x); kf[1] = bfhi(kv.x); kf[2] = bflo(kv.y); kf[3] = bfhi(kv.y); kf[4] = bflo(kv.z); kf[5] = bfhi(kv.z); kf[6] = bflo(kv.w); kf[7] = bfhi(kv.w);
                    vf[0] = bflo(vv.x); vf[1] = bfhi(vv.x); vf[2] = bflo(vv.y); vf[3] = bfhi(vv.y); vf[4] = bflo(vv.z); vf[5] = bfhi(vv.z); vf[6] = bflo(vv.w); vf[7] = bfhi(vv.w); }
                if (kidx >= 4 && kidx < 132) { const size_t oo = ((size_t)(bs * 128 + kidx - 4) * 2 + kvh2) * 64 + part * 8;
                    __builtin_nontemporal_store((f32x4){kf[0], kf[1], kf[2], kf[3]}, (f32x4*)(out + O_KS + oo)); __builtin_nontemporal_store((f32x4){kf[4], kf[5], kf[6], kf[7]}, (f32x4*)(out + O_KS + oo + 4));
                    __builtin_nontemporal_store((f32x4){vf[0], vf[1], vf[2], vf[3]}, (f32x4*)(out + O_VS + oo)); __builtin_nontemporal_store((f32x4){vf[4], vf[5], vf[6], vf[7]}, (f32x4*)(out + O_VS + oo + 4)); }
                u32x4 kw; kw.x = pk2(kf[0], kf[1]); kw.y = pk2(kf[2], kf[3]); kw.z = pk2(kf[4], kf[5]); kw.w = pk2(kf[6], kf[7]);
                u32x4 vw; vw.x = pk2(vf[0], vf[1]); vw.y = pk2(vf[2], vf[3]); vw.z = pk2(vf[4], vf[5]); vw.w = pk2(vf[6], vf[7]);
                *(LAS u32x4*)(Ks2 + kidx * KS_LD + part * 8) = kw; *(LAS u32x4*)(Vt2 + kidx * KS_LD + part * 8) = vw; }
            __syncthreads();
#pragma unroll
            for (int i = 0; i < 4; ++i) { const int r0 = qh * 64 + i * 16;
                bf16_t* qp = U + (size_t)(b * SEQ + qblk * 128 + r0 + c16) * INW + hq * 64;
                attn_tile(Ks, Vt, qp, qf[i][0], qf[i][1], r0 >> 4, r0 + c16, qblk == 0 ? 128 : 0, sink, lane); }
            if (w == sw) attn_tile(Ks2, Vt2, qp2, q2a, q2b, 0, ts, 0, sinks[hq2], lane);
        }
    }
    SEAM(2); STAMP(3);
    if (IN(3)) {
        const float* state_ssm = kin(5); const float* a_log = kin(12); const float* d_skip = kin(13);
        for (int ord = 0; ord < 2; ++ord) {
        if (((ord ^ bx) & 1) == 0) {
            LAS bf16_t* Bt = (LAS bf16_t*)lds;
            LAS bf16_t* Xs = (LAS bf16_t*)(lds + 18432);
            LAS float* scl = (LAS float*)(lds + 18432 + 73728);
            for (int unit = bx; unit < 256; unit += G) {
                LOCAL_IDS const int b = unit >> 5, c = (unit >> 1) & 15, g = unit & 1, row0 = b * SEQ + c * 128, h = 8 * g + w;
                __syncthreads();
                { const float A = -__expf(a_log[h]);
                  const float d0 = DT[(size_t)(row0 + lane) * 16 + h], d1 = DT[(size_t)(row0 + 64 + lane) * 16 + h];
                  float v0 = d0 * A, v1 = d1 * A;
#pragma unroll
                  for (int o = 1; o < 64; o <<= 1) { const float t0 = __builtin_bit_cast(float, __builtin_amdgcn_ds_bpermute((lane - o) << 2, __builtin_bit_cast(int, v0))), t1 = __builtin_bit_cast(float, __builtin_amdgcn_ds_bpermute((lane - o) << 2, __builtin_bit_cast(int, v1))); if (lane >= o) { v0 += t0; v1 += t1; } }
                  v1 += __builtin_bit_cast(float, __builtin_amdgcn_readlane(__builtin_bit_cast(int, v0), 63)); const float last = __builtin_bit_cast(float, __builtin_amdgcn_readlane(__builtin_bit_cast(int, v1), 63));
                  scl[w * 128 + lane] = d0 * __expf(last - v0); scl[w * 128 + 64 + lane] = d1 * __expf(last - v1);
                  if (lane == 0) CD[(b * 16 + c) * 16 + h] = __expf(last); }
                f32x4 acc[8][4];
#pragma unroll
                for (int nt = 0; nt < 8; ++nt)
#pragma unroll
                    for (int pt = 0; pt < 4; ++pt) acc[nt][pt] = (f32x4){0.f, 0.f, 0.f, 0.f};
                for (int half = 0; half < 2; ++half) {
                    __syncthreads();
#pragma unroll 2
                    for (int pc = tid; pc < 1024; pc += 512) { const int lr = pc >> 4, part = pc & 15;
                        *(LAS u32x4*)(Bt + lr * 136 + part * 8) = *(const u32x4*)(XC + (size_t)(row0 + half * 64 + lr) * CONVD + 1024 + g * 128 + part * 8); }
#pragma unroll 1
                    for (int pc0 = tid; pc0 < 4096; pc0 += 2048) { u32x4 vv[4];
#pragma unroll
                        for (int k = 0; k < 4; ++k) { const int pc = pc0 + 512 * k, lr = pc >> 6, part = pc & 63; vv[k] = *(const u32x4*)(XC + (size_t)(row0 + half * 64 + lr) * CONVD + g * 512 + part * 8); }
#pragma unroll
                        for (int k = 0; k < 4; ++k) { const int pc = pc0 + 512 * k, lr = pc >> 6, part = pc & 63, hh = part >> 3; const u32x4 v = vv[k];
                            const float sc = scl[hh * 128 + half * 64 + lr];
                            u32x4 o; o.x = pk2(bflo(v.x) * sc, bfhi(v.x) * sc); o.y = pk2(bflo(v.y) * sc, bfhi(v.y) * sc); o.z = pk2(bflo(v.z) * sc, bfhi(v.z) * sc); o.w = pk2(bflo(v.w) * sc, bfhi(v.w) * sc);
                            *(LAS u32x4*)(Xs + (hh * 64 + lr) * 72 + (part & 7) * 8) = o; } }
                    __syncthreads();
                    const unsigned baddr = LDSADDR(Bt) + (unsigned)(((quad * 8 + (c16 >> 2)) * 136 + 4 * (c16 & 3)) * 2);
                    const unsigned xaddr = LDSADDR(Xs) + (unsigned)(((w * 64 + quad * 8 + (c16 >> 2)) * 72 + 4 * (c16 & 3)) * 2);
#pragma unroll
                    for (int ks = 0; ks < 2; ++ks) { bf16x8 xf[4]; tr_frag4<0, 32, 64, 96, 4 * 144>(xaddr + ks * (32 * 144), xf);
#pragma unroll
                        for (int nh = 0; nh < 2; ++nh) { bf16x8 bfr[4]; tr_frag4<0, 32, 64, 96, 4 * 272>(baddr + ks * (32 * 272) + nh * 128, bfr);
#pragma unroll
                            for (int n4 = 0; n4 < 4; ++n4)
#pragma unroll
                                for (int pt = 0; pt < 4; ++pt) acc[nh * 4 + n4][pt] = MFMA16(bfr[n4], xf[pt], acc[nh * 4 + n4][pt]); } }
                }
                bf16_t* sp = STB + ((size_t)((b * 16 + c) * 16 + h) * 64) * 128;
#pragma unroll
                for (int nt = 0; nt < 8; ++nt)
#pragma unroll
                    for (int pt = 0; pt < 4; ++pt) { u32x2 o; o.x = pk2(acc[nt][pt][0], acc[nt][pt][1]); o.y = pk2(acc[nt][pt][2], acc[nt][pt][3]); *(u32x2*)(sp + (size_t)(pt * 16 + c16) * 128 + nt * 16 + quad * 4) = o; }
            }
        }
        else {
            LAS float* xr = (LAS float*)lds;
            LAS float* xdt = (LAS float*)(lds + 8192);
            LAS float* vals = (LAS float*)(lds + 16384);
            LAS float* rs = (LAS float*)(lds + 24576);
            for (int unit = bx; unit < 256; unit += G) {
                LOCAL_IDS const int b = unit >> 1, g = unit & 1, h = 8 * g + w, R0 = MP + b * 4;
                __syncthreads();
                const float A = -__expf(a_log[h]); float dtv[4], dA[4];
#pragma unroll
                for (int t = 0; t < 4; ++t) { dtv[t] = DT[(size_t)(R0 + t) * 16 + h]; dA[t] = __expf(dtv[t] * A); }
                { const int t = quad, p0 = c16 * 4; const u32x2 v = *(const u32x2*)(XC + (size_t)(R0 + t) * CONVD + h * 64 + p0);
                  const float dtt = t == 0 ? dtv[0] : (t == 1 ? dtv[1] : (t == 2 ? dtv[2] : dtv[3]));
                  const float f0 = bflo(v.x), f1 = bfhi(v.x), f2 = bflo(v.y), f3 = bfhi(v.y);
                  LAS float* p = xr + (w * 4 + t) * 64 + p0; p[0] = f0; p[1] = f1; p[2] = f2; p[3] = f3;
                  LAS float* q = xdt + (w * 4 + t) * 64 + p0; q[0] = f0 * dtt; q[1] = f1 * dtt; q[2] = f2 * dtt; q[3] = f3 * dtt; }
                float Bv[4][8], Cv[4][8];
#pragma unroll
                for (int t = 0; t < 4; ++t) { const bf16_t* rp = XC + (size_t)(R0 + t) * CONVD + 1024 + g * 128 + c16 * 4;
                    const u32x2 b0 = *(const u32x2*)rp, b1 = *(const u32x2*)(rp + 64), c0 = *(const u32x2*)(rp + 256), c1 = *(const u32x2*)(rp + 320);
                    Bv[t][0] = bflo(b0.x); Bv[t][1] = bfhi(b0.x); Bv[t][2] = bflo(b0.y); Bv[t][3] = bfhi(b0.y); Bv[t][4] = bflo(b1.x); Bv[t][5] = bfhi(b1.x); Bv[t][6] = bflo(b1.y); Bv[t][7] = bfhi(b1.y);
                    Cv[t][0] = bflo(c0.x); Cv[t][1] = bfhi(c0.x); Cv[t][2] = bflo(c0.y); Cv[t][3] = bfhi(c0.y); Cv[t][4] = bflo(c1.x); Cv[t][5] = bfhi(c1.x); Cv[t][6] = bflo(c1.y); Cv[t][7] = bfhi(c1.y); }
                const float Dh = d_skip[h];
                LDS_WAIT();
                const float* sin_ = state_ssm + (size_t)(b * 16 + h) * 8192; float* sout = out + O_SS + (size_t)(b * 16 + h) * 8192;
#pragma unroll 1
                for (int i0 = 0; i0 < 16; i0 += 4) { f32x4 H0[4], H1[4];
#pragma unroll
                  for (int ii = 0; ii < 4; ++ii) { const int p = 4 * (i0 + ii) + quad; H0[ii] = __builtin_nontemporal_load((const f32x4*)(sin_ + p * 128 + c16 * 4)); H1[ii] = __builtin_nontemporal_load((const f32x4*)(sin_ + p * 128 + 64 + c16 * 4)); }
#pragma unroll
                  for (int ii = 0; ii < 4; ++ii) { const int p = 4 * (i0 + ii) + quad;
                    f32x4 h0 = H0[ii], h1 = H1[ii];
                    float yk = 0.f;
#pragma unroll
                    for (int t = 0; t < 4; ++t) { const float xd = xdt[(w * 4 + t) * 64 + p]; float y = 0.f;
#pragma unroll
                        for (int k = 0; k < 4; ++k) { h0[k] = h0[k] * dA[t] + xd * Bv[t][k]; y += h0[k] * Cv[t][k]; h1[k] = h1[k] * dA[t] + xd * Bv[t][4 + k]; y += h1[k] * Cv[t][4 + k]; }
                        y = row16_sum(y);
                        if (c16 == t) yk = y + Dh * xr[(w * 4 + t) * 64 + p]; }
                    __builtin_nontemporal_store(h0, (f32x4*)(sout + p * 128 + c16 * 4)); __builtin_nontemporal_store(h1, (f32x4*)(sout + p * 128 + 64 + c16 * 4));
                    if (c16 < 4) { const float z = bf1(U[(size_t)(R0 + c16) * INW + OZ + h * 64 + p]); vals[(w * 4 + c16) * 64 + p] = yk * siluf_(z); } } }
                __syncthreads();
                if (w < 4) { float s = 0.f;
#pragma unroll
                    for (int hh = 0; hh < 8; ++hh) { const float v = vals[(hh * 4 + w) * 64 + lane]; s += v * v; }
                    s = wave_sum(s); if (lane == 0) rs[w] = rsqrtf(s * (1.f / 512.f) + EPS); }
                __syncthreads();
                { const int t = tid >> 7, ch4 = (tid & 127) * 4, hh = ch4 >> 6, p = ch4 & 63; const float r = rs[t]; const LAS float* vp = vals + (hh * 4 + t) * 64 + p;
                  u32x2 o; o.x = pk2(vp[0] * r, vp[1] * r); o.y = pk2(vp[2] * r, vp[3] * r);
                  *(u32x2*)(U + (size_t)(R0 + t) * INW + OZ + g * 512 + ch4) = o; }
            }
        }
        }
    }
    SEAM(3); STAMP(4);
    if (IN(4)) {
        LOCAL_IDS const int gtid = bx * 512 + tid;
        for (int idx = gtid; idx < 131072; idx += NGT) { const int n8 = idx & 15, p = (idx >> 4) & 63, h = (idx >> 10) & 15, b = idx >> 14;
            float hc[8];
#pragma unroll
            for (int k = 0; k < 8; ++k) hc[k] = 0.f;
            bf16_t* ptr0 = STB + ((size_t)(b * 16 * 16 + h) * 64 + p) * 128 + n8 * 8; u32x4 svv[16]; float dd[16];
#pragma unroll
            for (int c = 0; c < 16; ++c) { svv[c] = __builtin_nontemporal_load((const u32x4*)(ptr0 + (size_t)c * (16 * 8192))); dd[c] = CD[(b * 16 + c) * 16 + h]; }
#pragma unroll
            for (int c = 0; c < 16; ++c) { const u32x4 sv = svv[c];
                u32x4 o; o.x = pk2(hc[0], hc[1]); o.y = pk2(hc[2], hc[3]); o.z = pk2(hc[4], hc[5]); o.w = pk2(hc[6], hc[7]); *(u32x4*)(ptr0 + (size_t)c * (16 * 8192)) = o;
                const float d = dd[c];
                hc[0] = hc[0] * d + bflo(sv.x); hc[1] = hc[1] * d + bfhi(sv.x); hc[2] = hc[2] * d + bflo(sv.y); hc[3] = hc[3] * d + bfhi(sv.y);
                hc[4] = hc[4] * d + bflo(sv.z); hc[5] = hc[5] * d + bfhi(sv.z); hc[6] = hc[6] * d + bflo(sv.w); hc[7] = hc[7] * d + bfhi(sv.w); }
            float* op = out + O_SP + ((size_t)(b * 16 + h) * 64 + p) * 128 + n8 * 8;
            __builtin_nontemporal_store((f32x4){hc[0], hc[1], hc[2], hc[3]}, (f32x4*)op); __builtin_nontemporal_store((f32x4){hc[4], hc[5], hc[6], hc[7]}, (f32x4*)(op + 4)); }
    }
    SEAM(4); STAMP(5);
    if (IN(5)) {
        const float* a_log = kin(12); const float* d_skip = kin(13);
        LAS bf16_t* Cs = (LAS bf16_t*)lds; LAS bf16_t* Bs = (LAS bf16_t*)(lds + 34816); LAS bf16_t* CBs = (LAS bf16_t*)(lds + 69632);
        LAS bf16_t* Xt = (LAS bf16_t*)(lds + 104448 + w * 5120);
        LAS float* acs = (LAS float*)(lds + 145408); LAS float* dts = (LAS float*)(lds + 149504); LAS float* ssq = (LAS float*)(lds + 153600);
        for (int unit = bx; unit < 256; unit += G) {
            LOCAL_IDS const int b = unit >> 5, c = (unit >> 1) & 15, g = unit & 1, row0 = b * SEQ + c * 128, h = 8 * g + w;
            __syncthreads();
            { const float A = -__expf(a_log[h]);
              const float d0 = DT[(size_t)(row0 + lane) * 16 + h], d1 = DT[(size_t)(row0 + 64 + lane) * 16 + h];
              float v0 = d0 * A, v1 = d1 * A;
#pragma unroll
              for (int o = 1; o < 64; o <<= 1) { const float t0 = __builtin_bit_cast(float, __builtin_amdgcn_ds_bpermute((lane - o) << 2, __builtin_bit_cast(int, v0))), t1 = __builtin_bit_cast(float, __builtin_amdgcn_ds_bpermute((lane - o) << 2, __builtin_bit_cast(int, v1))); if (lane >= o) { v0 += t0; v1 += t1; } }
              v1 += __builtin_bit_cast(float, __builtin_amdgcn_readlane(__builtin_bit_cast(int, v0), 63));
              acs[w * 128 + lane] = v0; acs[w * 128 + 64 + lane] = v1; dts[w * 128 + lane] = d0; dts[w * 128 + 64 + lane] = d1; }
#pragma unroll 4
            for (int pc = tid; pc < 2048; pc += 512) { const int lr = pc >> 4, part = pc & 15; const bf16_t* rp = XC + (size_t)(row0 + lr) * CONVD + 1024 + g * 128 + part * 8;
                *(LAS u32x4*)(Bs + lr * 136 + part * 8) = __builtin_nontemporal_load((const u32x4*)rp); *(LAS u32x4*)(Cs + lr * 136 + part * 8) = __builtin_nontemporal_load((const u32x4*)(rp + 256)); }
            __syncthreads();
            {
                bf16x8 bfr[4];
#pragma unroll
                for (int ks = 0; ks < 4; ++ks) bfr[ks] = *(const LAS bf16x8*)(Bs + (16 * w + c16) * 136 + ks * 32 + quad * 8);
#pragma unroll
                for (int lt = 0; lt < 8; ++lt) { f32x4 d = (f32x4){0.f, 0.f, 0.f, 0.f};
#pragma unroll
                    for (int ks = 0; ks < 4; ++ks) { const bf16x8 cfr = *(const LAS bf16x8*)(Cs + (lt * 16 + c16) * 136 + ks * 32 + quad * 8); d = MFMA16(bfr[ks], cfr, d); }
                    u32x2 o; o.x = pk2(d[0], d[1]); o.y = pk2(d[2], d[3]); *(LAS u32x2*)(CBs + (lt * 16 + c16) * 136 + 16 * w + quad * 4) = o; }
            }
            __syncthreads();
            f32x4 acc[4][8];
#pragma unroll
            for (int pt = 0; pt < 4; ++pt)
#pragma unroll
                for (int lt = 0; lt < 8; ++lt) acc[pt][lt] = (f32x4){0.f, 0.f, 0.f, 0.f};
            const bf16_t* Hp = STB + (size_t)((b * 16 + c) * 16 + h) * 8192;
#pragma unroll
            for (int kh = 0; kh < 2; ++kh) { bf16x8 hf[2][4];
#pragma unroll
              for (int k2 = 0; k2 < 2; ++k2)
#pragma unroll
                for (int pt = 0; pt < 4; ++pt) hf[k2][pt] = __builtin_nontemporal_load((const bf16x8*)(Hp + (pt * 16 + c16) * 128 + (kh * 2 + k2) * 32 + quad * 8));
#pragma unroll
              for (int k2 = 0; k2 < 2; ++k2) {
#pragma unroll
                for (int lt = 0; lt < 8; ++lt) { const bf16x8 cfr = *(const LAS bf16x8*)(Cs + (lt * 16 + c16) * 136 + (kh * 2 + k2) * 32 + quad * 8);
#pragma unroll
                    for (int pt = 0; pt < 4; ++pt) acc[pt][lt] = MFMA16(hf[k2][pt], cfr, acc[pt][lt]); }
                asm volatile("" ::: "memory"); } }
#pragma unroll
            for (int lt = 0; lt < 8; ++lt) { const float e = __expf(acs[w * 128 + lt * 16 + c16]);
#pragma unroll
                for (int pt = 0; pt < 4; ++pt) acc[pt][lt] = acc[pt][lt] * e; }
            __builtin_amdgcn_sched_barrier(0);
            u32x4 xq[4][4];
#pragma unroll
            for (int k = 0; k < 4; ++k) { const int pc = lane + 64 * k, sr = pc >> 3, part = pc & 7; xq[0][k] = __builtin_nontemporal_load((const u32x4*)(XC + (size_t)(row0 + sr) * CONVD + h * 64 + part * 8)); }
#pragma unroll
            for (int sq = 0; sq < 4; ++sq) {
                asm volatile("s_waitcnt lgkmcnt(0)" ::: "memory");
#pragma unroll
                for (int k = 0; k < 4; ++k) { const int pc = lane + 64 * k, sr = pc >> 3, part = pc & 7; *(LAS u32x4*)(Xt + sr * 72 + part * 8) = xq[sq][k]; }
                if (sq < 3) {
#pragma unroll
                    for (int k = 0; k < 4; ++k) { const int pc = lane + 64 * k, sr = pc >> 3, part = pc & 7; xq[sq + 1][k] = __builtin_nontemporal_load((const u32x4*)(XC + (size_t)(row0 + (sq + 1) * 32 + sr) * CONVD + h * 64 + part * 8)); } }
                asm volatile("s_waitcnt lgkmcnt(0)" ::: "memory");
                bf16x8 xf[4]; tr_frag4<0, 32, 64, 96, 4 * 144>(LDSADDR(Xt) + (unsigned)(((quad * 8 + (c16 >> 2)) * 72 + 4 * (c16 & 3)) * 2), xf);
                const f32x4 as0 = *(const LAS f32x4*)(acs + w * 128 + sq * 32 + quad * 8), as1 = *(const LAS f32x4*)(acs + w * 128 + sq * 32 + quad * 8 + 4);
                const f32x4 ds0 = *(const LAS f32x4*)(dts + w * 128 + sq * 32 + quad * 8), ds1 = *(const LAS f32x4*)(dts + w * 128 + sq * 32 + quad * 8 + 4);
#pragma unroll
                for (int lt = 0; lt < 8; ++lt) { if (lt >= 2 * sq) {
                    const int l = lt * 16 + c16; const float al = acs[w * 128 + l];
                    const u32x4 cb = *(const LAS u32x4*)(CBs + l * 136 + sq * 32 + quad * 8);
                    const int s0 = sq * 32 + quad * 8;
                    float wv[8];
                    wv[0] = bflo(cb.x); wv[1] = bfhi(cb.x); wv[2] = bflo(cb.y); wv[3] = bfhi(cb.y); wv[4] = bflo(cb.z); wv[5] = bfhi(cb.z); wv[6] = bflo(cb.w); wv[7] = bfhi(cb.w);
#pragma unroll
                    for (int i = 0; i < 4; ++i) { wv[i] = (s0 + i <= l) ? wv[i] * __expf(fminf(al - as0[i], 0.f)) * ds0[i] : 0.f; wv[4 + i] = (s0 + 4 + i <= l) ? wv[4 + i] * __expf(fminf(al - as1[i], 0.f)) * ds1[i] : 0.f; }
                    u32x4 ww; ww.x = pk2(wv[0], wv[1]); ww.y = pk2(wv[2], wv[3]); ww.z = pk2(wv[4], wv[5]); ww.w = pk2(wv[6], wv[7]);
                    const bf16x8 wf = __builtin_bit_cast(bf16x8, ww);
#pragma unroll
                    for (int pt = 0; pt < 4; ++pt) acc[pt][lt] = MFMA16(xf[pt], wf, acc[pt][lt]);
                    asm volatile("" ::: "memory"); } }
            }
            const float Dh = d_skip[h];
#pragma unroll
            for (int lt = 0; lt < 8; ++lt) { const int l = lt * 16 + c16; const size_t tok = (size_t)(row0 + l); float ss = 0.f;
#pragma unroll
                for (int pt = 0; pt < 4; ++pt) { const int pb = pt * 16 + quad * 4;
                    const u32x2 xv = *(const u32x2*)(XC + tok * CONVD + h * 64 + pb), zv = *(const u32x2*)(U + tok * INW + OZ + h * 64 + pb);
                    const float xf0 = bflo(xv.x), xf1 = bfhi(xv.x), xf2 = bflo(xv.y), xf3 = bfhi(xv.y);
                    const float z0 = bflo(zv.x), z1 = bfhi(zv.x), z2 = bflo(zv.y), z3 = bfhi(zv.y);
                    f32x4 v = acc[pt][lt];
                    v[0] = (v[0] + Dh * xf0) * siluf_(z0); v[1] = (v[1] + Dh * xf1) * siluf_(z1); v[2] = (v[2] + Dh * xf2) * siluf_(z2); v[3] = (v[3] + Dh * xf3) * siluf_(z3);
                    acc[pt][lt] = v; ss += (v[0] * v[0] + v[1] * v[1]) + (v[2] * v[2] + v[3] * v[3]); }
                ss += __shfl_xor(ss, 16); ss += __shfl_xor(ss, 32);
                if (quad == 0) ssq[w * 128 + l] = ss;
                if (lt & 1) asm volatile("" ::: "memory"); }
            __syncthreads();
#pragma unroll
            for (int lt = 0; lt < 8; ++lt) { const int l = lt * 16 + c16; const size_t tok = (size_t)(row0 + l); float s = 0.f;
#pragma unroll
                for (int ww = 0; ww < 8; ++ww) s += ssq[ww * 128 + l];
                const float r = rsqrtf(s * (1.f / 512.f) + EPS);
#pragma unroll
                for (int pt = 0; pt < 4; ++pt) { const f32x4 v = acc[pt][lt] * r; u32x2 o; o.x = pk2(v[0], v[1]); o.y = pk2(v[2], v[3]);
                    *(u32x2*)(U + tok * INW + OZ + h * 64 + pt * 16 + quad * 4) = o; }
                asm volatile("" ::: "memory"); }
        }
    }
    SEAM(5); STAMP(6);
    if (IN(6)) {
        { pg8::Gemm g{U, WOA, M, DM, 1536, INW, 1536}; pg8::StaticOrder S; S.init(MP, DM, G, bx, 6, 2); EpiGate2 E{U, MERGED}; pg8::gemm_phase<EpiGate2, 256, 244 * MiB, -1, 8, true>(lds, g, S, E); }
    }
    SEAM(6); STAMP(7);
    if (IN(7)) {
        const float* x_p = kin(0);
        {
            LOCAL_IDS const bf16_t* pa = (const bf16_t*)(ws + 244 * MiB);
            for (int e4 = bx * 512 + tid; e4 < 512 * 256; e4 += NGT) { const int row = e4 >> 8, c4 = (e4 & 255) * 4;
                f32x4 sa = (f32x4){0.f, 0.f, 0.f, 0.f}, sb = (f32x4){0.f, 0.f, 0.f, 0.f};
#pragma unroll
                for (int sl = 0; sl < 6; ++sl) { const u32x2 qv = *(const u32x2*)(pa + ((size_t)sl * 512 + row) * DM + c4); const f32x4 v = (f32x4){bflo(qv.x), bfhi(qv.x), bflo(qv.y), bfhi(qv.y)}; if (sl < 2) sa += v; else sb += v; }
                const bf16_t* up = U + (size_t)(MP + row) * INW; const u32x2 ga = *(const u32x2*)(up + OGA + c4), gb = *(const u32x2*)(up + OGB + c4);
                u32x2 o; o.x = pk2(sigmoidf_(bflo(ga.x)) * sa[0] + sigmoidf_(bflo(gb.x)) * sb[0], sigmoidf_(bfhi(ga.x)) * sa[1] + sigmoidf_(bfhi(gb.x)) * sb[1]);
                o.y = pk2(sigmoidf_(bflo(ga.y)) * sa[2] + sigmoidf_(bflo(gb.y)) * sb[2], sigmoidf_(bfhi(ga.y)) * sa[3] + sigmoidf_(bfhi(gb.y)) * sb[3]);
                st_wt8(MERGED + (size_t)(MP + row) * DM + c4, o.x, o.y); }
            SOFT_ARRIVE(0); }
        pg8::Gemm g{MERGED, WO, M, DM, DM, DM, DM}; pg8::StaticOrder S; S.init(MP, DM, G, bx, 4, 2);
        EpiRes<1> E{x_p, X1B, SSQ2}; pg8::gemm_phase<EpiRes<1>, 256, 244 * MiB, 0, -1, true>(lds, g, S, E);
    }
    SEAM(7); STAMP(8);
    if (IN(8)) {
        {
            LOCAL_IDS const float* x_s = kin(1); const bf16_t* p4 = (const bf16_t*)(ws + 244 * MiB);
            for (int row = gw; row < 512; row += NGW) { float ss = 0.f;
#pragma unroll
                for (int j = 0; j < 4; ++j) { const int c = lane * 4 + 256 * j; f32x4 v = *(const f32x4*)(x_s + (size_t)row * DM + c);
#pragma unroll
                    for (int sl = 0; sl < 4; ++sl) { const u32x2 qv = *(const u32x2*)(p4 + ((size_t)sl * 512 + row) * DM + c); v += (f32x4){bflo(qv.x), bfhi(qv.x), bflo(qv.y), bfhi(qv.y)}; }
                    st_wt8(X1B + (size_t)(MP + row) * DM + c, pk2(v[0], v[1]), pk2(v[2], v[3]));
                    ss += (v[0] * v[0] + v[1] * v[1]) + (v[2] * v[2] + v[3] * v[3]); }
                ss = wave_sum(ss); if (lane == 0) __hip_atomic_store(SSQ2 + MP + row, ss, __ATOMIC_RELAXED, __HIP_MEMORY_SCOPE_AGENT); }
            SOFT_ARRIVE(1); }
        pg8::Gemm g{X1B, WUP, M, DFF, DM, DM, DM}; pg8::StaticOrder S; S.init(MP, DFF, G, bx, 4, 2);
        EpiUp E{SSQ2, ACT}; pg8::gemm_phase<EpiUp, 256, WS_MERGED, 1, -1, true>(lds, g, S, E);
    }
    SEAM(8); STAMP(9);
    if (IN(9)) {
        {
            LOCAL_IDS const bf16_t* p5 = (const bf16_t*)(ws + WS_MERGED);
            for (int e4 = bx * 512 + tid; e4 < 512 * 1024; e4 += NGT) { const int row = e4 >> 10, c4 = (e4 & 1023) * 4;
                f32x4 v = (f32x4){0.f, 0.f, 0.f, 0.f};
#pragma unroll
                for (int sl = 0; sl < 4; ++sl) { const u32x2 pv = *(const u32x2*)(p5 + ((size_t)sl * 512 + row) * DFF + c4); v += (f32x4){bflo(pv.x), bfhi(pv.x), bflo(pv.y), bfhi(pv.y)}; }
                const float rs = rsqrtf(SSQ2[MP + row] * (1.f / DM) + EPS);
#pragma unroll
                for (int i = 0; i < 4; ++i) { const float t = fmaxf(v[i] * rs, 0.f); v[i] = t * t; }
                st_wt8(ACT + (size_t)(MP + row) * DFF + c4, pk2(v[0], v[1]), pk2(v[2], v[3])); }
            SOFT_ARRIVE(2); }
        pg8::Gemm g{ACT, WDN, M, DM, DFF, DFF, DFF}; pg8::StaticOrder S; S.init(MP, DM, G, bx, 16, 2);
        EpiRes<0> E{nullptr, X1B, nullptr}; pg8::gemm_phase<EpiRes<0>, 256, WS_MERGED, 2, -1, true>(lds, g, S, E);
    }
    SEAM(9); STAMP(10);
    if (IN(10)) {
        const float* final_norm = kin(21);
        LOCAL_IDS
        const bf16_t* p6 = (const bf16_t*)(ws + WS_MERGED);
#pragma unroll 2
        for (int m = gw; m < M; m += NGW) { float* xr = X1 + (size_t)m * DM; f32x4 v[4]; float ss = 0.f;
#pragma unroll
            for (int j = 0; j < 4; ++j) { const int cidx = lane * 4 + 256 * j; const u32x2 pv = *(const u32x2*)(X1B + (size_t)m * DM + cidx); v[j] = (f32x4){bflo(pv.x), bfhi(pv.x), bflo(pv.y), bfhi(pv.y)};
                if (m >= MP) {
#pragma unroll
                    for (int sl = 0; sl < 16; ++sl) { const u32x2 qv = *(const u32x2*)(p6 + ((size_t)sl * 512 + (m - MP)) * DM + cidx); v[j] += (f32x4){bflo(qv.x), bfhi(qv.x), bflo(qv.y), bfhi(qv.y)}; } }
                ss += (v[j][0] * v[j][0] + v[j][1] * v[j][1]) + (v[j][2] * v[j][2] + v[j][3] * v[j][3]); }
            const float r = rsqrtf(wave_sum(ss) * (1.f / DM) + EPS);
#pragma unroll
            for (int j = 0; j < 4; ++j) { const int cidx = lane * 4 + 256 * j; const f32x4 fw = *(const f32x4*)(final_norm + cidx); __builtin_nontemporal_store(v[j] * r * fw, (f32x4*)(xr + cidx)); } }
    }
#ifdef PROBE_A
    STAMP(11);
    if (bx == 0 && tid0 == 0) { asm volatile("s_waitcnt vmcnt(0)" ::: "memory"); const float us = (float)(tstamp[PROBE_B] - tstamp[PROBE_A]) * 0.01f; out[0] = out[0] + 16.f + us * (1.f / PROBE_SCALE); }
#endif
#undef IN
#undef SEAM
}

#ifndef N_LAUNCH_MODE
#define N_LAUNCH_MODE 1
#endif
extern "C" void kernel_launch(void* const* d_in, const int* in_sizes, int n_in, void* d_out, int out_size, void* d_ws, size_t ws_size, hipStream_t stream) {
    static int grid = 0;
    if (grid == 0) {
        int dev = 0, cus = 0, per_cu = 0;
        hipGetDevice(&dev); hipDeviceGetAttribute(&cus, hipDeviceAttributeMultiprocessorCount, dev);
        if (hipFuncSetAttribute((const void*)mega, hipFuncAttributeMaxDynamicSharedMemorySize, LDS_BYTES) != hipSuccess) { fprintf(stderr, "hipFuncSetAttribute failed\n"); }
        if (hipOccupancyMaxActiveBlocksPerMultiprocessor(&per_cu, (const void*)mega, 512, LDS_BYTES) != hipSuccess || per_cu < 1) { fprintf(stderr, "occupancy query: %d\n", per_cu); per_cu = 1; }
        (void)hipGetLastError();
        grid = cus * 1;
        if (grid <= 0) grid = 256;
    }
    (void)hipMemsetAsync((unsigned char*)d_ws + WS_BAR, 0, 1024 + XCD_BAR_WORDS * 4, stream);
    Args a{};
    for (int i = 0; i < 22; ++i) a.in[i] = (const float*)d_in[i];
    a.out = (float*)d_out; a.ws = (unsigned char*)d_ws;
#if N_LAUNCH_MODE == 1
    a.ph_lo = 0; a.ph_hi = 11;
    void* args[] = {&a};
    hipError_t e = hipLaunchCooperativeKernel((const void*)mega, dim3(grid), dim3(512), args, LDS_BYTES, stream);
    if (e != hipSuccess) fprintf(stderr, "cooperative launch failed: %s (grid %d)\n", hipGetErrorString(e), grid);
#else
    for (int p = 0; p < 11; ++p) { a.ph_lo = p; a.ph_hi = p + 1; hipLaunchKernelGGL(mega, dim3(grid), dim3(512), LDS_BYTES, stream, a); }
#endif
}
```
